# Optimizing an MI355X kernel written in HIP

```python
import jax, jax.numpy as jnp
from jax import lax
import numpy as np


D_MODEL = 1024
BATCH = 16
SEQ = 4096
DEPTH = 1

CTX_LEN = 256
GRID_W = 64
N_RET_HEADS = 4
RET_QK_DIM = 256
RET_V_DIM = 512
RET_CHUNK = 128
N_MLA_HEADS = 8
MLA_Q_RANK = 384
MLA_KV_RANK = 256
MLA_QK_NOPE = 128
MLA_QK_ROPE = 64
MLA_V_DIM = 128
Q_BLOCK = 128
N_EXPERTS = 32
TOP_K = 4
D_FF_EXPERT = D_MODEL
SWIGLU_LIMIT = 7.0
SWIGLU_ALPHA = 1.702
MOE_BLOCK = 128
ROPE_BASE = 10000.0
EPS = 1e-6
IN_COLS = (2 * N_RET_HEADS * RET_QK_DIM + 2 * N_RET_HEADS * RET_V_DIM
           + MLA_Q_RANK + MLA_KV_RANK + MLA_QK_ROPE + 2 * D_MODEL)

kernel_name = 'hybrid_retention_mla_moe_dit_block'


def rms_norm(t, g):
    tf = t.astype(jnp.float32)
    n = tf * lax.rsqrt(jnp.mean(tf * tf, axis=-1, keepdims=True) + EPS)
    return n.astype(t.dtype) * g


def head_rms(t):
    tf = t.astype(jnp.float32)
    return (tf * lax.rsqrt(jnp.mean(tf * tf, axis=-1, keepdims=True) + EPS)).astype(t.dtype)


def ada_mod(cvec, w, b):
    m = jax.nn.silu(cvec) @ w + b
    return jnp.split(m[:, None, :], 6, axis=-1)


def modulate(t, shift, scale):
    return t * (1.0 + scale) + shift


def rope_1d(t, pos):
    half = t.shape[-1] // 2
    freqs = ROPE_BASE ** (-jnp.arange(half, dtype=jnp.float32) / half)
    ang = pos.astype(jnp.float32)[:, None] * freqs[None, :]
    cos = jnp.cos(ang)[None, :, None, :].astype(t.dtype)
    sin = jnp.sin(ang)[None, :, None, :].astype(t.dtype)
    t1, t2 = t[..., :half], t[..., half:]
    return jnp.concatenate([t1 * cos - t2 * sin, t1 * sin + t2 * cos], axis=-1)


def rope_2d(t, rows, cols):
    half = t.shape[-1] // 2
    return jnp.concatenate([rope_1d(t[..., :half], rows), rope_1d(t[..., half:], cols)], axis=-1)


def split_proj(z):
    sizes = (N_RET_HEADS * RET_QK_DIM, N_RET_HEADS * RET_QK_DIM, N_RET_HEADS * RET_V_DIM,
             N_RET_HEADS * RET_V_DIM, MLA_Q_RANK, MLA_KV_RANK, MLA_QK_ROPE, D_MODEL, D_MODEL)
    idx, acc = [], 0
    for s in sizes[:-1]:
        acc += s
        idx.append(acc)
    return jnp.split(z, idx, axis=-1)


def retention_qkv(rq, rk, rv, rope_fn):
    B, L, _ = rq.shape
    q = rq.reshape(B, L, N_RET_HEADS, RET_QK_DIM)
    k = rk.reshape(B, L, N_RET_HEADS, RET_QK_DIM)
    v = rv.reshape(B, L, N_RET_HEADS, RET_V_DIM)
    if rope_fn is not None:
        q, k = rope_fn(q), rope_fn(k)
    return q, k * (RET_QK_DIM ** -0.5), v


def retention_state(k, v, lg):
    L = k.shape[1]
    w = jnp.exp(lg[:, None] * (L - 1 - jnp.arange(L, dtype=jnp.float32))[None, :]).astype(v.dtype)
    return jnp.einsum('blhd,blhe,hl->bhde', k, v, w)


def retention_chunked(q, k, v, lg, init_state, include_diag):
    B, L, H, dk = q.shape
    dv = v.shape[-1]
    nc = L // RET_CHUNK
    idx = jnp.arange(RET_CHUNK, dtype=jnp.float32)
    diff = idx[:, None] - idx[None, :]
    mask = (diff >= 0) if include_diag else (diff > 0)
    intra = jnp.where(mask[None], jnp.exp(lg[:, None, None] * jnp.maximum(diff, 0.0)[None]), 0.0).astype(v.dtype)
    q_dec = jnp.exp(lg[:, None] * (idx + 1.0)[None, :]).astype(v.dtype)
    k_dec = jnp.exp(lg[:, None] * (RET_CHUNK - 1.0 - idx)[None, :]).astype(v.dtype)
    chunk_dec = jnp.exp(lg * RET_CHUNK).astype(v.dtype)

    def to_chunks(t):
        return t.reshape(B, nc, RET_CHUNK, H, t.shape[-1]).transpose(1, 0, 3, 2, 4)

    def step(state, blk):
        qc, kc, vc = blk
        s = jnp.einsum('bhid,bhjd->bhij', qc, kc) * intra[None]
        o = (jnp.einsum('bhij,bhje->bhie', s, vc)
             + jnp.einsum('bhid,bhde->bhie', qc * q_dec[None, :, :, None], state))
        state = (state * chunk_dec[None, :, None, None]
                 + jnp.einsum('bhjd,bhje->bhde', kc * k_dec[None, :, :, None], vc))
        return state, o

    _, o = lax.scan(step, init_state, (to_chunks(q), to_chunks(k), to_chunks(v)))
    return o.transpose(1, 0, 3, 2, 4).reshape(B, L, H, dv)


def bidir_retention(q, k, v, lg_f, lg_b, s_f, s_b):
    fwd = retention_chunked(q, k, v, lg_f, s_f, True)
    bwd = retention_chunked(jnp.flip(q, 1), jnp.flip(k, 1), jnp.flip(v, 1), lg_b, s_b, False)
    return fwd + jnp.flip(bwd, 1)


def mla_qkv(cq, ckv, kr, q_norm_g, w_uq, kv_norm_g, w_ukv, rope_fn):
    B, L, _ = cq.shape
    q = (rms_norm(cq, q_norm_g) @ w_uq).reshape(B, L, N_MLA_HEADS, MLA_QK_NOPE + MLA_QK_ROPE)
    q_nope, q_rope = q[..., :MLA_QK_NOPE], q[..., MLA_QK_NOPE:]
    kv = (rms_norm(ckv, kv_norm_g) @ w_ukv).reshape(B, L, N_MLA_HEADS, MLA_QK_NOPE + MLA_V_DIM)
    k_nope, v = kv[..., :MLA_QK_NOPE], kv[..., MLA_QK_NOPE:]
    k_rope = kr[:, :, None, :]
    if rope_fn is not None:
        q_rope, k_rope = rope_fn(q_rope), rope_fn(k_rope)
    return q_nope, q_rope, k_nope, k_rope[:, :, 0, :], v


def mla_attention(q_nope, q_rope, k_nope, k_rope, v):
    B, Lq, H, _ = q_nope.shape
    nb = Lq // Q_BLOCK
    scale = (MLA_QK_NOPE + MLA_QK_ROPE) ** -0.5

    def blocks(t):
        return t.reshape(B, nb, Q_BLOCK, H, t.shape[-1]).swapaxes(0, 1)

    def one_block(qb):
        qn, qr = qb
        s = (jnp.einsum('bqhd,bkhd->bhqk', qn, k_nope)
             + jnp.einsum('bqhd,bkd->bhqk', qr, k_rope)) * scale
        p = jax.nn.softmax(s.astype(jnp.float32), axis=-1).astype(v.dtype)
        return jnp.einsum('bhqk,bkhd->bqhd', p, v)

    o = lax.map(one_block, (blocks(q_nope), blocks(q_rope)))
    return o.swapaxes(0, 1).reshape(B, Lq, H, MLA_V_DIM)


def merge_branches(ret_o, ret_gate, att_o, g_ret, g_mla, w_branch_ret, w_branch_mla, w_out):
    B, L = ret_o.shape[:2]
    r = head_rms(ret_o).reshape(B, L, N_RET_HEADS * RET_V_DIM) * jax.nn.silu(ret_gate)
    m = att_o.reshape(B, L, N_MLA_HEADS * MLA_V_DIM)
    merged = jax.nn.sigmoid(g_ret) * (r @ w_branch_ret) + jax.nn.sigmoid(g_mla) * (m @ w_branch_mla)
    return merged @ w_out


def token_mixers(h_lat, h_ctx, rope_fn, need_ctx, w_in, ret_decay_fwd, ret_decay_bwd, mla_q_norm_g,
                 mla_w_uq, mla_kv_norm_g, mla_w_ukv, w_branch_ret, w_branch_mla, w_out):
    zl = split_proj(h_lat @ w_in)
    zc = split_proj(h_ctx @ w_in)
    lg_f = jax.nn.log_sigmoid(ret_decay_fwd.astype(jnp.float32))
    lg_b = jax.nn.log_sigmoid(ret_decay_bwd.astype(jnp.float32))
    ql, kl, vl = retention_qkv(zl[0], zl[1], zl[2], rope_fn)
    qc, kc, vc = retention_qkv(zc[0], zc[1], zc[2], None)
    s_f = retention_state(kc, vc, lg_f)
    s_b = retention_state(jnp.flip(kc, 1), jnp.flip(vc, 1), lg_b)
    ret_lat = bidir_retention(ql, kl, vl, lg_f, lg_b, s_f, s_b)
    ml = mla_qkv(zl[4], zl[5], zl[6], mla_q_norm_g, mla_w_uq, mla_kv_norm_g, mla_w_ukv, rope_fn)
    mc = mla_qkv(zc[4], zc[5], zc[6], mla_q_norm_g, mla_w_uq, mla_kv_norm_g, mla_w_ukv, None)
    att_lat = mla_attention(ml[0], ml[1], jnp.concatenate([mc[2], ml[2]], axis=1),
                            jnp.concatenate([mc[3], ml[3]], axis=1), jnp.concatenate([mc[4], ml[4]], axis=1))
    y_lat = merge_branches(ret_lat, zl[3], att_lat, zl[7], zl[8], w_branch_ret, w_branch_mla, w_out)
    y_ctx = None
    if need_ctx:
        zeros = jnp.zeros_like(s_f)
        ret_ctx = bidir_retention(qc, kc, vc, lg_f, lg_b, zeros, zeros)
        att_ctx = mla_attention(mc[0], mc[1], mc[2], mc[3], mc[4])
        y_ctx = merge_branches(ret_ctx, zc[3], att_ctx, zc[7], zc[8], w_branch_ret, w_branch_mla, w_out)
    return y_lat, y_ctx


def moe(h, router_w, router_b, w_gu, b_gu, w_down, b_down):
    B, L, D = h.shape
    tok = h.reshape(-1, D)
    n_tok = tok.shape[0]
    logits = tok @ router_w + router_b
    top_val, top_idx = lax.top_k(logits, TOP_K)
    gates = jax.nn.softmax(top_val.astype(jnp.float32), axis=-1)
    nk = n_tok * TOP_K
    flat_e = top_idx.reshape(-1)
    flat_tok = jnp.arange(nk, dtype=jnp.int32) // TOP_K
    order = jnp.argsort(flat_e)
    sorted_e = flat_e[order]
    sorted_tok = flat_tok[order]
    sorted_gate = gates.reshape(-1)[order]
    counts = jnp.zeros((N_EXPERTS,), jnp.int32).at[flat_e].add(1)
    padded = (counts + MOE_BLOCK - 1) // MOE_BLOCK * MOE_BLOCK
    start = jnp.cumsum(counts) - counts
    pad_end = jnp.cumsum(padded)
    pad_start = pad_end - padded
    dest = pad_start[sorted_e] + (jnp.arange(nk, dtype=jnp.int32) - start[sorted_e])
    n_rows = nk + N_EXPERTS * MOE_BLOCK
    n_blocks = n_rows // MOE_BLOCK
    xs = jnp.zeros((n_rows, D), tok.dtype).at[dest].set(tok[sorted_tok])
    block_e = jnp.minimum(jnp.searchsorted(pad_end, jnp.arange(n_blocks, dtype=jnp.int32) * MOE_BLOCK,
                                           side='right'), N_EXPERTS - 1)

    def expert_block(args):
        xb, e = args
        gu = xb @ w_gu[e] + b_gu[e]
        gate, up = gu[:, :D_FF_EXPERT], gu[:, D_FF_EXPERT:]
        gate = jnp.minimum(gate, SWIGLU_LIMIT)
        up = jnp.clip(up, -SWIGLU_LIMIT, SWIGLU_LIMIT)
        glu = gate * jax.nn.sigmoid(SWIGLU_ALPHA * gate)
        return ((up + 1.0) * glu) @ w_down[e] + b_down[e]

    ys = lax.map(expert_block, (xs.reshape(n_blocks, MOE_BLOCK, D), block_e)).reshape(n_rows, D)
    out = jnp.zeros_like(tok).at[sorted_tok].add(ys[dest] * sorted_gate[:, None].astype(ys.dtype))
    return out.reshape(B, L, D)


def setup_inputs(seed: int = 0) -> dict:
    key = jax.random.key(seed)
    ks = jax.random.split(key, 25)
    f32 = jnp.float32

    def nrm(k, shape, scale):
        return jax.random.normal(k, shape, f32) * scale

    ret_base = jnp.log(jnp.exp2(5.0 + jnp.arange(N_RET_HEADS, dtype=f32)) - 1.0)
    ret_v_w = N_RET_HEADS * RET_V_DIM
    mla_v_w = N_MLA_HEADS * MLA_V_DIM
    return {
        'x': nrm(ks[0], (BATCH, SEQ, D_MODEL), 1.0),
        'c': nrm(ks[1], (BATCH, D_MODEL), 1.0),
        'ctx': nrm(ks[2], (BATCH, CTX_LEN, D_MODEL), 1.0),
        'c_ctx': nrm(ks[3], (D_MODEL,), 1.0),
        'norm1_g': 1.0 + nrm(ks[4], (DEPTH, D_MODEL), 0.02),
        'norm2_g': 1.0 + nrm(ks[5], (DEPTH, D_MODEL), 0.02),
        'ada_w': nrm(ks[6], (DEPTH, D_MODEL, 6 * D_MODEL), 0.5 * D_MODEL ** -0.5),
        'ada_b': nrm(ks[7], (DEPTH, 6 * D_MODEL), 0.01),
        'w_in': nrm(ks[8], (DEPTH, D_MODEL, IN_COLS), D_MODEL ** -0.5),
        'ret_decay_fwd': ret_base[None, :] + nrm(ks[9], (DEPTH, N_RET_HEADS), 0.1),
        'ret_decay_bwd': ret_base[None, :] + nrm(ks[10], (DEPTH, N_RET_HEADS), 0.1),
        'mla_q_norm_g': 1.0 + nrm(ks[11], (DEPTH, MLA_Q_RANK), 0.02),
        'mla_w_uq': nrm(ks[12], (DEPTH, MLA_Q_RANK, N_MLA_HEADS * (MLA_QK_NOPE + MLA_QK_ROPE)), MLA_Q_RANK ** -0.5),
        'mla_kv_norm_g': 1.0 + nrm(ks[13], (DEPTH, MLA_KV_RANK), 0.02),
        'mla_w_ukv': nrm(ks[14], (DEPTH, MLA_KV_RANK, N_MLA_HEADS * (MLA_QK_NOPE + MLA_V_DIM)), MLA_KV_RANK ** -0.5),
        'w_branch_ret': nrm(ks[15], (DEPTH, ret_v_w, D_MODEL), ret_v_w ** -0.5),
        'w_branch_mla': nrm(ks[16], (DEPTH, mla_v_w, D_MODEL), mla_v_w ** -0.5),
        'w_out': nrm(ks[17], (DEPTH, D_MODEL, D_MODEL), D_MODEL ** -0.5),
        'router_w': nrm(ks[18], (DEPTH, D_MODEL, N_EXPERTS), D_MODEL ** -0.5),
        'router_b': nrm(ks[19], (DEPTH, N_EXPERTS), 0.01),
        'exp_w_gu': nrm(ks[20], (DEPTH, N_EXPERTS, D_MODEL, 2 * D_FF_EXPERT), D_MODEL ** -0.5),
        'exp_b_gu': nrm(ks[21], (DEPTH, N_EXPERTS, 2 * D_FF_EXPERT), 0.01),
        'exp_w_down': nrm(ks[22], (DEPTH, N_EXPERTS, D_FF_EXPERT, D_MODEL), D_FF_EXPERT ** -0.5),
        'exp_b_down': nrm(ks[23], (DEPTH, N_EXPERTS, D_MODEL), 0.01),
        'final_norm_g': 1.0 + nrm(ks[24], (D_MODEL,), 0.02),
    }


def reference(x, c, ctx, c_ctx, norm1_g, norm2_g, ada_w, ada_b, w_in, ret_decay_fwd, ret_decay_bwd,
              mla_q_norm_g, mla_w_uq, mla_kv_norm_g, mla_w_ukv, w_branch_ret, w_branch_mla, w_out,
              router_w, router_b, exp_w_gu, exp_b_gu, exp_w_down, exp_b_down, final_norm_g):
    L = x.shape[1]
    n_grid_rows = L // GRID_W
    rows = jnp.repeat(jnp.arange(n_grid_rows, dtype=jnp.int32), GRID_W)
    cols = jnp.tile(jnp.arange(GRID_W, dtype=jnp.int32), n_grid_rows)
    rope_fn = lambda t: rope_2d(t, rows, cols)
    for layer in range(DEPTH):
        need_ctx = layer < DEPTH - 1
        m_lat = ada_mod(c, ada_w[layer], ada_b[layer])
        m_ctx = ada_mod(c_ctx[None, :], ada_w[layer], ada_b[layer])
        h_lat = modulate(rms_norm(x, norm1_g[layer]), m_lat[0], m_lat[1])
        h_ctx = modulate(rms_norm(ctx, norm1_g[layer]), m_ctx[0], m_ctx[1])
        y_lat, y_ctx = token_mixers(h_lat, h_ctx, rope_fn, need_ctx, w_in[layer], ret_decay_fwd[layer],
                                    ret_decay_bwd[layer], mla_q_norm_g[layer], mla_w_uq[layer],
                                    mla_kv_norm_g[layer], mla_w_ukv[layer], w_branch_ret[layer],
                                    w_branch_mla[layer], w_out[layer])
        x = x + m_lat[2] * y_lat
        h2 = modulate(rms_norm(x, norm2_g[layer]), m_lat[3], m_lat[4])
        x = x + m_lat[5] * moe(h2, router_w[layer], router_b[layer], exp_w_gu[layer], exp_b_gu[layer],
                               exp_w_down[layer], exp_b_down[layer])
        if need_ctx:
            ctx = ctx + m_ctx[2] * y_ctx
            h2c = modulate(rms_norm(ctx, norm2_g[layer]), m_ctx[3], m_ctx[4])
            ctx = ctx + m_ctx[5] * moe(h2c, router_w[layer], router_b[layer], exp_w_gu[layer],
                                       exp_b_gu[layer], exp_w_down[layer], exp_b_down[layer])
    return rms_norm(x, final_norm_g)
```

```cpp
#include <hip/hip_runtime.h>
#include <cstdio>
#include <cstdint>

#define GAS __attribute__((address_space(1)))
#define LAS __attribute__((address_space(3)))
typedef unsigned short bf16;
typedef unsigned v4u __attribute__((ext_vector_type(4)));
typedef unsigned v2u __attribute__((ext_vector_type(2)));
typedef float f32x4 __attribute__((ext_vector_type(4)));
typedef float f32x2 __attribute__((ext_vector_type(2)));
typedef float f32x16 __attribute__((ext_vector_type(16)));
typedef short bf16x8 __attribute__((ext_vector_type(8)));
typedef short s16x4 __attribute__((ext_vector_type(4)));
typedef GAS unsigned gu32;
#define RLX_AGENT __ATOMIC_RELAXED, __HIP_MEMORY_SCOPE_AGENT
#define LDS_WAIT() asm volatile("s_waitcnt lgkmcnt(0)" ::: "memory")
#define VM_WAIT() asm volatile("s_waitcnt vmcnt(0)" ::: "memory")

constexpr int D = 1024, BATCH = 16, SEQ = 4096, CTX = 256, LE = SEQ + CTX;
constexpr int NBG = 4, NGROUPS = BATCH / NBG;
constexpr int TE = NBG * LE, TL = NBG * SEQ;
constexpr int NCH = LE / 256;
constexpr int NEXP = 32, TOPK = 4;
constexpr float EPS = 1e-6f;
constexpr int NBM = 8, NSG = BATCH / NBM, TLM = NBM * SEQ;
constexpr int MOE_ROWS = TLM * TOPK + NEXP * 256;
constexpr int MAXPANELS = MOE_ROWS / 256;

__device__ __forceinline__ unsigned f2bf(float f) { unsigned u = __builtin_bit_cast(unsigned, f); return (u + 0x7fffu + ((u >> 16) & 1u)) >> 16; }
__device__ __forceinline__ unsigned cvt_pk_bf16(float lo, float hi) { unsigned r; asm volatile("v_cvt_pk_bf16_f32 %0, %1, %2" : "=v"(r) : "v"(lo), "v"(hi)); return r; }
__device__ __forceinline__ unsigned pk2(float lo, float hi) { return cvt_pk_bf16(lo, hi); }
__device__ __forceinline__ float bf2f(unsigned short b) { return __builtin_bit_cast(float, ((unsigned)b) << 16); }
__device__ __forceinline__ float bflo(unsigned w) { return __builtin_bit_cast(float, w << 16); }
__device__ __forceinline__ float bfhi(unsigned w) { return __builtin_bit_cast(float, w & 0xffff0000u); }
#define SWZ_XOR(v, k) __builtin_bit_cast(float, __builtin_amdgcn_ds_swizzle(__builtin_bit_cast(int, (v)), 0x1f | ((k) << 10)))
#define DPP_ADD(v, ctrl) (v) += __builtin_bit_cast(float, __builtin_amdgcn_update_dpp(0, __builtin_bit_cast(int, (v)), (ctrl), 0xF, 0xF, true))
__device__ __forceinline__ float wave_sum(float v) {
    DPP_ADD(v, 0xB1); DPP_ADD(v, 0x4E); DPP_ADD(v, 0x141); DPP_ADD(v, 0x140);
    v += SWZ_XOR(v, 16);
    { unsigned a_ = __builtin_bit_cast(unsigned, v), b_ = a_; asm volatile("" : "+v"(b_));
      auto rr = __builtin_amdgcn_permlane32_swap(a_, b_, false, false);
      unsigned r0_ = rr[0], r1_ = rr[1]; asm volatile("" : "+v"(r0_), "+v"(r1_));
      v = __builtin_bit_cast(float, r0_) + __builtin_bit_cast(float, r1_); }
    return v;
}
__device__ __forceinline__ float fast_sigmoid(float x) { return __builtin_amdgcn_rcpf(1.0f + __builtin_amdgcn_exp2f(-1.4426950408889634f * x)); }
__device__ __forceinline__ f32x2 sig2(f32x2 x) { const f32x2 z = x * (f32x2){-1.4426950408889634f, -1.4426950408889634f}; const f32x2 d = (f32x2){__builtin_amdgcn_exp2f(z.x), __builtin_amdgcn_exp2f(z.y)} + (f32x2){1.f, 1.f}; return (f32x2){__builtin_amdgcn_rcpf(d.x), __builtin_amdgcn_rcpf(d.y)}; }
__device__ __forceinline__ f32x2 bf2x2(unsigned u) { return (f32x2){bflo(u), bfhi(u)}; }

__device__ __forceinline__ int lane_id_asm() { int l; asm volatile("v_mbcnt_lo_u32_b32 %0, -1, 0\n\tv_mbcnt_hi_u32_b32 %0, -1, %0" : "=v"(l)); return l; }

#define XB_TMO      128
#define XB_XCNT(j)  (256  + 64 * (j))
#define XB_XSUB(j)  (1280 + 64 * (j))
#define XB_XGEN(j)  (2304 + 64 * (j))
#define XB_TOP      3328
#define XB_TOPGEN   3392
#define XCD_BAR_WORDS 3456
#define XB_SPIN_CAP (1u << 22)

__device__ __forceinline__ unsigned xb_ld(unsigned* p)              { return __hip_atomic_load(p, __ATOMIC_RELAXED, __HIP_MEMORY_SCOPE_AGENT); }
__device__ __forceinline__ unsigned xb_add(unsigned* p, unsigned v) { return __hip_atomic_fetch_add(p, v, __ATOMIC_RELAXED, __HIP_MEMORY_SCOPE_AGENT); }
__device__ __forceinline__ unsigned xb_xcc_id() { return (unsigned)__builtin_amdgcn_s_getreg((3 << 11) | 20) & 0xFu; }
#define XB_SPIN(cond, bar) do { unsigned _sp = 0; while (cond) { __builtin_amdgcn_s_sleep(1); \
    if ((++_sp & 255u) == 0u) { if (xb_ld(&(bar)[XB_TMO])) break; if (_sp > XB_SPIN_CAP) { atomicAdd(&(bar)[XB_TMO], 1u); break; } } } } while (0)

struct XcdBarrier { unsigned* bar; unsigned x; volatile LAS unsigned* st; };

__device__ __forceinline__ XcdBarrier xcd_barrier_post(unsigned* bar, volatile LAS unsigned* st) {
    XcdBarrier b; b.bar = bar; b.x = xb_xcc_id(); b.st = st;
    if (threadIdx.x == 0) (void)xb_add(&bar[XB_XCNT(b.x)], 1u);
    return b;
}
__device__ __forceinline__ void xcd_barrier_complete(unsigned* bar, unsigned x, unsigned& nloc, unsigned& nx) {
    const unsigned G = gridDim.x * gridDim.y * gridDim.z;
    unsigned sum, cnt, mine, sp = 0u;
    for (;;) {
        sum = 0u; cnt = 0u; mine = 0u;
#pragma unroll
        for (unsigned j = 0; j < 16; ++j) { const unsigned c = xb_ld(&bar[XB_XCNT(j)]); sum += c; cnt += (c > 0u) ? 1u : 0u; mine = (j == x) ? c : mine; }
        if (sum == G) break;
        __builtin_amdgcn_s_sleep(1);
        if ((++sp & 255u) == 0u) { if (xb_ld(&bar[XB_TMO])) break; if (sp > XB_SPIN_CAP) { atomicAdd(&bar[XB_TMO], 1u); break; } }
    }
    nloc = mine > 0u ? mine : 1u; nx = cnt > 0u ? cnt : 1u;
}
__device__ __forceinline__ void xcd_barrier(const XcdBarrier& b, int tid_b) {
    asm volatile("s_waitcnt vmcnt(0)" ::: "memory");
    __syncthreads();
    if (tid_b == 0) {
        unsigned* bar = b.bar;
        __builtin_amdgcn_s_waitcnt(0);
        unsigned nloc = b.st[0], nx = b.st[1];
        if (nloc == 0u) { xcd_barrier_complete(bar, b.x, nloc, nx); b.st[0] = nloc; b.st[1] = nx; }
        const unsigned old = xb_add(&bar[XB_XSUB(b.x)], 1u);
        const unsigned gen = old / nloc;
        if (old + 1u == (gen + 1u) * nloc) {
            __builtin_amdgcn_fence(__ATOMIC_RELEASE, "agent");
            asm volatile("s_waitcnt vmcnt(0)" ::: "memory");
            const unsigned og = xb_add(&bar[XB_TOP], 1u);
            const unsigned tg = og / nx;
            if (og + 1u == (tg + 1u) * nx) xb_add(&bar[XB_TOPGEN], 1u);
            else XB_SPIN(xb_ld(&bar[XB_TOPGEN]) == tg, bar);
            __builtin_amdgcn_fence(__ATOMIC_ACQUIRE, "agent");
            xb_add(&bar[XB_XGEN(b.x)], 1u);
            asm volatile("s_waitcnt vmcnt(0)" ::: "memory");
        } else {
            XB_SPIN(xb_ld(&bar[XB_XGEN(b.x)]) == gen, bar);
            __builtin_amdgcn_fence(__ATOMIC_ACQUIRE, "agent");
            asm volatile("s_waitcnt vmcnt(0)" ::: "memory");
        }
    }
    __syncthreads();
}

namespace pg8 {
constexpr int BM = 256, BK = 64, HALF = 128, HTB = HALF * BK * 2, STAGE_BYTES = 8 * HTB, NXCD = 8, WGM = 8;
constexpr int EPI_SLOT_OFF = STAGE_BYTES + 8192, EPI_SLOT_BYTES = 4096;
__host__ __device__ __forceinline__ int lds_byte(int r, int c) { const int pos = ((c >> 3) & 3) ^ (((r >> 2) & 1) << 1); return (r >> 3) * 1024 + ((c >> 5) & 1) * 512 + (r & 7) * 64 + pos * 16 + (c & 7) * 2; }
__host__ __device__ __forceinline__ void stage_rc(int b, int& R, int& C) { const int p = b / 1024, sb = b % 1024, pos = (sb >> 4) & 3; R = p * 8 + ((sb >> 6) & 7); C = (sb >> 9) * 32 + ((pos ^ (((R >> 2) & 1) << 1)) * 8) + (sb & 15) / 2; }
__host__ __device__ __forceinline__ int perm32(int rho) { const int n = rho >> 4, i = rho & 15; return 8 * (i >> 2) + 4 * n + (i & 3); }

struct Unit { const char* a; const char* b; int u0, u1, u2, u3, u4; };

__device__ __forceinline__ void tile2d(int L, int nM, int nN, int& pm, int& pn) {
    const int nwg = nM * nN; int wgid = L;
    { const int q = nwg / NXCD, r = nwg % NXCD, xcd = wgid % NXCD, off = wgid / NXCD; wgid = (xcd < r ? xcd * (q + 1) : r * (q + 1) + (xcd - r) * q) + off; }
    const int nig = WGM * nN, gid = wgid / nig, fm = gid * WGM, gsz = (nM - fm) < WGM ? (nM - fm) : WGM;
    pm = fm + ((wgid % nig) % gsz); pn = (wgid % nig) / gsz;
}

struct Cont { const char* a; const char* b; int lda, ldb; };
template <class Epi, class Sched, int LDA, int LDB, int KT, bool GATHER = false, bool STAGGER = false>
__device__ __forceinline__ bool gemm_phase(LAS unsigned char* lds, const Sched& S, const Epi& E, int tid_in, const Cont cont = Cont{nullptr, nullptr, 0, 0}, const bool prestaged = false) {
    static_assert(KT >= 4 && (KT % 2) == 0, "K multiple of 128, >= 256");
    const int tid_o = tid_in * 64 + lane_id_asm();
    const int tid = tid_o, wid = __builtin_amdgcn_readfirstlane(tid >> 6), lane = tid & 63, wr = wid >> 2, wc = wid & 3, fr = lane & 15, fq = lane >> 4;
    constexpr int nt = KT;
    unsigned voffA[2], voffB[2];
#pragma unroll
    for (int i = 0; i < 2; ++i) { int R, C; stage_rc(tid * 16 + i * 8192, R, C); const int Rb = Epi::PERM ? ((R & ~31) + perm32(R & 31)) : R;
        voffA[i] = (unsigned)(R * LDA + C) * 2u; voffB[i] = (unsigned)(Rb * LDB + C) * 2u; }
    constexpr size_t kstep = (size_t)(BK * 2);
    size_t hstepA = (size_t)HALF * LDA * 2, hstepB = (size_t)HALF * LDB * 2;
    const unsigned ldsw = (unsigned)wid * 1024u;
    const int aoff = lds_byte(wr * 64 + fr, fq * 8), boff = lds_byte(wc * 32 + fr, fq * 8);
#define PG8_SA(b, h) (((b) * 2 + (h)) * HTB)
#define PG8_SB(b, h) ((4 + (b) * 2 + (h)) * HTB)
#define PG8_STAGE(bufoff, gbase, voff) do { const char* _b = (const char*)(gbase); asm volatile("" : "+s"(_b)); _Pragma("unroll") for (int _i = 0; _i < 2; ++_i) { unsigned _v = (voff)[_i]; asm volatile("" : "+v"(_v)); \
        __builtin_amdgcn_global_load_lds((const unsigned*)(_b + _v), (LAS unsigned*)(lds + (bufoff) + ldsw + _i * 8192), 16, 0, 0); } } while (0)
    unsigned ogc[2] = {0u, 0u}, ogn[2] = {0u, 0u}; const unsigned gpk = (voffA[0] / (unsigned)(LDA * 2)) | ((voffA[0] % (unsigned)(LDA * 2)) << 8);
#define PG8_LOAD_OG(og, un) do { if constexpr (GATHER) { unsigned _g = gpk; asm volatile("" : "+v"(_g)); const int rA0 = (int)(_g & 255u); _Pragma("unroll") for (int _h = 0; _h < 2; ++_h) { const unsigned* _q = (const unsigned*)S.rowtok + ((((un).u4 + 128 * _h) >> 1) + rA0); unsigned _x; \
        asm volatile("global_load_dword %0, %1, off" : "=v"(_x) : "v"(_q) : "memory"); og[_h] = _x; } } } while (0)
#define PG8_MASK_OG(p, rem, h) ([&](unsigned _pp, int _rem, int _hh) { unsigned _gg = gpk; asm volatile("" : "+v"(_gg)); const int _r = (int)(_gg & 255u) + 128 * _hh; return ((_r < _rem) ? (_pp & 0xffffu) : (unsigned)S.zrow) | (((_r + 64 < _rem) ? (_pp >> 16) : (unsigned)S.zrow) << 16); }((p), (rem), (h)))
#define PG8_STAGE_A(bufoff, base, h, nx) do { if constexpr (GATHER) { const char* _bg = (const char*)(base); asm volatile("" : "+s"(_bg)); unsigned _pn = ogn[h], _g = gpk; asm volatile("" : "+v"(_pn), "+v"(_g)); const unsigned _p = (nx) ? PG8_MASK_OG(_pn, nxt.u3, h) : ogc[h], cbA = _g >> 8; \
        __builtin_amdgcn_global_load_lds((const unsigned*)(_bg + (size_t)((_p & 0xffffu) * (unsigned)(LDA * 2) + cbA)), (LAS unsigned*)(lds + (bufoff) + ldsw), 16, 0, 0); \
        __builtin_amdgcn_global_load_lds((const unsigned*)(_bg + (size_t)((_p >> 16) * (unsigned)(LDA * 2) + cbA)), (LAS unsigned*)(lds + (bufoff) + ldsw + 8192), 16, 0, 0); } \
        else { PG8_STAGE(bufoff, (base) + (h) * hstepA, voffA); } } while (0)
#define PG8_LDA(dst, b, h) do { _Pragma("unroll") for (int m = 0; m < 4; ++m) _Pragma("unroll") for (int k = 0; k < 2; ++k) dst[m][k] = *(const LAS bf16x8*)(lds + PG8_SA(b, h) + aoff + m * 2048 + k * 512); } while (0)
#define PG8_LDB(dst, b, h) do { _Pragma("unroll") for (int n = 0; n < 2; ++n) _Pragma("unroll") for (int k = 0; k < 2; ++k) dst[n][k] = *(const LAS bf16x8*)(lds + PG8_SB(b, h) + boff + n * 2048 + k * 512); } while (0)
#define PG8_MMA(ai, bj, At, Bt) do { __builtin_amdgcn_s_setprio(1); _Pragma("unroll") for (int m = 0; m < 4; ++m) _Pragma("unroll") for (int n = 0; n < 2; ++n) _Pragma("unroll") for (int k = 0; k < 2; ++k) \
        acc[ai][bj][m][n] = __builtin_amdgcn_mfma_f32_16x16x32_bf16(Bt[n][k], At[m][k], acc[ai][bj][m][n], 0, 0, 0); __builtin_amdgcn_s_setprio(0); } while (0)
#define PG8_WAIT_V(n) asm volatile("s_waitcnt vmcnt(" #n ")" ::: "memory")
#define PG8_WAIT_L(n) asm volatile("s_waitcnt lgkmcnt(" #n ")" ::: "memory")
#define PG8_BAR __builtin_amdgcn_s_barrier()
#define PG8_SCHED __builtin_amdgcn_sched_barrier(0)
    Unit cur, nxt; int ui = 0;
    if (!S.next(0, cur)) return false;
    bool cont_done = false;
    f32x4 acc[2][2][4][2];
#pragma unroll
    for (int a = 0; a < 2; ++a)
#pragma unroll
        for (int b = 0; b < 2; ++b)
#pragma unroll
            for (int m = 0; m < 4; ++m)
#pragma unroll
                for (int n = 0; n < 2; ++n) acc[a][b][m][n] = (f32x4){0.f, 0.f, 0.f, 0.f};
    bf16x8 At[4][2], B0[2][2], B1[2][2];
    const char* cA; if constexpr (GATHER) cA = S.gbase; else cA = cur.a;
    const char* cB = cur.b;
    PG8_LOAD_OG(ogc, cur);
    if constexpr (GATHER) { asm volatile("s_waitcnt vmcnt(0)" : "+v"(ogc[0]), "+v"(ogc[1]) :: "memory"); ogc[0] = PG8_MASK_OG(ogc[0], cur.u3, 0); ogc[1] = PG8_MASK_OG(ogc[1], cur.u3, 1); }
    if constexpr (STAGGER) { const int stag = ((int)blockIdx.x >> 3) & 3; for (int i = 0; i < stag; ++i) __builtin_amdgcn_s_sleep(45); }
    if (!prestaged) {
    PG8_STAGE(PG8_SB(0, 0), cB, voffB); PG8_STAGE(PG8_SB(0, 1), cB + hstepB, voffB); PG8_STAGE_A(PG8_SA(0, 0), cA, 0, false); PG8_STAGE_A(PG8_SA(0, 1), cA, 1, false);
    PG8_STAGE(PG8_SB(1, 0), cB + kstep, voffB); PG8_STAGE_A(PG8_SA(1, 0), cA + kstep, 0, false); PG8_STAGE(PG8_SB(1, 1), cB + hstepB + kstep, voffB); }
    if (wr == 1) PG8_BAR;
    PG8_WAIT_V(8); PG8_BAR;
    PG8_WAIT_V(6); PG8_BAR;
    for (;;) {
        if constexpr (Epi::PRE) { cur.u3 = ui & 1; E.pre(cur, lds + EPI_SLOT_OFF + (ui & 1) * EPI_SLOT_BYTES, wid); }
        const bool has_next = S.next(ui + 1, nxt);
        const char* nA; if constexpr (GATHER) nA = cA; else nA = has_next ? nxt.a : cA;
        const char* nB = has_next ? nxt.b : cB;
        const bool use_cont = !GATHER && !has_next && cont.a != nullptr;
        if constexpr (GATHER) { if (has_next) { PG8_LOAD_OG(ogn, nxt); } else { ogn[0] = ogc[0]; ogn[1] = ogc[1]; } }
#pragma unroll 1
        for (int t = 0; t < nt; t += 2) {
            const bool last = (t == nt - 2);
            if constexpr (Epi::KSCALE) { if (t != 0 && (t & 7) == 0) E.kscale(acc, wr, (t >> 3) - 1, lds + EPI_SLOT_OFF + cur.u3 * EPI_SLOT_BYTES); }
            const char* a1 = cA + (size_t)(t + 1) * kstep;
            PG8_LDB(B0, 0, 0); PG8_LDB(B1, 0, 1); PG8_SCHED; PG8_LDA(At, 0, 0); PG8_STAGE_A(PG8_SA(1, 1), a1, 1, false);
            if (last && use_cont) {
                const int tid2 = wid * 64 + lane_id_asm();
#pragma unroll
                for (int i = 0; i < 2; ++i) { int R, C; stage_rc(tid2 * 16 + i * 8192, R, C); const int Rb = Epi::PERM ? ((R & ~31) + perm32(R & 31)) : R;
                    voffA[i] = (unsigned)(R * cont.lda + C) * 2u; voffB[i] = (unsigned)(Rb * cont.ldb + C) * 2u; }
                hstepA = (size_t)HALF * cont.lda * 2; hstepB = (size_t)HALF * cont.ldb * 2; nA = cont.a; nB = cont.b; cont_done = true; }
            const char* a2 = last ? nA : cA + (size_t)(t + 2) * kstep; const char* b2 = last ? nB : cB + (size_t)(t + 2) * kstep;
            const char* a3 = a2 + kstep; const char* b3 = b2 + kstep;
            PG8_WAIT_V(8); PG8_WAIT_L(0); PG8_BAR; PG8_MMA(0, 0, At, B0); PG8_MMA(0, 1, At, B1); PG8_BAR; PG8_SCHED;
            PG8_LDA(At, 0, 1); PG8_STAGE(PG8_SB(0, 0), b2, voffB); PG8_STAGE(PG8_SB(0, 1), b2 + hstepB, voffB); PG8_STAGE_A(PG8_SA(0, 0), a2, 0, last);
            PG8_WAIT_V(8); PG8_WAIT_L(0); PG8_BAR; PG8_MMA(1, 0, At, B0); PG8_MMA(1, 1, At, B1); PG8_BAR; PG8_SCHED;
            PG8_LDB(B0, 1, 0); PG8_LDB(B1, 1, 1); PG8_SCHED; PG8_LDA(At, 1, 0); PG8_STAGE_A(PG8_SA(0, 1), a2, 1, last);
            PG8_WAIT_V(8); PG8_WAIT_L(0); PG8_BAR; PG8_MMA(0, 0, At, B0); PG8_MMA(0, 1, At, B1); PG8_BAR; PG8_SCHED;
            PG8_LDA(At, 1, 1); PG8_STAGE(PG8_SB(1, 0), b3, voffB); PG8_STAGE(PG8_SB(1, 1), b3 + hstepB, voffB); PG8_STAGE_A(PG8_SA(1, 0), a3, 0, last);
            PG8_WAIT_V(8); PG8_WAIT_L(0); PG8_BAR; PG8_MMA(1, 0, At, B0); PG8_MMA(1, 1, At, B1); PG8_BAR; PG8_SCHED;
        }
        if (wr == 0) PG8_BAR;
        { const int l_e = lane_id_asm(); int wr_e = wr, wc_e = wc, fr_e = l_e & 15, fq_e = l_e >> 4; asm volatile("" : "+s"(wr_e), "+s"(wc_e));
          if constexpr (Epi::PRE) E(acc, cur, wr_e, wc_e, fr_e, fq_e, lds + EPI_SLOT_OFF + cur.u3 * EPI_SLOT_BYTES); else E(acc, cur, wr_e, wc_e, fr_e, fq_e); }
        if (!has_next) break;
#pragma unroll
        for (int a = 0; a < 2; ++a)
#pragma unroll
            for (int b = 0; b < 2; ++b)
#pragma unroll
                for (int m = 0; m < 4; ++m)
#pragma unroll
                    for (int n = 0; n < 2; ++n) acc[a][b][m][n] = (f32x4){0.f, 0.f, 0.f, 0.f};
        cur = nxt; cA = nA; cB = nB; ++ui;
        if constexpr (GATHER) { ogc[0] = PG8_MASK_OG(ogn[0], cur.u3, 0); ogc[1] = PG8_MASK_OG(ogn[1], cur.u3, 1); }
        if (wr == 1) PG8_BAR;
    }
    PG8_WAIT_V(0);
    PG8_BAR;
    return cont_done;
#undef PG8_SA
#undef PG8_SB
#undef PG8_STAGE
#undef PG8_STAGE_A
#undef PG8_LOAD_OG
#undef PG8_MASK_OG
#undef PG8_LDA
#undef PG8_LDB
#undef PG8_MMA
#undef PG8_WAIT_V
#undef PG8_WAIT_L
#undef PG8_BAR
#undef PG8_SCHED
}
}
constexpr size_t MiB = 1u << 20;
constexpr size_t WS_CTL = 0, CTL_ZERO_BYTES = 1 * MiB;
constexpr size_t WS_ADA = 1 * MiB;
constexpr size_t WS_TABR = WS_ADA + 512 * 1024;
constexpr size_t WS_TABM = WS_TABR + 64 * 64 * 8;
constexpr size_t WS_LG = WS_TABM + 64 * 16 * 8;
constexpr size_t WS_WIN = 2 * MiB;
constexpr int    WIN_ROWS = 8960, WIN_Q = 0, WIN_K = 1024, WIN_MLA = 2048, WIN_V = 2816, WIN_GATE = 4864, WIN_GRET = 6912, WIN_GMLA = 7936;
constexpr size_t WS_WUQ = WS_WIN + (size_t)WIN_ROWS * 1024 * 2;
constexpr size_t WS_WUKV = WS_WUQ + (size_t)1536 * 384 * 2;
constexpr size_t WS_WBR = WS_WUKV + (size_t)2048 * 256 * 2;
constexpr size_t WS_WBM = WS_WBR + (size_t)1024 * 2048 * 2;
constexpr size_t WS_WO = WS_WBM + (size_t)1024 * 1024 * 2;
constexpr size_t WS_WGU = WS_WO + (size_t)1024 * 1024 * 2;
constexpr size_t WS_WD = WS_WGU + (size_t)32 * 2048 * 1024 * 2;
constexpr size_t WS_WEND = WS_WD + (size_t)32 * 1024 * 1024 * 2;
constexpr size_t WS_ARENA = (WS_WEND + MiB - 1) / MiB * MiB;
constexpr size_t AR_H = 0;
constexpr size_t AR_MLAIN = AR_H + (size_t)TE * 1024 * 2;
constexpr size_t AR_O = AR_MLAIN + (size_t)TE * 768 * 2;
constexpr size_t AR_Q = AR_O + (size_t)TE * 2048 * 2;
constexpr size_t AR_K = AR_Q + (size_t)TE * 1024 * 2;
constexpr size_t AR_ACAT = AR_K + (size_t)TE * 1024 * 2;
constexpr size_t AR_KT2 = AR_ACAT + (size_t)TE * 3072 * 2;
constexpr size_t KT2_DIR = (size_t)NBG * 4 * NCH * 256 * 256 * 2;
constexpr size_t AR_BCAT = AR_KT2 + 2 * KT2_DIR;
constexpr size_t BCAT_CH = (size_t)512 * 768 * 2;
constexpr size_t AR_MLAN = AR_BCAT + (size_t)NBG * 4 * NCH * BCAT_CH;
constexpr size_t AR_ATTO = AR_MLAN + (size_t)TE * 640 * 2;
constexpr size_t AR_GATE = AR_ATTO + (size_t)TE * 1024 * 2;
constexpr size_t AR_SSQ = AR_GATE + (size_t)TE * 2048 * 2;
constexpr size_t AR_END1 = AR_SSQ + (size_t)TE * 32 * 4;
constexpr size_t AR_QMLA = AR_O;
constexpr size_t AR_KVMLA = AR_Q;
constexpr size_t AR_GRET = AR_KT2;
constexpr size_t AR_GMLA = AR_GRET + (size_t)TE * 1024 * 2;
constexpr size_t AR_T1 = AR_ACAT;
constexpr size_t AR_MERGED = AR_T1 + (size_t)TE * 1024 * 2;
static_assert(AR_QMLA + (size_t)TE * 1536 * 2 <= AR_Q, "q_mla over o");
static_assert(AR_KVMLA + (size_t)TE * 2048 * 2 <= AR_ACAT, "kv_mla / gate over q,k");
static_assert(AR_GMLA + (size_t)TE * 1024 * 2 <= AR_BCAT, "g over kt2");
static_assert(AR_MERGED + (size_t)TE * 1024 * 2 <= AR_KT2, "t1/merged over acat");
constexpr size_t AR_H2 = 0;
constexpr size_t AR_XS = AR_H2 + (size_t)(TLM + 8) * 1024 * 2;
constexpr size_t AR_ACT = AR_XS + (size_t)MOE_ROWS * 1024 * 2;
constexpr size_t AR_SEL = AR_ACT + (size_t)MOE_ROWS * 1024 * 2;
constexpr size_t AR_ROWG = AR_SEL + (size_t)TLM * 4 * 4 * 4;
constexpr size_t AR_ROWTOK = AR_ROWG + (size_t)NEXP * TLM * 4;
constexpr size_t AR_END2 = AR_ROWTOK + (size_t)NEXP * TLM * 2;
constexpr size_t AR_SIZE = (AR_END1 > AR_END2 ? AR_END1 : AR_END2);
constexpr size_t WS_END = WS_ARENA + AR_SIZE;
constexpr int CW_BAR = 4096;
constexpr int CW_CNT = 16384;
constexpr int CW_BBASE = 32768;

constexpr int RING_BYTES = 131072;
constexpr int MISC_OFF = RING_BYTES; static_assert(pg8::EPI_SLOT_OFF == RING_BYTES + 8192 && pg8::STAGE_BYTES == RING_BYTES && RING_BYTES + 8192 + 2 * pg8::EPI_SLOT_BYTES <= 147456, "epilogue operand slots");
constexpr int MISC_LCNT = 3072, MISC_PT = 4096;
constexpr int LDS_BYTES = 147456;

struct Params {
    const float* in[25];
    float* out;
    unsigned char* ws;
    int ph_lo, ph_hi;
};
using pg8::Unit;
__device__ __forceinline__ int lat_panel_to_ext(int pml) { return (pml >> 4) * NCH + (pml & 15) + 1; }

template <bool LAT_A, bool LAT_B>
struct Sched2D {
    const char* A; const char* B; size_t sa, sb; int nM, nN, G, c, n0 = 0;
    __device__ __forceinline__ bool next(int i, Unit& u) const {
        const int L = i * G + c; if (L >= nM * nN) return false;
        int pm, pn; pg8::tile2d(L, nM, nN, pm, pn); pn += n0;
        const int am = LAT_A ? lat_panel_to_ext(pm) : pm, bn = LAT_B ? lat_panel_to_ext(pn) : pn;
        u.a = A + (size_t)am * sa; u.b = B + (size_t)bn * sb; u.u0 = am; u.u1 = bn; u.u2 = 0; u.u3 = 0; return true;
    }
};

struct EpiGA {
    static constexpr bool PERM = true; static constexpr bool PRE = false, KSCALE = false;
    bf16 *q, *k, *acat, *mlain; const float2* tabr; const float2* tabm; const float* lg; float* ssqm;
    __device__ __forceinline__ void operator()(const f32x4 (&acc)[2][2][4][2], const Unit& u, int wr, int wc, int fr, int fq) const {
        const int pm = u.u0, pn = u.u1;
        if (pn < 8) {
            const int h = pn & 3; const bool isq = pn < 4;
            const float lgf = lg[h], lgb = lg[4 + h];
#pragma unroll
            for (int ai = 0; ai < 2; ++ai) { f32x4 csa[4][2][2];
#pragma unroll
                for (int m = 0; m < 4; ++m) { const int r = pm * 256 + ai * 128 + wr * 64 + m * 16 + fr; const int p = r % LE; const int t = p >= CTX ? p - CTX : 0;
#pragma unroll
                    for (int bj = 0; bj < 2; ++bj) { const int pos = bj == 0 ? (t >> 6) : (t & 63); const f32x4* tp = (const f32x4*)(tabr + pos * 64 + 16 * wc + 4 * fq); csa[m][bj][0] = tp[0]; csa[m][bj][1] = tp[1]; } }
#pragma unroll
                for (int m = 0; m < 4; ++m) {
                    const int r = pm * 256 + ai * 128 + wr * 64 + m * 16 + fr;
                    const int p = r % LE; const bool lat = p >= CTX;
                    const int iloc = p & 255;
                    const float sf = isq ? __builtin_amdgcn_exp2f(lgf * (float)(iloc + 1)) : 0.0625f;
                    const float sb = __builtin_amdgcn_exp2f(lgb * (float)(256 - iloc));
#pragma unroll
                    for (int bj = 0; bj < 2; ++bj) {
                        f32x4 cs0 = csa[m][bj][0], cs1 = csa[m][bj][1];
                        if (!lat) { cs0 = (f32x4){1.f, 0.f, 1.f, 0.f}; cs1 = cs0; }
                        const f32x4 v0 = acc[ai][bj][m][0], v1 = acc[ai][bj][m][1];
                        float o[8];
                        o[0] = v0[0] * cs0[0] - v0[1] * cs0[1]; o[1] = v0[0] * cs0[1] + v0[1] * cs0[0];
                        o[2] = v0[2] * cs0[2] - v0[3] * cs0[3]; o[3] = v0[2] * cs0[3] + v0[3] * cs0[2];
                        o[4] = v1[0] * cs1[0] - v1[1] * cs1[1]; o[5] = v1[0] * cs1[1] + v1[1] * cs1[0];
                        o[6] = v1[2] * cs1[2] - v1[3] * cs1[3]; o[7] = v1[2] * cs1[3] + v1[3] * cs1[2];
                        const int col = bj * 128 + wc * 32 + 8 * fq;
                        if (isq) {
                            v4u w; w.x = cvt_pk_bf16(o[0], o[1]); w.y = cvt_pk_bf16(o[2], o[3]); w.z = cvt_pk_bf16(o[4], o[5]); w.w = cvt_pk_bf16(o[6], o[7]);
                            *(v4u*)(q + (size_t)r * 1024 + h * 256 + col) = w;
                            v4u wf; wf.x = cvt_pk_bf16(o[0] * sf, o[1] * sf); wf.y = cvt_pk_bf16(o[2] * sf, o[3] * sf); wf.z = cvt_pk_bf16(o[4] * sf, o[5] * sf); wf.w = cvt_pk_bf16(o[6] * sf, o[7] * sf);
                            *(v4u*)(acat + (size_t)r * 3072 + h * 768 + 256 + col) = wf;
                            v4u wb; wb.x = cvt_pk_bf16(o[0] * sb, o[1] * sb); wb.y = cvt_pk_bf16(o[2] * sb, o[3] * sb); wb.z = cvt_pk_bf16(o[4] * sb, o[5] * sb); wb.w = cvt_pk_bf16(o[6] * sb, o[7] * sb);
                            *(v4u*)(acat + (size_t)r * 3072 + h * 768 + 512 + col) = wb;
                        } else {
                            v4u w; w.x = cvt_pk_bf16(o[0] * sf, o[1] * sf); w.y = cvt_pk_bf16(o[2] * sf, o[3] * sf); w.z = cvt_pk_bf16(o[4] * sf, o[5] * sf); w.w = cvt_pk_bf16(o[6] * sf, o[7] * sf);
                            *(v4u*)(k + (size_t)r * 1024 + h * 256 + col) = w;
                        }
                    }
                } }
        } else {
            const int c0 = (pn - 8) * 256;
#pragma unroll
            for (int ai = 0; ai < 2; ++ai)
#pragma unroll
                for (int m = 0; m < 4; ++m) {
                    const int r = pm * 256 + ai * 128 + wr * 64 + m * 16 + fr;
                    const int p = r % LE; const bool lat = p >= CTX; const int t = lat ? p - CTX : 0;
#pragma unroll
                    for (int bj = 0; bj < 2; ++bj) {
                        const int col = c0 + bj * 128 + wc * 32 + 8 * fq;
                        const f32x4 v0 = acc[ai][bj][m][0], v1 = acc[ai][bj][m][1];
                        float o[8] = {v0[0], v0[1], v0[2], v0[3], v1[0], v1[1], v1[2], v1[3]};
                        if (col >= 640 && col < 704 && lat) {
                            const int pp0 = (col - 640) >> 1; const int pos = pp0 < 16 ? (t >> 6) : (t & 63);
                            const f32x4* tp = (const f32x4*)(tabm + pos * 16 + (pp0 & 15));
                            const f32x4 cs0 = tp[0], cs1 = tp[1];
                            o[0] = v0[0] * cs0[0] - v0[1] * cs0[1]; o[1] = v0[0] * cs0[1] + v0[1] * cs0[0];
                            o[2] = v0[2] * cs0[2] - v0[3] * cs0[3]; o[3] = v0[2] * cs0[3] + v0[3] * cs0[2];
                            o[4] = v1[0] * cs1[0] - v1[1] * cs1[1]; o[5] = v1[0] * cs1[1] + v1[1] * cs1[0];
                            o[6] = v1[2] * cs1[2] - v1[3] * cs1[3]; o[7] = v1[2] * cs1[3] + v1[3] * cs1[2];
                        }
                        v4u w; w.x = cvt_pk_bf16(o[0], o[1]); w.y = cvt_pk_bf16(o[2], o[3]); w.z = cvt_pk_bf16(o[4], o[5]); w.w = cvt_pk_bf16(o[6], o[7]);
                        *(v4u*)(mlain + (size_t)r * 768 + col) = w;
                        const int blk = (c0 >> 7) + bj;
                        if (blk < 5) { float sq = 0.f;
#pragma unroll
                            for (int x = 0; x < 8; ++x) sq += o[x] * o[x];
                            sq += SWZ_XOR(sq, 16);
                            { unsigned a_ = __builtin_bit_cast(unsigned, sq), b_ = a_; asm volatile("" : "+v"(b_));
                              auto rr = __builtin_amdgcn_permlane32_swap(a_, b_, false, false);
                              unsigned r0_ = rr[0], r1_ = rr[1]; asm volatile("" : "+v"(r0_), "+v"(r1_));
                              sq = __builtin_bit_cast(float, r0_) + __builtin_bit_cast(float, r1_); }
                            if (fq == 0) ssqm[(size_t)r * 32 + blk * 4 + wc] = sq; }
                    }
                }
        }
    }
};

struct SchedGAV { const char* H; const char* W; int G, c;
    __device__ __forceinline__ bool next(int i, Unit& u) const {
        const int L = i * G + c; int pm, pn;
        if (L < 476) { pg8::tile2d(L, TE / 256, 7, pm, pn); pn += 4; u.u2 = 0; }
        else if (L < 732) { pg8::tile2d(L - 476, TL / 256, 4, pm, pn); pm = lat_panel_to_ext(pm); u.u2 = 0; }
        else if (L < 1276) { pg8::tile2d(L - 732, 8, TE / 256, pm, pn); u.u2 = 1; }
        else return false;
        if (u.u2 == 0) { u.a = H + (size_t)pm * 256 * 1024 * 2; u.b = W + (size_t)pn * 256 * 1024 * 2; }
        else { u.a = W + (size_t)(WIN_V + pm * 256) * 1024 * 2; u.b = H + (size_t)pn * 256 * 1024 * 2; }
        u.u0 = pm; u.u1 = pn; u.u3 = 0; return true; } };

template <class Loc>
struct EpiStore {
    static constexpr bool PERM = true; static constexpr bool PRE = false, KSCALE = false;
    Loc loc;
    __device__ __forceinline__ void operator()(const f32x4 (&acc)[2][2][4][2], const Unit& u, int wr, int wc, int fr, int fq) const {
        bf16* base; int ldc; loc(u, base, ldc);
#pragma unroll
        for (int ai = 0; ai < 2; ++ai)
#pragma unroll
            for (int m = 0; m < 4; ++m) { bf16* rowp = base + (size_t)(ai * 128 + wr * 64 + m * 16 + fr) * ldc + wc * 32 + 8 * fq;
#pragma unroll
                for (int bj = 0; bj < 2; ++bj) { const f32x4 v0 = acc[ai][bj][m][0], v1 = acc[ai][bj][m][1];
                    v4u w; w.x = cvt_pk_bf16(v0[0], v0[1]); w.y = cvt_pk_bf16(v0[2], v0[3]); w.z = cvt_pk_bf16(v1[0], v1[1]); w.w = cvt_pk_bf16(v1[2], v1[3]);
                    *(v4u*)(rowp + bj * 128) = w; } }
    }
};

struct LocGV { bf16* bcat;
    __device__ __forceinline__ void operator()(const Unit& u, bf16*& base, int& ldc) const {
        const int vt = u.u0, tt = u.u1, bl = tt / NCH, e = tt % NCH, h = vt >> 1;
        base = bcat + ((size_t)((bl * 4 + h) * NCH + e) * 512 + (vt & 1) * 256) * 768; ldc = 768; } };
struct EpiGAV {
    static constexpr bool PERM = true; static constexpr bool PRE = false, KSCALE = false;
    EpiGA ga; EpiStore<LocGV> gv;
    __device__ __forceinline__ void operator()(const f32x4 (&acc)[2][2][4][2], const Unit& u, int wr, int wc, int fr, int fq) const {
        if (u.u2 == 0) ga(acc, u, wr, wc, fr, fq); else gv(acc, u, wr, wc, fr, fq); }
};
struct LocGB { bf16 *gate, *gret, *gmla;
    __device__ __forceinline__ void operator()(const Unit& u, bf16*& base, int& ldc) const {
        const int pn = u.u1; const size_t r0 = (size_t)u.u0 * 256;
        if (pn < 8) { base = gate + r0 * 2048 + pn * 256; ldc = 2048; }
        else if (pn < 12) { base = gret + r0 * 1024 + (pn - 8) * 256; ldc = 1024; }
        else { base = gmla + r0 * 1024 + (pn - 12) * 256; ldc = 1024; } } };
struct LocM3 { bf16* kv;
    __device__ __forceinline__ void operator()(const Unit& u, bf16*& base, int& ldc) const { base = kv + (size_t)u.u0 * 256 * 2048 + u.u1 * 256; ldc = 2048; } };

struct EpiM2 {
    static constexpr bool PERM = true; static constexpr bool PRE = true, KSCALE = false;
    bf16* qm; const float2* tabm; const float* ssqm;
    __device__ __forceinline__ void pre(const Unit& u, LAS unsigned char* slot, int wid) const {
        if (wid < 4) { const int rl = wid * 64 + lane_id_asm(); const float* p = ssqm + ((size_t)u.u0 * 256 + rl) * 32;
            const f32x4 a = *(const f32x4*)p, b = *(const f32x4*)(p + 4), c = *(const f32x4*)(p + 8);
            ((LAS float*)slot)[rl] = 1.0f / sqrtf(((((a.x + a.y) + (a.z + a.w)) + ((b.x + b.y) + (b.z + b.w))) + ((c.x + c.y) + (c.z + c.w))) * (1.f / 384.f) + EPS); } }
    __device__ __forceinline__ void operator()(const f32x4 (&acc)[2][2][4][2], const Unit& u, int wr, int wc, int fr, int fq, const LAS unsigned char* slot) const {
        const int pm = u.u0, pn = u.u1;
#pragma unroll
        for (int ai = 0; ai < 2; ++ai) { f32x4 csa[4][2][2];
#pragma unroll
            for (int m = 0; m < 4; ++m) { const int r = pm * 256 + ai * 128 + wr * 64 + m * 16 + fr; const int p = r % LE; const int t = p >= CTX ? p - CTX : 0;
#pragma unroll
                for (int bj = 0; bj < 2; ++bj) { const int jj = (pn * 256 + bj * 128 + wc * 32 + 8 * fq) % 192; const int pp0 = (jj >= 128 ? jj - 128 : 0) >> 1; const int pos = pp0 < 16 ? (t >> 6) : (t & 63);
                    const f32x4* tp = (const f32x4*)(tabm + pos * 16 + (pp0 & 15)); csa[m][bj][0] = tp[0]; csa[m][bj][1] = tp[1]; } }
#pragma unroll
            for (int m = 0; m < 4; ++m) {
                const int r = pm * 256 + ai * 128 + wr * 64 + m * 16 + fr;
                const int p = r % LE; const bool lat = p >= CTX;
#pragma unroll
                for (int bj = 0; bj < 2; ++bj) {
                    const int col = pn * 256 + bj * 128 + wc * 32 + 8 * fq; const int jj = col % 192;
                    const float rs = ((const LAS float*)slot)[ai * 128 + wr * 64 + m * 16 + fr];
                    const f32x4 v0 = acc[ai][bj][m][0] * rs, v1 = acc[ai][bj][m][1] * rs;
                    float o[8] = {v0[0], v0[1], v0[2], v0[3], v1[0], v1[1], v1[2], v1[3]};
                    if (jj >= 128 && lat) {
                        const f32x4 cs0 = csa[m][bj][0], cs1 = csa[m][bj][1];
                        o[0] = v0[0] * cs0[0] - v0[1] * cs0[1]; o[1] = v0[0] * cs0[1] + v0[1] * cs0[0];
                        o[2] = v0[2] * cs0[2] - v0[3] * cs0[3]; o[3] = v0[2] * cs0[3] + v0[3] * cs0[2];
                        o[4] = v1[0] * cs1[0] - v1[1] * cs1[1]; o[5] = v1[0] * cs1[1] + v1[1] * cs1[0];
                        o[6] = v1[2] * cs1[2] - v1[3] * cs1[3]; o[7] = v1[2] * cs1[3] + v1[3] * cs1[2];
                    }
                    v4u w; w.x = cvt_pk_bf16(o[0], o[1]); w.y = cvt_pk_bf16(o[2], o[3]); w.z = cvt_pk_bf16(o[4], o[5]); w.w = cvt_pk_bf16(o[6], o[7]);
                    *(v4u*)(qm + (size_t)r * 1536 + col) = w;
                }
            } }
    }
};

struct EpiM3 {
    static constexpr bool PERM = true; static constexpr bool PRE = true, KSCALE = false;
    bf16* kv; const float* ssqm;
    __device__ __forceinline__ void pre(const Unit& u, LAS unsigned char* slot, int wid) const {
        if (wid < 4) { const int rl = wid * 64 + lane_id_asm(); const float* p = ssqm + ((size_t)u.u0 * 256 + rl) * 32 + 12;
            const f32x4 a = *(const f32x4*)p, b = *(const f32x4*)(p + 4);
            ((LAS float*)slot)[rl] = 1.0f / sqrtf((((a.x + a.y) + (a.z + a.w)) + ((b.x + b.y) + (b.z + b.w))) * (1.f / 256.f) + EPS); } }
    __device__ __forceinline__ void operator()(const f32x4 (&acc)[2][2][4][2], const Unit& u, int wr, int wc, int fr, int fq, const LAS unsigned char* slot) const {
        bf16* base = kv + (size_t)u.u0 * 256 * 2048 + u.u1 * 256;
#pragma unroll
        for (int ai = 0; ai < 2; ++ai)
#pragma unroll
            for (int m = 0; m < 4; ++m) { const int rl = ai * 128 + wr * 64 + m * 16 + fr; const float rs = ((const LAS float*)slot)[rl]; bf16* rowp = base + (size_t)rl * 2048 + wc * 32 + 8 * fq;
#pragma unroll
                for (int bj = 0; bj < 2; ++bj) { const f32x4 v0 = acc[ai][bj][m][0] * rs, v1 = acc[ai][bj][m][1] * rs;
                    v4u w; w.x = cvt_pk_bf16(v0[0], v0[1]); w.y = cvt_pk_bf16(v0[2], v0[3]); w.z = cvt_pk_bf16(v1[0], v1[1]); w.w = cvt_pk_bf16(v1[2], v1[3]);
                    *(v4u*)(rowp + bj * 128) = w; } }
    }
};

struct SchedRT4 { const char* q; const char* k; int G, c;
    __device__ __forceinline__ bool next(int i, Unit& u) const {
        const int L = i * G + c; if (L >= NBG * 4 * 16) return false;
        const int e = (L & 15) + 1, h = (L >> 4) & 3, bl = L >> 6; const size_t r0 = (size_t)bl * LE + e * 256;
        u.a = q + (r0 * 1024 + h * 256) * 2; u.b = k + (r0 * 1024 + h * 256) * 2; u.u0 = (int)r0; u.u1 = h; u.u2 = 0; u.u3 = 0; return true; } };
struct EpiRT4 {
    static constexpr bool PERM = true; static constexpr bool PRE = false, KSCALE = false;
    bf16* acat; const float* lg;
    __device__ __forceinline__ void operator()(const f32x4 (&acc)[2][2][4][2], const Unit& u, int wr, int wc, int fr, int fq) const {
        const int r0 = u.u0, h = u.u1; const float lgf = lg[h], lgb = lg[4 + h];
#pragma unroll
        for (int ai = 0; ai < 2; ++ai)
#pragma unroll
            for (int m = 0; m < 4; ++m) { const int i = ai * 128 + wr * 64 + m * 16 + fr;
#pragma unroll
                for (int bj = 0; bj < 2; ++bj) { const int j0 = bj * 128 + wc * 32 + 8 * fq;
                    const f32x4 v0 = acc[ai][bj][m][0], v1 = acc[ai][bj][m][1];
                    float o[8] = {v0[0], v0[1], v0[2], v0[3], v1[0], v1[1], v1[2], v1[3]};
#pragma unroll
                    for (int x = 0; x < 8; ++x) { const int d = i - (j0 + x); const float e2 = d >= 0 ? lgf * (float)d : lgb * (float)(-d); o[x] *= __builtin_amdgcn_exp2f(e2); }
                    v4u w; w.x = cvt_pk_bf16(o[0], o[1]); w.y = cvt_pk_bf16(o[2], o[3]); w.z = cvt_pk_bf16(o[4], o[5]); w.w = cvt_pk_bf16(o[6], o[7]);
                    *(v4u*)(acat + (size_t)(r0 + i) * 3072 + h * 768 + j0) = w; } }
    }
};
struct SchedRT2 { const char* bcat; const char* kt2; int G, c;
    __device__ __forceinline__ bool next(int i, Unit& u) const {
        int L = i * G + c; if (L >= NBG * 4 * 2 * 16 * 2) return false;
        if (G == 256) L = i * 256 + (c & 7) * 32 + (c >> 3);
        const int s6 = L & 63, bh = L >> 6, h = bh & 3, bl = bh >> 2; int es, dir, pm = s6 & 1;
        if (s6 < 4) { es = 0; dir = s6 >> 1; } else if (s6 < 6) { es = 1; dir = 0; } else if (s6 < 62) { const int t = s6 - 6; es = 2 + (t >> 2); dir = (t >> 1) & 1; } else { es = 16; dir = 1; }
        const int ed = dir == 0 ? es + 1 : (es == 0 ? 16 : es - 1);
        const int ch = (bl * 4 + h) * NCH;
        u.a = bcat + (size_t)(ch + es) * BCAT_CH + (size_t)pm * 256 * 768 * 2;
        u.b = kt2 + (size_t)dir * KT2_DIR + (size_t)(ch + es) * 131072;
        u.u0 = ch + ed; u.u1 = pm; u.u2 = dir; u.u3 = 0; return true; } };
struct LocRT2 { bf16* bcat;
    __device__ __forceinline__ void operator()(const Unit& u, bf16*& base, int& ldc) const {
        base = bcat + ((size_t)u.u0 * 512 + u.u1 * 256) * 768 + 256 + u.u2 * 256; ldc = 768; } };
struct SchedRT5 { const char* acat; const char* bcat; int G, c;
    __device__ __forceinline__ bool next(int i, Unit& u) const {
        int L = i * G + c; if (L >= NBG * 4 * 16 * 2) return false;
        if (G == 256) { const int xcd = c & 7, slot = c >> 3; L = ((i * 128 + xcd * 16 + (slot >> 1)) << 1) | (slot & 1); }
        const int pn = L & 1, idx = L >> 1, e = (idx & 15) + 1, h = (idx >> 4) & 3, bl = idx >> 6; const size_t r0 = (size_t)bl * LE + e * 256;
        u.a = acat + (r0 * 3072 + h * 768) * 2; u.b = bcat + (size_t)((bl * 4 + h) * NCH + e) * BCAT_CH + (size_t)pn * 256 * 768 * 2;
        u.u0 = (int)r0; u.u1 = h * 512 + pn * 256; u.u2 = 0; u.u3 = 0; return true; } };
struct LocRT5 { bf16* o;
    __device__ __forceinline__ void operator()(const Unit& u, bf16*& base, int& ldc) const { base = o + (size_t)u.u0 * 2048 + u.u1; ldc = 2048; } };

struct EpiRT5F {
    static constexpr bool PERM = true; static constexpr bool PRE = false, KSCALE = false;
    bf16* o; const bf16* gate; float* ssq;
    __device__ __forceinline__ void operator()(const f32x4 (&acc)[2][2][4][2], const Unit& u, int wr, int wc, int fr, int fq) const {
        const int pidx = (u.u1 >> 8) * 4 + wc;
        v4u gwa[2][4][2];
#pragma unroll
        for (int ai = 0; ai < 2; ++ai)
#pragma unroll
            for (int m = 0; m < 4; ++m) { const size_t off = ((size_t)u.u0 + ai * 128 + wr * 64 + m * 16 + fr) * 2048 + u.u1 + wc * 32 + 8 * fq;
#pragma unroll
                for (int bj = 0; bj < 2; ++bj) gwa[ai][m][bj] = *(const v4u*)(gate + off + bj * 128); }
#pragma unroll
        for (int ai = 0; ai < 2; ++ai)
#pragma unroll
            for (int m = 0; m < 4; ++m) { const size_t row = (size_t)u.u0 + ai * 128 + wr * 64 + m * 16 + fr; const size_t off = row * 2048 + u.u1 + wc * 32 + 8 * fq;
                f32x2 s2 = {0.f, 0.f};
#pragma unroll
                for (int bj = 0; bj < 2; ++bj) { const f32x4 v0 = acc[ai][bj][m][0], v1 = acc[ai][bj][m][1];
                    const v4u gw = gwa[ai][m][bj];
                    const f32x2 vv[4] = {(f32x2){v0[0], v0[1]}, (f32x2){v0[2], v0[3]}, (f32x2){v1[0], v1[1]}, (f32x2){v1[2], v1[3]}}; const unsigned gd[4] = {gw.x, gw.y, gw.z, gw.w};
                    unsigned wv[4];
#pragma unroll
                    for (int q = 0; q < 4; ++q) { const f32x2 g2 = bf2x2(gd[q]); s2 += vv[q] * vv[q]; const f32x2 og = vv[q] * (g2 * sig2(g2)); wv[q] = cvt_pk_bf16(og.x, og.y); }
                    v4u w; w.x = wv[0]; w.y = wv[1]; w.z = wv[2]; w.w = wv[3];
                    *(v4u*)(o + off + bj * 128) = w; }
                float s = s2.x + s2.y;
                s += SWZ_XOR(s, 16);
                { unsigned a_ = __builtin_bit_cast(unsigned, s), b_ = a_; asm volatile("" : "+v"(b_));
                  auto rr = __builtin_amdgcn_permlane32_swap(a_, b_, false, false);
                  unsigned r0_ = rr[0], r1_ = rr[1]; asm volatile("" : "+v"(r0_), "+v"(r1_));
                  s = __builtin_bit_cast(float, r0_) + __builtin_bit_cast(float, r1_); }
                if (fq == 0) ssq[row * 32 + pidx] = s; }
    }
};
struct EpiG1 {
    static constexpr bool PERM = true; static constexpr bool PRE = true, KSCALE = true;
    const bf16* g; bf16* out; const float* ssq;
    __device__ __forceinline__ void pre(const Unit& u, LAS unsigned char* slot, int wid) const {
        if (wid < 4) { const int rl = wid * 64 + lane_id_asm(); const float* p = ssq + ((size_t)u.u0 * 256 + rl) * 32; float rs[4];
#pragma unroll
            for (int h = 0; h < 4; ++h) { const f32x4 a = *(const f32x4*)(p + h * 8), b = *(const f32x4*)(p + h * 8 + 4);
                rs[h] = 1.0f / sqrtf((((a.x + a.y) + (a.z + a.w)) + ((b.x + b.y) + (b.z + b.w))) * (1.f / 512.f) + EPS); }
            *(LAS f32x4*)(slot + rl * 16) = (f32x4){rs[0] / rs[1], rs[1] / rs[2], rs[2] / rs[3], rs[3]}; } }
    __device__ __forceinline__ void kscale(f32x4 (&acc)[2][2][4][2], int wr, int hidx, const LAS unsigned char* slot) const {
        const int fr = lane_id_asm() & 15; const LAS float* f = (const LAS float*)slot + hidx;
#pragma unroll
        for (int ai = 0; ai < 2; ++ai)
#pragma unroll
            for (int m = 0; m < 4; ++m) { const float sc = f[(ai * 128 + wr * 64 + m * 16 + fr) * 4];
#pragma unroll
                for (int bj = 0; bj < 2; ++bj)
#pragma unroll
                    for (int n = 0; n < 2; ++n) acc[ai][bj][m][n] *= sc; } }
    __device__ __forceinline__ void operator()(const f32x4 (&acc)[2][2][4][2], const Unit& u, int wr, int wc, int fr, int fq, const LAS unsigned char* slot) const {
        const LAS float* f = (const LAS float*)slot + 3;
        v4u gwa[2][4][2];
#pragma unroll
        for (int ai = 0; ai < 2; ++ai)
#pragma unroll
            for (int m = 0; m < 4; ++m) { const size_t off = (size_t)(u.u0 * 256 + ai * 128 + wr * 64 + m * 16 + fr) * 1024 + u.u1 * 256 + wc * 32 + 8 * fq;
#pragma unroll
                for (int bj = 0; bj < 2; ++bj) gwa[ai][m][bj] = *(const v4u*)(g + off + bj * 128); }
#pragma unroll
        for (int ai = 0; ai < 2; ++ai)
#pragma unroll
            for (int m = 0; m < 4; ++m) { const int rl = ai * 128 + wr * 64 + m * 16 + fr; const float sc = f[rl * 4];
                const size_t off = (size_t)(u.u0 * 256 + rl) * 1024 + u.u1 * 256 + wc * 32 + 8 * fq;
#pragma unroll
                for (int bj = 0; bj < 2; ++bj) { const f32x4 v0 = acc[ai][bj][m][0] * sc, v1 = acc[ai][bj][m][1] * sc;
                    const v4u gw = gwa[ai][m][bj];
                    const f32x2 o0 = (f32x2){v0[0], v0[1]} * sig2(bf2x2(gw.x)), o1 = (f32x2){v0[2], v0[3]} * sig2(bf2x2(gw.y)), o2 = (f32x2){v1[0], v1[1]} * sig2(bf2x2(gw.z)), o3 = (f32x2){v1[2], v1[3]} * sig2(bf2x2(gw.w));
                    v4u w; w.x = cvt_pk_bf16(o0.x, o0.y); w.y = cvt_pk_bf16(o1.x, o1.y); w.z = cvt_pk_bf16(o2.x, o2.y); w.w = cvt_pk_bf16(o3.x, o3.y);
                    *(v4u*)(out + off + bj * 128) = w; } }
    }
};

template <bool ADD>
struct EpiGate {
    static constexpr bool PERM = true; static constexpr bool PRE = false, KSCALE = false;
    const bf16* g; const bf16* prev; bf16* out;
    __device__ __forceinline__ void operator()(const f32x4 (&acc)[2][2][4][2], const Unit& u, int wr, int wc, int fr, int fq) const {
#pragma unroll
        for (int ai = 0; ai < 2; ++ai) { v4u gwa[4][2], pwa[4][2];
#pragma unroll
            for (int m = 0; m < 4; ++m) { const size_t off = (size_t)(u.u0 * 256 + ai * 128 + wr * 64 + m * 16 + fr) * 1024 + u.u1 * 256 + wc * 32 + 8 * fq;
#pragma unroll
                for (int bj = 0; bj < 2; ++bj) { gwa[m][bj] = *(const v4u*)(g + off + bj * 128); if (ADD) pwa[m][bj] = *(const v4u*)(prev + off + bj * 128); } }
#pragma unroll
            for (int m = 0; m < 4; ++m) { const size_t off = (size_t)(u.u0 * 256 + ai * 128 + wr * 64 + m * 16 + fr) * 1024 + u.u1 * 256 + wc * 32 + 8 * fq;
#pragma unroll
                for (int bj = 0; bj < 2; ++bj) { const f32x4 v0 = acc[ai][bj][m][0], v1 = acc[ai][bj][m][1];
                    const v4u gw = gwa[m][bj];
                    f32x2 o0 = (f32x2){v0[0], v0[1]} * sig2(bf2x2(gw.x)), o1 = (f32x2){v0[2], v0[3]} * sig2(bf2x2(gw.y)), o2 = (f32x2){v1[0], v1[1]} * sig2(bf2x2(gw.z)), o3 = (f32x2){v1[2], v1[3]} * sig2(bf2x2(gw.w));
                    if (ADD) { const v4u pw = pwa[m][bj]; o0 += bf2x2(pw.x); o1 += bf2x2(pw.y); o2 += bf2x2(pw.z); o3 += bf2x2(pw.w); }
                    v4u w; w.x = cvt_pk_bf16(o0.x, o0.y); w.y = cvt_pk_bf16(o1.x, o1.y); w.z = cvt_pk_bf16(o2.x, o2.y); w.w = cvt_pk_bf16(o3.x, o3.y);
                    *(v4u*)(out + off + bj * 128) = w; } } }
    }
};
struct EpiG3 {
    static constexpr bool PERM = true; static constexpr bool PRE = false, KSCALE = false;
    const float* x; const float* ada; float* out; int g0;
    __device__ __forceinline__ void operator()(const f32x4 (&acc)[2][2][4][2], const Unit& u, int wr, int wc, int fr, int fq) const {
        const int pe = u.u0, bl = pe / NCH, e = pe % NCH, b = g0 + bl;
        const float* gv = ada + (size_t)b * 6144 + 2048 + u.u1 * 256 + wc * 32 + 8 * fq;
        f32x4 gt[2][2];
#pragma unroll
        for (int bj = 0; bj < 2; ++bj)
#pragma unroll
            for (int n = 0; n < 2; ++n) gt[bj][n] = *(const f32x4*)(gv + bj * 128 + n * 4);
#pragma unroll
        for (int ai = 0; ai < 2; ++ai) { f32x4 xa[4][2][2];
#pragma unroll
            for (int m = 0; m < 4; ++m) { const size_t tok = (size_t)b * SEQ + (e - 1) * 256 + ai * 128 + wr * 64 + m * 16 + fr; const int col = u.u1 * 256 + wc * 32 + 8 * fq;
#pragma unroll
                for (int bj = 0; bj < 2; ++bj) { const float* xp = x + tok * 1024 + col + bj * 128; xa[m][bj][0] = *(const f32x4*)xp; xa[m][bj][1] = *(const f32x4*)(xp + 4); } }
#pragma unroll
            for (int m = 0; m < 4; ++m) { const size_t tok = (size_t)b * SEQ + (e - 1) * 256 + ai * 128 + wr * 64 + m * 16 + fr;
                const int col = u.u1 * 256 + wc * 32 + 8 * fq;
#pragma unroll
                for (int bj = 0; bj < 2; ++bj) {
                    const f32x4 v0 = xa[m][bj][0] + gt[bj][0] * acc[ai][bj][m][0], v1 = xa[m][bj][1] + gt[bj][1] * acc[ai][bj][m][1];
                    v4u w; w.x = cvt_pk_bf16(v0[0], v0[1]); w.y = cvt_pk_bf16(v0[2], v0[3]); w.z = cvt_pk_bf16(v1[0], v1[1]); w.w = cvt_pk_bf16(v1[2], v1[3]);
                    *(v4u*)((bf16*)(out + tok * 1024) + col + bj * 128) = w; } } }
    }
};

template <int NT>
struct SchedMoE { const char* A; const char* W; size_t wexp; const volatile LAS int* ptab; int npan, G, c;
    __device__ __forceinline__ bool next(int i, Unit& u) const {
        const int L = i * G + c; if (L >= npan * NT) return false;
        int pm, pn; pg8::tile2d(L, npan, NT, pm, pn);
        const int e = ptab[pm]; const int pl = pm - ptab[e - 48];
        u.a = A + (size_t)pm * 256 * 1024 * 2; u.b = W + (size_t)e * wexp + (size_t)pn * 256 * 1024 * 2; u.u0 = pm; u.u1 = pn; u.u2 = e; u.u3 = ptab[608 + e] - pl * 256; u.u4 = e * TLM + pl * 256; return true; } };
struct SchedMoEG { const char* gbase; const unsigned short* rowtok; const char* W; size_t wexp; const volatile LAS int* ptab; int npan, G, c, zrow;
    __device__ __forceinline__ bool next(int i, Unit& u) const {
        const int L = i * G + c; if (L >= npan * 8) return false;
        int pm, pn; pg8::tile2d(L, npan, 8, pm, pn);
        const int e = ptab[pm]; const int pl = pm - ptab[e - 48];
        u.a = gbase; u.b = W + (size_t)e * wexp + (size_t)pn * 256 * 1024 * 2; u.u0 = pm; u.u1 = pn; u.u2 = e; u.u3 = ptab[608 + e] - pl * 256; u.u4 = e * TLM + pl * 256; return true; } };
struct EpiE3 {
    static constexpr bool PERM = true; static constexpr bool PRE = false, KSCALE = false;
    bf16* act; const float* bgu;
    __device__ __forceinline__ void operator()(const f32x4 (&acc)[2][2][4][2], const Unit& u, int wr, int wc, int fr, int fq) const {
        const int jj = u.u1 * 128 + wc * 32 + 8 * fq; const float* bp = bgu + (size_t)u.u2 * 2048 + jj;
        const f32x4 bg0 = *(const f32x4*)bp, bg1 = *(const f32x4*)(bp + 4), bu0 = *(const f32x4*)(bp + 1024), bu1 = *(const f32x4*)(bp + 1028);
#pragma unroll
        for (int ai = 0; ai < 2; ++ai)
#pragma unroll
            for (int m = 0; m < 4; ++m) { const size_t row = (size_t)u.u0 * 256 + ai * 128 + wr * 64 + m * 16 + fr;
                const f32x4 gs[2] = {acc[ai][0][m][0], acc[ai][0][m][1]}, us[2] = {acc[ai][1][m][0], acc[ai][1][m][1]}, bgs[2] = {bg0, bg1}, bus[2] = {bu0, bu1};
                unsigned wv[4];
#pragma unroll
                for (int q = 0; q < 4; ++q) { const int hx = q >> 1, x0 = (q & 1) * 2;
                    const f32x2 g2 = (f32x2){gs[hx][x0], gs[hx][x0 + 1]} + (f32x2){bgs[hx][x0], bgs[hx][x0 + 1]}, u2 = (f32x2){us[hx][x0], us[hx][x0 + 1]} + (f32x2){bus[hx][x0], bus[hx][x0 + 1]};
                    const f32x2 ga = (f32x2){fminf(g2.x, 7.f), fminf(g2.y, 7.f)}, up = (f32x2){fminf(fmaxf(u2.x, -7.f), 7.f), fminf(fmaxf(u2.y, -7.f), 7.f)};
                    const f32x2 z = ga * (f32x2){-1.702f * 1.4426950408889634f, -1.702f * 1.4426950408889634f};
                    const f32x2 den = (f32x2){__builtin_amdgcn_exp2f(z.x), __builtin_amdgcn_exp2f(z.y)} + (f32x2){1.f, 1.f};
                    const f32x2 sg = (f32x2){__builtin_amdgcn_rcpf(den.x), __builtin_amdgcn_rcpf(den.y)};
                    const f32x2 o2 = (up + (f32x2){1.f, 1.f}) * (ga * sg);
                    wv[q] = cvt_pk_bf16(o2.x, o2.y); }
                v4u w; w.x = wv[0]; w.y = wv[1]; w.z = wv[2]; w.w = wv[3];
                *(v4u*)(act + row * 1024 + jj) = w; }
    }
};
struct EpiE4 {
    static constexpr bool PERM = true; static constexpr bool PRE = false, KSCALE = false;
    bf16* ys; const float* bd; const float* rowg;
    __device__ __forceinline__ void operator()(const f32x4 (&acc)[2][2][4][2], const Unit& u, int wr, int wc, int fr, int fq) const {
        const int c0 = u.u1 * 256 + wc * 32 + 8 * fq; const float* bp = bd + (size_t)u.u2 * 1024 + c0;
        f32x4 b[2][2];
#pragma unroll
        for (int bj = 0; bj < 2; ++bj) { b[bj][0] = *(const f32x4*)(bp + bj * 128); b[bj][1] = *(const f32x4*)(bp + bj * 128 + 4); }
        float rga[2][4];
#pragma unroll
        for (int ai = 0; ai < 2; ++ai)
#pragma unroll
            for (int m = 0; m < 4; ++m) rga[ai][m] = rowg[(size_t)u.u4 + ai * 128 + wr * 64 + m * 16 + fr];
#pragma unroll
        for (int ai = 0; ai < 2; ++ai)
#pragma unroll
            for (int m = 0; m < 4; ++m) { const size_t row = (size_t)u.u0 * 256 + ai * 128 + wr * 64 + m * 16 + fr; const float rg = rga[ai][m];
#pragma unroll
                for (int bj = 0; bj < 2; ++bj) { const f32x4 v0 = (acc[ai][bj][m][0] + b[bj][0]) * rg, v1 = (acc[ai][bj][m][1] + b[bj][1]) * rg;
                    v4u w; w.x = cvt_pk_bf16(v0[0], v0[1]); w.y = cvt_pk_bf16(v0[2], v0[3]); w.z = cvt_pk_bf16(v1[0], v1[1]); w.w = cvt_pk_bf16(v1[2], v1[3]);
                    *(v4u*)(ys + row * 1024 + c0 + bj * 128) = w; } }
    }
};
namespace att {
constexpr int NW = 8, QBLK = 32, KVBLK = 64;
constexpr float SCALE = 0.072168783648703220f;
constexpr float THR = 8.f;
constexpr int KROWB = 384;
constexpr size_t SHM_V = KVBLK * 128 * 2, SHM_K = KVBLK * KROWB, SHM_ATTN = 2 * SHM_V + 2 * SHM_K + NW * 64 * 4;
constexpr int OST_ROW = 72, OST_WAVE = 32 * OST_ROW * 2;
static_assert(SHM_ATTN + NW * OST_WAVE <= RING_BYTES, "attention LDS");
#define KSWZ(row, colB) ((row) * att::KROWB + ((colB) ^ (((row) & 7) << 4)))
#define SBAR() __builtin_amdgcn_sched_barrier(0)
__device__ __forceinline__ int crow(int r, int hi) { return (r & 3) + 8 * (r >> 2) + 4 * hi; }

__device__ __forceinline__ void partialSM(f32x16& p0, f32x16& p1, float& m_reg, float& mn, float& alpha) {
  constexpr float C = SCALE * 1.4426950408889634f;
  float pmax = p0[0];
#pragma unroll
  for (int r = 1; r < 16; ++r) pmax = fmaxf(pmax, p0[r]);
#pragma unroll
  for (int r = 0; r < 16; ++r) pmax = fmaxf(pmax, p1[r]);
  { unsigned a_ = __float_as_uint(pmax), b_ = a_; asm volatile("" : "+v"(b_));
    auto rr = __builtin_amdgcn_permlane32_swap(a_, b_, false, false);
    unsigned r0_ = rr[0], r1_ = rr[1]; asm volatile("" : "+v"(r0_), "+v"(r1_));
    pmax = fmaxf(__uint_as_float(r0_), __uint_as_float(r1_)); }
  if (__builtin_expect(__all(pmax - m_reg <= THR / SCALE), 1)) { mn = m_reg; alpha = 1.f; }
  else { mn = fmaxf(m_reg, pmax); alpha = __builtin_amdgcn_exp2f((m_reg - mn) * C); m_reg = mn; }
  float mnC = -mn * C;
#pragma unroll
  for (int r = 0; r < 16; ++r) p0[r] = fmaf(p0[r], C, mnC);
#pragma unroll
  for (int r = 0; r < 16; ++r) p1[r] = fmaf(p1[r], C, mnC);
#pragma unroll
  for (int r = 0; r < 16; ++r) p0[r] = __builtin_amdgcn_exp2f(p0[r]);
}
__device__ __forceinline__ void finishSM(f32x16& p0, f32x16& p1, float alpha, float& l_reg, bf16x8& pa0, bf16x8& pa1, bf16x8& pa2, bf16x8& pa3) {
#pragma unroll
  for (int r = 0; r < 16; ++r) p1[r] = __builtin_amdgcn_exp2f(p1[r]);
  float ps = 0;
#pragma unroll
  for (int r = 0; r < 16; ++r) ps += p0[r];
#pragma unroll
  for (int r = 0; r < 16; ++r) ps += p1[r];
  { unsigned a_ = __float_as_uint(ps), b_ = a_; asm volatile("" : "+v"(b_));
    auto rr = __builtin_amdgcn_permlane32_swap(a_, b_, false, false);
    unsigned r0_ = rr[0], r1_ = rr[1]; asm volatile("" : "+v"(r0_), "+v"(r1_));
    ps = __uint_as_float(r0_) + __uint_as_float(r1_); }
  l_reg = l_reg * alpha + ps;
#define PK4(P, BASE, OUT) do { unsigned a0 = cvt_pk_bf16(P[BASE + 0], P[BASE + 1]), a1 = cvt_pk_bf16(P[BASE + 2], P[BASE + 3]);   \
    unsigned b0 = cvt_pk_bf16(P[BASE + 4], P[BASE + 5]), b1 = cvt_pk_bf16(P[BASE + 6], P[BASE + 7]);                              \
    auto r0 = __builtin_amdgcn_permlane32_swap(a0, b0, false, false); auto r1 = __builtin_amdgcn_permlane32_swap(a1, b1, false, false); \
    v4u w = {r0[0], r1[0], r0[1], r1[1]}; OUT = *reinterpret_cast<bf16x8*>(&w); } while (0)
  PK4(p0, 0, pa0); PK4(p0, 8, pa1); PK4(p1, 0, pa2); PK4(p1, 8, pa3);
#undef PK4
}
__device__ __forceinline__ void qkt(f32x16& p0, f32x16& p1, const char* Ks, const bf16x8 (&qr)[12], int r32, int hi) {
  p0 = f32x16{}; p1 = f32x16{};
#pragma unroll
  for (int d0 = 0; d0 < 12; ++d0) { int cb = (d0 * 16 + hi * 8) * 2;
    bf16x8 b0 = *reinterpret_cast<const bf16x8*>(Ks + KSWZ(r32, cb));
    bf16x8 b1 = *reinterpret_cast<const bf16x8*>(Ks + KSWZ(32 + r32, cb));
    p0 = __builtin_amdgcn_mfma_f32_32x32x16_bf16(b0, qr[d0], p0, 0, 0, 0);
    p1 = __builtin_amdgcn_mfma_f32_32x32x16_bf16(b1, qr[d0], p1, 0, 0, 0); }
}
__device__ __forceinline__ int v_st(int k, int c) { const int kk = (k & ~0xC) | ((k & 4) << 1) | ((k & 8) >> 1); return ((kk >> 3) * 4 + (c >> 5)) * 512 + ((kk & 7) * 32 + (c & 31)) * 2; }
__device__ __forceinline__ int v_rd_base(int lane) { return ((lane & 3) << 3) | (((lane >> 2) & 3) << 6) | (((lane >> 4) & 1) << 5) | (((lane >> 5) & 1) << 8); }
constexpr int v_rd_off(int d0, int ks, int half) { return d0 * 512 + ks * 4096 + half * 2048; }
template <int OFF> __device__ __forceinline__ s16x4 tr_read(int vb) {
  s16x4 r; asm volatile("ds_read_b64_tr_b16 %0, %1 offset:%2" : "=&v"(r) : "v"(vb), "i"(OFF) : "memory"); return r;
}
template <int D0> __device__ __forceinline__ void pv_one(f32x16& od, int vb, bf16x8 pa0, bf16x8 pa1, bf16x8 pa2, bf16x8 pa3) {
  const s16x4 l0 = tr_read<v_rd_off(D0, 0, 0)>(vb), h0 = tr_read<v_rd_off(D0, 0, 1)>(vb), l1 = tr_read<v_rd_off(D0, 1, 0)>(vb), h1 = tr_read<v_rd_off(D0, 1, 1)>(vb);
  const s16x4 l2 = tr_read<v_rd_off(D0, 2, 0)>(vb), h2 = tr_read<v_rd_off(D0, 2, 1)>(vb), l3 = tr_read<v_rd_off(D0, 3, 0)>(vb), h3 = tr_read<v_rd_off(D0, 3, 1)>(vb);
  asm volatile("s_waitcnt lgkmcnt(0)" ::: "memory"); SBAR();
#define PK(L, H) (bf16x8){L[0], L[1], L[2], L[3], H[0], H[1], H[2], H[3]}
  od = __builtin_amdgcn_mfma_f32_32x32x16_bf16(pa0, PK(l0, h0), od, 0, 0, 0);
  od = __builtin_amdgcn_mfma_f32_32x32x16_bf16(pa1, PK(l1, h1), od, 0, 0, 0);
  od = __builtin_amdgcn_mfma_f32_32x32x16_bf16(pa2, PK(l2, h2), od, 0, 0, 0);
  od = __builtin_amdgcn_mfma_f32_32x32x16_bf16(pa3, PK(l3, h3), od, 0, 0, 0);
#undef PK
}
__device__ __forceinline__ void pv_d0(f32x16 (&o)[4], int vb, bf16x8 pa0, bf16x8 pa1, bf16x8 pa2, bf16x8 pa3) {
  pv_one<0>(o[0], vb, pa0, pa1, pa2, pa3); pv_one<1>(o[1], vb, pa0, pa1, pa2, pa3); pv_one<2>(o[2], vb, pa0, pa1, pa2, pa3); pv_one<3>(o[3], vb, pa0, pa1, pa2, pa3);
}

__device__ __forceinline__ void attn_body(const bf16* __restrict__ Qb, const bf16* __restrict__ Kn, const bf16* __restrict__ Kr, const bf16* __restrict__ Vh,
                                          bf16* __restrict__ Ob, int seq, char* lds, int tid_in) {
  constexpr int LDQ = 1536, LDKV = 2048, LDKR = 768, LDO = 1024;
  const int tid_o = tid_in * 64 + lane_id_asm();
  const int tid = tid_o, wid = tid >> 6, lane = tid & 63, r32 = lane & 31, hi = lane >> 5;
  if (tid_in >= 4) __builtin_amdgcn_s_setprio(1);
  char* V_lds = lds; char* K_lds = lds + 2 * SHM_V;
  float* ws = (float*)(lds + 2 * SHM_V + 2 * SHM_K) + wid * 64; float* li_l = ws; float* al_l = ws + 32;
  float m_reg = -1e30f, l_reg = 0; f32x16 o[4] = {}; bf16x8 qr[12];
  const bf16* Qw = Qb + (long)(wid * QBLK + r32) * LDQ + hi * 8;
#pragma unroll
  for (int d0 = 0; d0 < 12; ++d0) qr[d0] = *reinterpret_cast<const bf16x8*>(Qw + d0 * 16);
  const int sr = tid >> 4, sc = (tid & 15) * 8, vst0 = v_st(sr, sc), vst1 = v_st(32 + sr, sc);
  const int rr = tid >> 3, rc = (tid & 7) * 8;
  const int vb0 = (int)(uintptr_t)V_lds + v_rd_base(lane);
  bf16x8 vs0, vs1, ks0, ks1, kr0;
#define SLOAD(k0) do { vs0 = *(const bf16x8*)(&Vh[(long)((k0) + sr) * LDKV + sc]); vs1 = *(const bf16x8*)(&Vh[(long)((k0) + 32 + sr) * LDKV + sc]); \
    ks0 = *(const bf16x8*)(&Kn[(long)((k0) + sr) * LDKV + sc]); ks1 = *(const bf16x8*)(&Kn[(long)((k0) + 32 + sr) * LDKV + sc]); \
    kr0 = *(const bf16x8*)(&Kr[(long)((k0) + rr) * LDKR + rc]); } while (0)
#define SWRITE(b) do { *(bf16x8*)(V_lds + (b) * SHM_V + vst0) = vs0; *(bf16x8*)(V_lds + (b) * SHM_V + vst1) = vs1; int kc = sc * 2;               \
    *(bf16x8*)(K_lds + (b) * SHM_K + KSWZ(sr, kc)) = ks0; *(bf16x8*)(K_lds + (b) * SHM_K + KSWZ(32 + sr, kc)) = ks1;                              \
    *(bf16x8*)(K_lds + (b) * SHM_K + KSWZ(rr, 256 + rc * 2)) = kr0; } while (0)
#define SWAIT() asm volatile("s_waitcnt vmcnt(0)" ::: "memory")
#define RESC(a) do { if (__any((a) < 1.f)) { if (hi == 0) al_l[r32] = (a); asm volatile("s_waitcnt lgkmcnt(0)" ::: "memory"); \
    _Pragma("unroll") for (int d = 0; d < 4; ++d) _Pragma("unroll") for (int r = 0; r < 16; ++r) o[d][r] *= al_l[crow(r, hi)]; } } while (0)
  f32x16 pA0, pA1, pB0, pB1; float mnA, mnB, alA, alB; bf16x8 pa0, pa1, pa2, pa3; const int NT = seq / KVBLK;
  SLOAD(0); asm volatile("s_waitcnt vmcnt(0)" ::: "memory"); SWRITE(0); SLOAD(KVBLK); __syncthreads();
  qkt(pA0, pA1, K_lds, qr, r32, hi); partialSM(pA0, pA1, m_reg, mnA, alA);
  SWAIT(); SWRITE(1); __syncthreads();
  for (int j = 1; j + 1 < NT; j += 2) {
    SBAR(); qkt(pB0, pB1, K_lds + SHM_K, qr, r32, hi);
    finishSM(pA0, pA1, alA, l_reg, pa0, pa1, pa2, pa3); SBAR();
    SLOAD((j + 1) * KVBLK); SBAR();
    pv_d0(o, vb0, pa0, pa1, pa2, pa3); partialSM(pB0, pB1, m_reg, mnB, alB);
    __syncthreads(); SWAIT(); SWRITE(0);
    RESC(alB); __syncthreads();
    SBAR(); qkt(pA0, pA1, K_lds, qr, r32, hi);
    finishSM(pB0, pB1, alB, l_reg, pa0, pa1, pa2, pa3); SBAR();
    SLOAD((j + 2) * KVBLK); SBAR();
    pv_d0(o, vb0 + (int)SHM_V, pa0, pa1, pa2, pa3); partialSM(pA0, pA1, m_reg, mnA, alA);
    __syncthreads(); SWAIT(); SWRITE(1);
    RESC(alA); __syncthreads();
  }
  SBAR(); qkt(pB0, pB1, K_lds + SHM_K, qr, r32, hi);
  finishSM(pA0, pA1, alA, l_reg, pa0, pa1, pa2, pa3); SBAR();
  pv_d0(o, vb0, pa0, pa1, pa2, pa3); partialSM(pB0, pB1, m_reg, mnB, alB);
  __syncthreads(); RESC(alB);
  finishSM(pB0, pB1, alB, l_reg, pa0, pa1, pa2, pa3); SBAR();
  pv_d0(o, vb0 + (int)SHM_V, pa0, pa1, pa2, pa3);
  if (hi == 0) li_l[r32] = l_reg; asm volatile("s_waitcnt lgkmcnt(0)" ::: "memory");
  { const int l_e = lane_id_asm(), r32e = l_e & 31, hie = l_e >> 5;
    bf16* Obe = Ob; asm volatile("" : "+s"(Obe)); Obe = (bf16*)(GAS bf16*)(unsigned long long)Obe;
    float rli[16];
#pragma unroll
    for (int r = 0; r < 16; ++r) rli[r] = __builtin_amdgcn_rcpf(li_l[crow(r, hie)]);
    bf16* Ow = Obe + (long)(wid * QBLK) * LDO;
    unsigned short* stg = (unsigned short*)(lds + SHM_ATTN + wid * OST_WAVE);
#pragma unroll
    for (int p = 0; p < 2; ++p) {
#pragma unroll
      for (int r = 0; r < 16; ++r) { const int orow = crow(r, hie);
#pragma unroll
        for (int d = 0; d < 2; ++d) stg[orow * OST_ROW + d * 32 + r32e] = f2bf(o[2 * p + d][r] * rli[r]); }
      asm volatile("s_waitcnt lgkmcnt(0)" ::: "memory");
#pragma unroll
      for (int i = 0; i < 4; ++i) { const int row = i * 8 + (l_e >> 3), ch = l_e & 7; const v4u v = *(const v4u*)(stg + row * OST_ROW + ch * 8); *(v4u*)(Ow + (long)row * LDO + p * 64 + ch * 8) = v; }
      asm volatile("s_waitcnt lgkmcnt(0)" ::: "memory");
    } }
  __builtin_amdgcn_s_setprio(0);
#undef SLOAD
#undef SWRITE
#undef SWAIT
#undef RESC
}
}
struct Ctx {
    LAS unsigned char* lds; int tid, lane, wave, G, gw, NGW;
    __device__ __forceinline__ void* p(int i) const { asm volatile("" : "+s"(i));
        volatile LAS unsigned* T = (volatile LAS unsigned*)(lds + MISC_OFF + MISC_PT);
        const unsigned lo = __builtin_amdgcn_readfirstlane(T[2 * i]), hi = __builtin_amdgcn_readfirstlane(T[2 * i + 1]); return (void*)(GAS void*)(((unsigned long long)hi << 32) | lo); }
};

template <class Map>
__device__ __forceinline__ void transpose_item(const float* W, int K, int N, bf16* WT, const float* kscale, LAS float* scr, int item, int lane, Map map) {
    const int nblk = N / 32, kb = item / nblk, nb = item % nblk, k0 = 64 * kb, n0 = 32 * nb;
#pragma unroll 8
    for (int i = 0; i < 32; ++i) { const int kk = 2 * i + (lane >> 5); float v = W[(size_t)(k0 + kk) * N + n0 + (lane & 31)]; if (kscale) v *= kscale[k0 + kk]; scr[kk * 33 + (lane & 31)] = v; }
    LDS_WAIT(); asm volatile("" ::: "memory");
    const int c = lane & 7;
#pragma unroll
    for (int j = 0; j < 4; ++j) { const int n = (lane >> 3) + 8 * j; const LAS float* s = scr + (8 * c) * 33 + n;
        v4u o; o.x = pk2(s[0 * 33], s[1 * 33]); o.y = pk2(s[2 * 33], s[3 * 33]); o.z = pk2(s[4 * 33], s[5 * 33]); o.w = pk2(s[6 * 33], s[7 * 33]);
        const int dr = map(n0 + n);
        *(v4u*)(WT + (size_t)dr * K + k0 + 8 * c) = o; }
    LDS_WAIT(); asm volatile("" ::: "memory");
}
__device__ __forceinline__ int map_win(int n) {
    if (n < 2048) { const int seg = n >> 10, r = n & 1023, h = r >> 8, j = r & 255;
        const int jp = 2 * (64 * (j >> 7) + (j & 63)) + ((j >> 6) & 1); return seg * 1024 + h * 256 + jp; }
    if (n < 4096) return WIN_V + (n - 2048);
    if (n < 6144) return WIN_GATE + (n - 4096);
    if (n < 6528) return WIN_MLA + (n - 6144);
    if (n < 6784) return WIN_MLA + 384 + (n - 6528);
    if (n < 6848) { const int j = n - 6784; const int jp = 2 * (16 * (j >> 5) + (j & 15)) + ((j >> 4) & 1); return WIN_MLA + 640 + jp; }
    if (n < 7872) return WIN_GRET + (n - 6848);
    return WIN_GMLA + (n - 7872);
}
__device__ __forceinline__ int map_wuq(int n) { const int h = n / 192, jj = n % 192; if (jj < 128) return n; const int j = jj - 128; return h * 192 + 128 + 2 * (16 * (j >> 5) + (j & 15)) + ((j >> 4) & 1); }
__device__ __forceinline__ int map_id(int n) { return n; }
__device__ __forceinline__ int map_wgu(int n) { const int up = n >> 10, j = n & 1023; return 256 * (j >> 7) + 128 * up + (j & 127); }

__device__ __forceinline__ void p0_weights(const Ctx& C) {
    LAS float* scr = (LAS float*)(C.lds + C.wave * 16384);
    unsigned char* ws = ((unsigned char*)C.p(26));
    const float* w_in = ((const float*)C.p(8)); const float* w_uq = ((const float*)C.p(12)); const float* w_ukv = ((const float*)C.p(14)); const float* w_br = ((const float*)C.p(15)); const float* w_bm = ((const float*)C.p(16)); const float* w_o = ((const float*)C.p(17));
    const float* w_gu = ((const float*)C.p(20)); const float* w_d = ((const float*)C.p(22)); const float* qg = ((const float*)C.p(11)); const float* kvg = ((const float*)C.p(13));
    constexpr int I_IN = 16 * (8896 / 32), I_UQ = 6 * 48, I_UKV = 4 * 64, I_BR = 32 * 32, I_BM = 16 * 32, I_O = 16 * 32, I_GU1 = 16 * 64, I_D1 = 16 * 32;
    constexpr int NIT = I_IN + I_UQ + I_UKV + I_BR + I_BM + I_O + 32 * I_GU1 + 32 * I_D1;
    for (int it = C.gw; it < NIT; it += C.NGW) {
        int r = it;
        if (r < I_IN) { transpose_item(w_in, 1024, 8896, (bf16*)(ws + WS_WIN), nullptr, scr, r, C.lane, map_win); continue; } r -= I_IN;
        if (r < I_UQ) { transpose_item(w_uq, 384, 1536, (bf16*)(ws + WS_WUQ), qg, scr, r, C.lane, map_wuq); continue; } r -= I_UQ;
        if (r < I_UKV) { transpose_item(w_ukv, 256, 2048, (bf16*)(ws + WS_WUKV), kvg, scr, r, C.lane, map_id); continue; } r -= I_UKV;
        if (r < I_BR) { transpose_item(w_br, 2048, 1024, (bf16*)(ws + WS_WBR), nullptr, scr, r, C.lane, map_id); continue; } r -= I_BR;
        if (r < I_BM) { transpose_item(w_bm, 1024, 1024, (bf16*)(ws + WS_WBM), nullptr, scr, r, C.lane, map_id); continue; } r -= I_BM;
        if (r < I_O) { transpose_item(w_o, 1024, 1024, (bf16*)(ws + WS_WO), nullptr, scr, r, C.lane, map_id); continue; } r -= I_O;
        if (r < 32 * I_GU1) { const int e = r / I_GU1; transpose_item(w_gu + (size_t)e * 1024 * 2048, 1024, 2048, (bf16*)(ws + WS_WGU) + (size_t)e * 2048 * 1024, nullptr, scr, r % I_GU1, C.lane, map_wgu); continue; } r -= 32 * I_GU1;
        { const int e = r / I_D1; transpose_item(w_d + (size_t)e * 1024 * 1024, 1024, 1024, (bf16*)(ws + WS_WD) + (size_t)e * 1024 * 1024, nullptr, scr, r % I_D1, C.lane, map_id); }
    }
    { bf16* padp = (bf16*)(ws + WS_WIN) + (size_t)(WIN_MLA + 704) * 1024; const int n16 = 64 * 1024 * 2 / 16;
      for (int i = blockIdx.x * 512 + C.tid; i < n16; i += C.G * 512) ((v4u*)padp)[i] = (v4u){0u, 0u, 0u, 0u}; }
    { float2* tabr = (float2*)(ws + WS_TABR); float2* tabm = (float2*)(ws + WS_TABM); float* lg = (float*)(ws + WS_LG);
      for (int i = blockIdx.x * 512 + C.tid; i < 64 * 64 + 64 * 16 + 8; i += C.G * 512) {
        if (i < 4096) { const int pos = i >> 6, f = i & 63; const float fr = exp2f(-(float)f * (13.287712379549449f / 64.0f)); const float a = (float)pos * fr; tabr[i] = make_float2(cosf(a), sinf(a)); }
        else if (i < 4096 + 1024) { const int k = i - 4096, pos = k >> 4, f = k & 15; const float fr = exp2f(-(float)f * (13.287712379549449f / 16.0f)); const float a = (float)pos * fr; tabm[k] = make_float2(cosf(a), sinf(a)); }
        else { const int k = i - 5120; const float d = (k < 4 ? ((const float*)C.p(9)) : ((const float*)C.p(10)))[k & 3];
               lg[k] = -log2f(1.0f + expf(-d)); }
      } }
}
__device__ __forceinline__ void p0_ada(const Ctx& C) {
    if ((int)blockIdx.x >= 96) return;
    LAS float* sl = (LAS float*)C.lds;
    LAS float* red = sl + 17 * 1024;
    const float* cv = ((const float*)C.p(1)); const float* cc = ((const float*)C.p(3)); const float* aw = ((const float*)C.p(6)); const float* ab = ((const float*)C.p(7));
#pragma unroll 8
    for (int i = C.tid; i < 17 * 1024; i += 512) { const float v = i < 16 * 1024 ? cv[i] : cc[i - 16 * 1024]; sl[i] = v / (1.0f + expf(-v)); }
    __syncthreads();
    const int n = blockIdx.x * 64 + C.lane; float acc[17];
#pragma unroll
    for (int b = 0; b < 17; ++b) acc[b] = 0.f;
#pragma unroll 8
    for (int k = C.wave * 128; k < C.wave * 128 + 128; ++k) { const float w = aw[(size_t)k * 6144 + n];
#pragma unroll
        for (int b = 0; b < 17; ++b) acc[b] += sl[b * 1024 + k] * w; }
#pragma unroll
    for (int b = 0; b < 17; ++b) red[(C.wave * 17 + b) * 64 + C.lane] = acc[b];
    __syncthreads();
    float* m = (float*)(((unsigned char*)C.p(26)) + WS_ADA);
    for (int i = C.tid; i < 17 * 64; i += 512) { const int b = i >> 6, l = i & 63; float s = ab[blockIdx.x * 64 + l];
#pragma unroll
        for (int w = 0; w < 8; ++w) s += red[(w * 17 + b) * 64 + l];
        m[(size_t)b * 6144 + blockIdx.x * 64 + l] = s; }
    __syncthreads();
}

__device__ __forceinline__ const float* p1_src(const float* x, const float* ctx, int grp, int r) {
    const int bl = r / LE, p = r % LE, b = grp * NBG + bl; return p < CTX ? ctx + ((size_t)b * CTX + p) * D : x + ((size_t)b * SEQ + (p - CTX)) * D; }
__device__ __forceinline__ void p1_finish(const f32x4 (&v)[4], const float* g1, const float* ada, bf16* h, int grp, int r, int lane) {
    const int bl = r / LE, p = r % LE, b = grp * NBG + bl; const float* mod = ada + (size_t)(p < CTX ? 16 : b) * 6144;
    f32x4 ga[4], sha[4], sca[4];
#pragma unroll
    for (int j = 0; j < 4; ++j) { const int c = 4 * lane + 256 * j; ga[j] = *(const f32x4*)(g1 + c); sha[j] = *(const f32x4*)(mod + c); sca[j] = *(const f32x4*)(mod + 1024 + c); }
    float s = 0.f;
#pragma unroll
    for (int j = 0; j < 4; ++j) s += (v[j].x * v[j].x + v[j].y * v[j].y) + (v[j].z * v[j].z + v[j].w * v[j].w);
    const float rstd = 1.0f / sqrtf(wave_sum(s) * (1.f / D) + EPS);
#pragma unroll
    for (int j = 0; j < 4; ++j) { const int c = 4 * lane + 256 * j;
        const f32x4 g = ga[j], sh = sha[j], sc = sca[j];
        const f32x4 o = (v[j] * rstd * g) * (sc + 1.0f) + sh;
        v2u w; w.x = pk2(o.x, o.y); w.y = pk2(o.z, o.w); *(v2u*)(h + (size_t)r * 1024 + c) = w; }
}
__device__ __forceinline__ void p1_hext(const Ctx& C, int grp) {
    const float* x = ((const float*)C.p(0)); const float* ctx = ((const float*)C.p(2)); const float* g1 = ((const float*)C.p(4)); const float* ada = (const float*)(((unsigned char*)C.p(26)) + WS_ADA);
    bf16* h = (bf16*)(((unsigned char*)C.p(26)) + WS_ARENA + AR_H);
    for (int rA = C.gw; rA < TE; rA += 2 * C.NGW) {
        const int rB = rA + C.NGW; const bool hasB = rB < TE;
        const float* sA = p1_src(x, ctx, grp, rA); const float* sB = p1_src(x, ctx, grp, hasB ? rB : rA);
        f32x4 vA[4], vB[4];
#pragma unroll
        for (int j = 0; j < 4; ++j) { vA[j] = *(const f32x4*)(sA + 4 * C.lane + 256 * j); vB[j] = *(const f32x4*)(sB + 4 * C.lane + 256 * j); }
        p1_finish(vA, g1, ada, h, grp, rA, C.lane);
        if (hasB) p1_finish(vB, g1, ada, h, grp, rB, C.lane);
    }
}

__device__ __forceinline__ void p_kt2(const Ctx& C) {
    const bf16* k = (const bf16*)(((unsigned char*)C.p(26)) + WS_ARENA + AR_K); bf16* kt = (bf16*)(((unsigned char*)C.p(26)) + WS_ARENA + AR_KT2); const float* lg = (const float*)(((unsigned char*)C.p(26)) + WS_LG);
    LAS unsigned short* tile = (LAS unsigned short*)C.lds;
    const int nitems = NBG * 4 * NCH * 4;
    v4u wn[4];
#define KT2_LOAD(itx) do { const int db_ = (itx) & 3, h_ = ((itx) >> 2) & 3, t_ = (itx) >> 4, e_ = t_ % NCH, bl_ = t_ / NCH; const size_t r0_ = (size_t)bl_ * LE + e_ * 256; \
        _Pragma("unroll") for (int i = 0; i < 4; ++i) { const int pc = C.tid + 512 * i, j = pc >> 3, dc = (pc & 7) * 8; wn[i] = *(const v4u*)(k + (r0_ + j) * 1024 + h_ * 256 + db_ * 64 + dc); } } while (0)
    if ((int)blockIdx.x < nitems) KT2_LOAD((int)blockIdx.x);
    for (int it = blockIdx.x; it < nitems; it += C.G) {
        const int db = it & 3, h = (it >> 2) & 3, t = it >> 4, e = t % NCH, bl = t / NCH, chh = (bl * 4 + h) * NCH + e;
#pragma unroll
        for (int i = 0; i < 4; ++i) { const int pc = C.tid + 512 * i, j = pc >> 3, dc = (pc & 7) * 8; const v4u w = wn[i];
            LAS unsigned* tp = (LAS unsigned*)(tile + j * 66 + dc); tp[0] = w.x; tp[1] = w.y; tp[2] = w.z; tp[3] = w.w; }
        if (it + C.G < nitems) KT2_LOAD(it + C.G);
        __syncthreads();
        const float lgf = lg[h], lgb = lg[4 + h];
        const LAS unsigned* tile32 = (const LAS unsigned*)tile;
#pragma unroll
        for (int i = 0; i < 2; ++i) { const int dp = 4 * C.wave + (C.lane & 3), j0 = (16 * i + (C.lane >> 2)) * 8;
            unsigned w[8];
#pragma unroll
            for (int x = 0; x < 8; ++x) w[x] = tile32[(j0 + x) * 33 + dp];
            float f0[8], f1[8], g0[8], g1[8];
#pragma unroll
            for (int x = 0; x < 8; ++x) { const float ef = __builtin_amdgcn_exp2f(lgf * (float)(255 - (j0 + x))), eb = __builtin_amdgcn_exp2f(lgb * (float)(j0 + x)); const float lo = bflo(w[x]), hi = bfhi(w[x]);
                f0[x] = lo * ef; f1[x] = hi * ef; g0[x] = lo * eb; g1[x] = hi * eb; }
            v4u wf0, wf1, wb0, wb1;
            wf0.x = pk2(f0[0], f0[1]); wf0.y = pk2(f0[2], f0[3]); wf0.z = pk2(f0[4], f0[5]); wf0.w = pk2(f0[6], f0[7]);
            wf1.x = pk2(f1[0], f1[1]); wf1.y = pk2(f1[2], f1[3]); wf1.z = pk2(f1[4], f1[5]); wf1.w = pk2(f1[6], f1[7]);
            wb0.x = pk2(g0[0], g0[1]); wb0.y = pk2(g0[2], g0[3]); wb0.z = pk2(g0[4], g0[5]); wb0.w = pk2(g0[6], g0[7]);
            wb1.x = pk2(g1[0], g1[1]); wb1.y = pk2(g1[2], g1[3]); wb1.z = pk2(g1[4], g1[5]); wb1.w = pk2(g1[6], g1[7]);
            const size_t off = ((size_t)chh * 256 + db * 64 + 2 * dp) * 256 + j0;
            *(v4u*)(kt + off) = wf0; *(v4u*)(kt + off + 256) = wf1; *(v4u*)(kt + KT2_DIR / 2 + off) = wb0; *(v4u*)(kt + KT2_DIR / 2 + off + 256) = wb1; }
        __syncthreads();
    }
#undef KT2_LOAD
}

__device__ __forceinline__ void p_scan(const Ctx& C) {
    bf16* bcat = (bf16*)(((unsigned char*)C.p(26)) + WS_ARENA + AR_BCAT); const float* lg = (const float*)(((unsigned char*)C.p(26)) + WS_LG);
    const int nitems = NBG * 4 * 2 * 512 * 32;
    for (int it = blockIdx.x * 512 + C.tid; it < nitems; it += C.G * 512) {
        const int c8 = it & 31, dv = (it >> 5) & 511, dir = (it >> 14) & 1, bh = it >> 15, h = bh & 3;
        const float gC = __builtin_amdgcn_exp2f(lg[dir * 4 + h] * 256.0f);
        bf16* base = bcat + (size_t)bh * NCH * 512 * 768 + (size_t)dv * 768 + 256 + dir * 256 + c8 * 8;
        v4u w[16];
#pragma unroll
        for (int st = 0; st < 16; ++st) { const int e = dir == 0 ? 1 + st : 16 - st; w[st] = *(const v4u*)(base + (size_t)e * 512 * 768); }
        float s[8] = {bflo(w[0].x), bfhi(w[0].x), bflo(w[0].y), bfhi(w[0].y), bflo(w[0].z), bfhi(w[0].z), bflo(w[0].w), bfhi(w[0].w)};
#pragma unroll
        for (int st = 1; st < 16; ++st) { const int e = dir == 0 ? 1 + st : 16 - st;
            s[0] = gC * s[0] + bflo(w[st].x); s[1] = gC * s[1] + bfhi(w[st].x); s[2] = gC * s[2] + bflo(w[st].y); s[3] = gC * s[3] + bfhi(w[st].y);
            s[4] = gC * s[4] + bflo(w[st].z); s[5] = gC * s[5] + bfhi(w[st].z); s[6] = gC * s[6] + bflo(w[st].w); s[7] = gC * s[7] + bfhi(w[st].w);
            v4u o; o.x = pk2(s[0], s[1]); o.y = pk2(s[2], s[3]); o.z = pk2(s[4], s[5]); o.w = pk2(s[6], s[7]); *(v4u*)(base + (size_t)e * 512 * 768) = o; }
    }
}

__device__ __forceinline__ void rt6_finish(const v4u (&w)[4], const v4u (&gw)[4], bf16* o, size_t r, int lane) {
#pragma unroll
    for (int c = 0; c < 4; ++c) { const size_t off = r * 2048 + (size_t)(c * 64 + lane) * 8;
        float v[8] = {bflo(w[c].x), bfhi(w[c].x), bflo(w[c].y), bfhi(w[c].y), bflo(w[c].z), bfhi(w[c].z), bflo(w[c].w), bfhi(w[c].w)};
        float g[8] = {bflo(gw[c].x), bfhi(gw[c].x), bflo(gw[c].y), bfhi(gw[c].y), bflo(gw[c].z), bfhi(gw[c].z), bflo(gw[c].w), bfhi(gw[c].w)};
        float s = 0.f;
#pragma unroll
        for (int x = 0; x < 8; ++x) s += v[x] * v[x];
        const float rstd = 1.0f / sqrtf(wave_sum(s) * (1.f / 512.f) + EPS);
#pragma unroll
        for (int x = 0; x < 8; ++x) v[x] = v[x] * rstd * g[x] * fast_sigmoid(g[x]);
        v4u ow; ow.x = pk2(v[0], v[1]); ow.y = pk2(v[2], v[3]); ow.z = pk2(v[4], v[5]); ow.w = pk2(v[6], v[7]); *(v4u*)(o + off) = ow; }
}
__device__ __forceinline__ void p_rt6(const Ctx& C) {
    bf16* o = (bf16*)(((unsigned char*)C.p(26)) + WS_ARENA + AR_O); const bf16* gate = (const bf16*)(((unsigned char*)C.p(26)) + WS_ARENA + AR_GATE);
    for (int rlA = C.gw; rlA < TL; rlA += 2 * C.NGW) { const int rlB = rlA + C.NGW; const bool hasB = rlB < TL;
        const size_t rA = (size_t)(rlA >> 12) * LE + CTX + (rlA & 4095); const int rlb = hasB ? rlB : rlA; const size_t rB = (size_t)(rlb >> 12) * LE + CTX + (rlb & 4095);
        v4u wA[4], gA[4], wB[4], gB[4];
#pragma unroll
        for (int c = 0; c < 4; ++c) { const size_t oa = rA * 2048 + (size_t)(c * 64 + C.lane) * 8, ob = rB * 2048 + (size_t)(c * 64 + C.lane) * 8;
            wA[c] = *(const v4u*)(o + oa); gA[c] = *(const v4u*)(gate + oa); wB[c] = *(const v4u*)(o + ob); gB[c] = *(const v4u*)(gate + ob); }
        rt6_finish(wA, gA, o, rA, C.lane);
        if (hasB) rt6_finish(wB, gB, o, rB, C.lane);
    }
}

__device__ __forceinline__ void p_m1(const Ctx& C) {
    const bf16* mi = (const bf16*)(((unsigned char*)C.p(26)) + WS_ARENA + AR_MLAIN); bf16* mn = (bf16*)(((unsigned char*)C.p(26)) + WS_ARENA + AR_MLAN);
    for (int r0 = C.gw; r0 < TE; r0 += 4 * C.NGW) {
        unsigned w[4][5];
#pragma unroll
        for (int q = 0; q < 4; ++q) { const int r = r0 + q * C.NGW; const unsigned* src = (const unsigned*)(mi + (size_t)(r < TE ? r : r0) * 768);
#pragma unroll
            for (int i = 0; i < 5; ++i) w[q][i] = src[C.lane + 64 * i]; }
#pragma unroll
        for (int q = 0; q < 4; ++q) { const int r = r0 + q * C.NGW; float sq = 0.f, sk = 0.f;
#pragma unroll
            for (int i = 0; i < 5; ++i) { const float a = bflo(w[q][i]), b = bfhi(w[q][i]); if (i < 3) sq += a * a + b * b; else sk += a * a + b * b; }
            const float rq = 1.0f / sqrtf(wave_sum(sq) * (1.f / 384.f) + EPS), rk = 1.0f / sqrtf(wave_sum(sk) * (1.f / 256.f) + EPS);
            if (r < TE) { unsigned* dst = (unsigned*)(mn + (size_t)r * 640);
#pragma unroll
                for (int i = 0; i < 5; ++i) { const float sc = i < 3 ? rq : rk; dst[C.lane + 64 * i] = pk2(bflo(w[q][i]) * sc, bfhi(w[q][i]) * sc); } } }
    }
}
__device__ __forceinline__ void build_ptab(const Ctx& C, const unsigned* cnt) {
    volatile LAS int* T = (volatile LAS int*)(C.lds + MISC_OFF);
    __syncthreads();
    if (C.tid < NEXP) { const int c = (int)__hip_atomic_load(cnt + C.tid, RLX_AGENT); T[672 + C.tid] = c; T[640 + C.tid] = (c + 255) >> 8; }
    __syncthreads();
    if (C.tid < NEXP) { int acc = 0; for (int e = 0; e < C.tid; ++e) acc += T[640 + e]; const int np = T[640 + C.tid];
        T[16 + C.tid] = acc; for (int p = 0; p < np; ++p) T[64 + acc + p] = C.tid; if (C.tid == NEXP - 1) T[16 + NEXP] = acc + np; }
    __syncthreads();
}
#define LX1(v) __builtin_bit_cast(float, __builtin_amdgcn_update_dpp(0, __builtin_bit_cast(int, (v)), 0xB1, 0xF, 0xF, true))
#define LX2(v) __builtin_bit_cast(float, __builtin_amdgcn_update_dpp(0, __builtin_bit_cast(int, (v)), 0x4E, 0xF, 0xF, true))
#define LX8(v) __builtin_bit_cast(float, __builtin_amdgcn_update_dpp(0, __builtin_bit_cast(int, (v)), 0x128, 0xF, 0xF, true))
#define LX4(v) SWZ_XOR((v), 4)
#define LX16(v) SWZ_XOR((v), 16)
__device__ __forceinline__ float reduce32_transposed(const float (&L)[32], int lane) {
    float M[16], N[8], P[4], Q[2];
#pragma unroll
    for (int e = 0; e < 16; ++e) { unsigned a_ = __builtin_bit_cast(unsigned, L[e]), b_ = __builtin_bit_cast(unsigned, L[e + 16]);
        auto rr = __builtin_amdgcn_permlane32_swap(a_, b_, false, false); unsigned r0_ = rr[0], r1_ = rr[1]; asm volatile("" : "+v"(r0_), "+v"(r1_));
        M[e] = __builtin_bit_cast(float, r0_) + __builtin_bit_cast(float, r1_); }
    const bool b3 = (lane & 8) != 0, b2 = (lane & 4) != 0, b1 = (lane & 2) != 0;
#pragma unroll
    for (int e = 0; e < 8; ++e) { unsigned a_ = __builtin_bit_cast(unsigned, M[e]), b_ = __builtin_bit_cast(unsigned, M[e + 8]);
        auto rr = __builtin_amdgcn_permlane16_swap(a_, b_, false, false); unsigned r0_ = rr[0], r1_ = rr[1]; asm volatile("" : "+v"(r0_), "+v"(r1_));
        N[e] = __builtin_bit_cast(float, r0_) + __builtin_bit_cast(float, r1_); }
#pragma unroll
    for (int e = 0; e < 4; ++e) { const float snd = b3 ? N[e] : N[e + 4]; P[e] = (b3 ? N[e + 4] : N[e]) + LX8(snd); }
#pragma unroll
    for (int e = 0; e < 2; ++e) { const float snd = b2 ? P[e] : P[e + 2]; Q[e] = (b2 ? P[e + 2] : P[e]) + LX4(snd); }
    const float snd = b1 ? Q[0] : Q[1]; float R = (b1 ? Q[1] : Q[0]) + LX2(snd);
    R += LX1(R);
    return R;
}
__device__ __forceinline__ void e1_route_t(float v, int ridx0, bool hasB, int lane, LAS unsigned* lcnt, LAS unsigned* rec) {
    int se[4]; float sv[4]; const unsigned myi = (unsigned)lane >> 1;
    const unsigned kb = __builtin_bit_cast(unsigned, v); unsigned key = kb ^ ((unsigned)((int)kb >> 31) | 0x80000000u);
#define UX2(x) ((unsigned)__builtin_amdgcn_update_dpp(0, (int)(x), 0x4E, 0xF, 0xF, true))
#define UX8(x) ((unsigned)__builtin_amdgcn_update_dpp(0, (int)(x), 0x128, 0xF, 0xF, true))
#define UX4(x) ((unsigned)__builtin_amdgcn_update_dpp(0, __builtin_amdgcn_update_dpp(0, (int)(x), 0x141, 0xF, 0xF, true), 0x1B, 0xF, 0xF, true))
#define USWAP(x, OP, BI) { unsigned a_ = (x), b_ = a_; asm volatile("" : "+v"(b_)); auto rr = BI(a_, b_, false, false); unsigned r0_ = rr[0], r1_ = rr[1]; asm volatile("" : "+v"(r0_), "+v"(r1_)); (x) = OP(r0_, r1_); }
#define UMAX(a, b) ((a) > (b) ? (a) : (b))
#define UMIN(a, b) ((a) < (b) ? (a) : (b))
#pragma unroll
    for (int k = 0; k < 4; ++k) { unsigned mk = key;
        { const unsigned o = UX2(mk); mk = UMAX(mk, o); } { const unsigned o = UX4(mk); mk = UMAX(mk, o); } { const unsigned o = UX8(mk); mk = UMAX(mk, o); }
        USWAP(mk, UMAX, __builtin_amdgcn_permlane16_swap) USWAP(mk, UMAX, __builtin_amdgcn_permlane32_swap)
        unsigned ci = key == mk ? myi : 64u;
        { const unsigned o = UX2(ci); ci = UMIN(ci, o); } { const unsigned o = UX4(ci); ci = UMIN(ci, o); } { const unsigned o = UX8(ci); ci = UMIN(ci, o); }
        USWAP(ci, UMIN, __builtin_amdgcn_permlane16_swap) USWAP(ci, UMIN, __builtin_amdgcn_permlane32_swap)
        se[k] = (int)ci; sv[k] = __builtin_bit_cast(float, mk ^ ((mk >> 31) ? 0x80000000u : 0xFFFFFFFFu)); if (myi == ci) key = 0u; }
#undef UX2
#undef UX8
#undef UX4
#undef USWAP
#undef UMAX
#undef UMIN
    const float L2E = 1.4426950408889634f; const float e1 = __builtin_amdgcn_exp2f((sv[1] - sv[0]) * L2E), e2 = __builtin_amdgcn_exp2f((sv[2] - sv[0]) * L2E), e3 = __builtin_amdgcn_exp2f((sv[3] - sv[0]) * L2E); const float inv = __builtin_amdgcn_rcpf(1.0f + e1 + e2 + e3);
    const float gt[4] = {inv, e1 * inv, e2 * inv, e3 * inv};
    if (lane < 8 && (hasB || (lane & 1) == 0)) { const int k = lane >> 1, ridx = ridx0 + (lane & 1); const int e = k == 0 ? se[0] : k == 1 ? se[1] : k == 2 ? se[2] : se[3]; const float gk = k == 0 ? gt[0] : k == 1 ? gt[1] : k == 2 ? gt[2] : gt[3];
        const unsigned pos = __hip_atomic_fetch_add(lcnt + e, 1u, __ATOMIC_RELAXED, __HIP_MEMORY_SCOPE_WORKGROUP);
        LAS unsigned* rp = rec + (ridx * 4 + k) * 3; rp[0] = (unsigned)e; rp[1] = pos; rp[2] = __builtin_bit_cast(unsigned, gk); }
}
__device__ __forceinline__ void e1_route(const float (&lgt)[32], int ridx, int lane, LAS unsigned* lcnt, LAS unsigned* rec) {
    int se[4]; float sv[4];
#pragma unroll
    for (int k = 0; k < 4; ++k) { float best = -3.0e38f; int bi = 0;
#pragma unroll
        for (int e = 0; e < 32; ++e) { const bool taken = (k > 0 && se[0] == e) || (k > 1 && se[1] == e) || (k > 2 && se[2] == e); if (!taken && lgt[e] > best) { best = lgt[e]; bi = e; } }
        se[k] = bi; sv[k] = best; }
    const float e1 = expf(sv[1] - sv[0]), e2 = expf(sv[2] - sv[0]), e3 = expf(sv[3] - sv[0]); const float inv = 1.0f / (1.0f + e1 + e2 + e3);
    const float gt[4] = {inv, e1 * inv, e2 * inv, e3 * inv};
    if (lane < 4) { const int k = lane; const int e = k == 0 ? se[0] : k == 1 ? se[1] : k == 2 ? se[2] : se[3]; const float gk = k == 0 ? gt[0] : k == 1 ? gt[1] : k == 2 ? gt[2] : gt[3];
        const unsigned pos = __hip_atomic_fetch_add(lcnt + e, 1u, __ATOMIC_RELAXED, __HIP_MEMORY_SCOPE_WORKGROUP);
        LAS unsigned* rp = rec + (ridx * 4 + k) * 3; rp[0] = (unsigned)e; rp[1] = pos; rp[2] = __builtin_bit_cast(unsigned, gk); }
}
__device__ __forceinline__ void e1_rawload(v2u (&raw)[4], const float* x1, int grp, int tl, int lane) {
    const int bl = tl >> 12, b = grp * NBM + bl; const size_t tok = (size_t)b * SEQ + (tl & 4095);
#pragma unroll
    for (int j = 0; j < 4; ++j) raw[j] = *(const v2u*)((const bf16*)(x1 + tok * 1024) + 4 * lane + 256 * j);
}
struct E1Par { f32x4 gs[4], sha[4]; };
__device__ __forceinline__ void e1_params(E1Par& P, const float* g2, const float* ada, int grp, int tl, int lane) {
    const int bl = tl >> 12, b = grp * NBM + bl;
    const float* mod = ada + (size_t)b * 6144 + 3072;
    f32x4 ga[4], sca[4];
#pragma unroll
    for (int j = 0; j < 4; ++j) { const int c = 4 * lane + 256 * j; ga[j] = *(const f32x4*)(g2 + c); sca[j] = *(const f32x4*)(mod + 1024 + c); P.sha[j] = *(const f32x4*)(mod + c); }
#pragma unroll
    for (int j = 0; j < 4; ++j) P.gs[j] = ga[j] * (sca[j] + 1.0f);
}
__device__ __forceinline__ void e1_row(f32x4 (&v)[4], const v2u (&raw)[4], const E1Par& P, bf16* h2, int tl, int lane) {
    float s = 0.f;
#pragma unroll
    for (int j = 0; j < 4; ++j) { const v2u w = raw[j]; v[j] = (f32x4){bflo(w.x), bfhi(w.x), bflo(w.y), bfhi(w.y)}; s += (v[j].x * v[j].x + v[j].y * v[j].y) + (v[j].z * v[j].z + v[j].w * v[j].w); }
    const float rstd = __builtin_amdgcn_rsqf(wave_sum(s) * (1.f / D) + EPS);
#pragma unroll
    for (int j = 0; j < 4; ++j) { const int c = 4 * lane + 256 * j;
        v[j] = (v[j] * rstd) * P.gs[j] + P.sha[j];
        v2u w; w.x = cvt_pk_bf16(v[j].x, v[j].y); w.y = cvt_pk_bf16(v[j].z, v[j].w); *(v2u*)(h2 + (size_t)tl * 1024 + c) = w; }
}
__device__ __forceinline__ void p_e1(const Ctx& C, int grp) {
    const float* x1 = ((float*)C.p(25)); const float* g2 = ((const float*)C.p(5)); const float* ada = (const float*)(((unsigned char*)C.p(26)) + WS_ADA); const float* rwg = ((const float*)C.p(18)); const float* rb = ((const float*)C.p(19));
    bf16* h2 = (bf16*)(((unsigned char*)C.p(26)) + WS_ARENA + AR_H2); int* sel = (int*)(((unsigned char*)C.p(26)) + WS_ARENA + AR_SEL);
    unsigned* cnt = (unsigned*)(((unsigned char*)C.p(26)) + WS_CTL) + CW_CNT + grp * 64;
    LAS float* rw = (LAS float*)C.lds;
    LAS unsigned* lcnt = (LAS unsigned*)(C.lds + MISC_OFF + MISC_LCNT);
    LAS unsigned* rec = (LAS unsigned*)(C.lds + MISC_OFF + 8192);
    if (C.tid < 32) lcnt[C.tid] = 0u;
    { f32x4 rv[16];
#pragma unroll
      for (int i = 0; i < 16; ++i) rv[i] = *(const f32x4*)(rwg + (size_t)(C.tid + 512 * i) * 4);
#pragma unroll
      for (int i = 0; i < 16; ++i) { const int q = C.tid + 512 * i, k = q >> 3, eg = q & 7; const int l = (k & 255) >> 2, j = k >> 8, c = k & 3; *(LAS f32x4*)(rw + (((j * 4 + c) * 8 + eg) * 64 + l) * 4) = rv[i]; } }
    __syncthreads();
    const int tl0 = C.gw * 16; const bool live = tl0 < TLM && 16 * 8 * C.G >= TLM;
    E1Par P; e1_params(P, g2, ada, grp, live ? tl0 : 0, C.lane);
    const float be = rb[C.lane >> 1];
    v2u rawA[4], rawB[4];
    e1_rawload(rawA, x1, grp, live ? tl0 : 0, C.lane); e1_rawload(rawB, x1, grp, live ? tl0 + 1 : 0, C.lane);
    for (int trip = 0; live && trip < 8; ++trip) {
        const int tlA = tl0 + 2 * trip, tlB = tlA + 1; const bool hasB = true;
        f32x4 vA[4], vB[4]; v2u nxA[4], nxB[4];
        { const int nA = trip < 7 ? tlA + 2 : tlA;
          e1_rawload(nxA, x1, grp, nA, C.lane); e1_rawload(nxB, x1, grp, nA + 1, C.lane); }
        e1_row(vA, rawA, P, h2, tlA, C.lane);
        e1_row(vB, rawB, P, h2, tlB, C.lane);
        float lgA[32], lgB[32];
        { f32x4 rb0[8], rb1[8];
#define E1_LD8(buf, eg, h) _Pragma("unroll") for (int k = 0; k < 8; ++k) buf[k] = *(const LAS f32x4*)(rw + ((((h) * 8 + k) * 8 + (eg)) * 64 + C.lane) * 4);
#define E1_FM8(buf, h) _Pragma("unroll") for (int k = 0; k < 8; ++k) { const int kk = (h) * 8 + k; const float a_ = vA[kk >> 2][kk & 3], b_ = vB[kk >> 2][kk & 3];                  \
            const f32x2 r01 = {buf[k].x, buf[k].y}, r23 = {buf[k].z, buf[k].w}, a2 = {a_, a_}, b2 = {b_, b_};                                                                   \
            if (kk == 0) { aA0 = a2 * r01; aA1 = a2 * r23; aB0 = b2 * r01; aB1 = b2 * r23; }                                                                                   \
            else { aA0 = __builtin_elementwise_fma(a2, r01, aA0); aA1 = __builtin_elementwise_fma(a2, r23, aA1); aB0 = __builtin_elementwise_fma(b2, r01, aB0); aB1 = __builtin_elementwise_fma(b2, r23, aB1); } }
          E1_LD8(rb0, 0, 0)
#pragma unroll
          for (int eg = 0; eg < 8; ++eg) { f32x2 aA0, aA1, aB0, aB1;
              E1_LD8(rb1, eg, 1) __builtin_amdgcn_sched_barrier(0);
              E1_FM8(rb0, 0) __builtin_amdgcn_sched_barrier(0);
              if (eg < 7) { E1_LD8(rb0, eg + 1, 0) } __builtin_amdgcn_sched_barrier(0);
              E1_FM8(rb1, 1) __builtin_amdgcn_sched_barrier(0);
              lgA[eg * 4 + 0] = aA0.x; lgA[eg * 4 + 1] = aA0.y; lgA[eg * 4 + 2] = aA1.x; lgA[eg * 4 + 3] = aA1.y;
              lgB[eg * 4 + 0] = aB0.x; lgB[eg * 4 + 1] = aB0.y; lgB[eg * 4 + 2] = aB1.x; lgB[eg * 4 + 3] = aB1.y; }
#undef E1_LD8
#undef E1_FM8
        }
        {
          const float vA1 = reduce32_transposed(lgA, C.lane) + be, vB1 = reduce32_transposed(lgB, C.lane) + be;
          e1_route_t((C.lane & 1) ? vB1 : vA1, C.wave * 16 + 2 * trip, hasB, C.lane, lcnt, rec); }
#pragma unroll
        for (int j = 0; j < 4; ++j) { rawA[j] = nxA[j]; rawB[j] = nxB[j]; }
    }
    __syncthreads();
    if (C.tid < 32) lcnt[32 + C.tid] = __hip_atomic_fetch_add(cnt + C.tid, lcnt[C.tid], RLX_AGENT);
    __syncthreads();
    { const int i = C.tid, w = i >> 6, t = (i >> 2) & 15, k = i & 3; const int tl = ((int)blockIdx.x * 8 + w) * 16 + t;
      if (tl < TLM && 16 * 8 * C.G >= TLM) {
          const unsigned e = rec[i * 3], lp = rec[i * 3 + 1]; const float gk = __builtin_bit_cast(float, rec[i * 3 + 2]);
          const unsigned posg = lcnt[32 + e] + lp, d = e * (unsigned)TLM + posg;
          float* rowg = (float*)(((unsigned char*)C.p(26)) + WS_ARENA + AR_ROWG); unsigned short* rowtok = (unsigned short*)(((unsigned char*)C.p(26)) + WS_ARENA + AR_ROWTOK);
          rowtok[(d & ~127u) + 2 * (d & 63u) + ((d >> 6) & 1u)] = (unsigned short)tl; rowg[d] = gk; sel[(size_t)TLM * 12 + (size_t)tl * 4 + k] = (int)(e | (posg << 8)); } }
    if (blockIdx.x == 0 && C.tid < 128) { unsigned zz = 0u; asm volatile("" : "+v"(zz)); ((v4u*)(h2 + (size_t)TLM * 1024))[C.tid] = (v4u){zz, zz, zz, zz}; }
    __syncthreads();
}
typedef int i32x4 __attribute__((ext_vector_type(4)));
__device__ __forceinline__ void e5_load(f32x4 (&v)[4], const float* out, const float* ada, const bf16* ys, const i32x4 rec4, const volatile LAS int* T, int grp, int tl, int lane) {
    const int bl = tl >> 12, b = grp * NBM + bl; const size_t tok = (size_t)b * SEQ + (tl & 4095);
    const float* g2v = ada + (size_t)b * 6144 + 5120;
    i32x4 d4;
#pragma unroll
    for (int k = 0; k < 4; ++k) d4[k] = T[16 + (rec4[k] & 255)] * 256 + (int)((unsigned)rec4[k] >> 8);
#pragma unroll
    for (int j = 0; j < 2; ++j) { const int c = 8 * lane + 512 * j; f32x4 m0 = (f32x4){0.f, 0.f, 0.f, 0.f}, m1 = m0;
#pragma unroll
        for (int k = 0; k < 4; ++k) { const v4u w = *(const v4u*)(ys + (size_t)d4[k] * 1024 + c);
            m0 += (f32x4){bflo(w.x), bfhi(w.x), bflo(w.y), bfhi(w.y)}; m1 += (f32x4){bflo(w.z), bfhi(w.z), bflo(w.w), bfhi(w.w)}; }
        const v4u xw = *(const v4u*)((const bf16*)(out + tok * 1024) + c);
        v[2 * j] = (f32x4){bflo(xw.x), bfhi(xw.x), bflo(xw.y), bfhi(xw.y)} + *(const f32x4*)(g2v + c) * m0;
        v[2 * j + 1] = (f32x4){bflo(xw.z), bfhi(xw.z), bflo(xw.w), bfhi(xw.w)} + *(const f32x4*)(g2v + c + 4) * m1; }
}
__device__ __forceinline__ void e5_store(const f32x4 (&v)[4], float* out, const f32x4 (&fga)[4], int grp, int tl, int lane) {
    const int bl = tl >> 12, b = grp * NBM + bl; const size_t tok = (size_t)b * SEQ + (tl & 4095);
    float s = 0.f;
#pragma unroll
    for (int j = 0; j < 4; ++j) s += (v[j].x * v[j].x + v[j].y * v[j].y) + (v[j].z * v[j].z + v[j].w * v[j].w);
    const float rstd = 1.0f / sqrtf(wave_sum(s) * (1.f / D) + EPS);
#pragma unroll
    for (int j = 0; j < 4; ++j) { const int c = 8 * lane + 512 * (j >> 1) + 4 * (j & 1); *(f32x4*)(out + tok * 1024 + c) = v[j] * rstd * fga[j]; }
}
__device__ __forceinline__ void p_e5(const Ctx& C, int grp) {
    float* out = ((float*)C.p(25)); const float* ada = (const float*)(((unsigned char*)C.p(26)) + WS_ADA); const float* fg = ((const float*)C.p(24));
    const bf16* ys = (const bf16*)(((unsigned char*)C.p(26)) + WS_ARENA + AR_XS); const int* sel = (const int*)(((unsigned char*)C.p(26)) + WS_ARENA + AR_SEL);
    build_ptab(C, (const unsigned*)(((unsigned char*)C.p(26)) + WS_CTL) + CW_CNT + grp * 64);
    const volatile LAS int* T = (const volatile LAS int*)(C.lds + MISC_OFF);
    f32x4 fga[4];
#pragma unroll
    for (int j = 0; j < 4; ++j) fga[j] = *(const f32x4*)(fg + 8 * C.lane + 512 * (j >> 1) + 4 * (j & 1));
    const int* dsel = sel + (size_t)TLM * 12;
    i32x4 dA = {0, 0, 0, 0}, dB = {0, 0, 0, 0};
    if (C.gw < TLM) { dA = *(const i32x4*)(dsel + (size_t)C.gw * 4); const int tb = C.gw + C.NGW; dB = *(const i32x4*)(dsel + (size_t)(tb < TLM ? tb : C.gw) * 4); }
    for (int tlA = C.gw; tlA < TLM; tlA += 2 * C.NGW) {
        const int tlB = tlA + C.NGW; const bool hasB = tlB < TLM;
        f32x4 vA[4], vB[4];
        e5_load(vA, out, ada, ys, dA, T, grp, tlA, C.lane);
        if (hasB) e5_load(vB, out, ada, ys, dB, T, grp, tlB, C.lane);
        { const int nA = tlA + 2 * C.NGW, nB = nA + C.NGW; if (nA < TLM) { dA = *(const i32x4*)(dsel + (size_t)nA * 4); dB = *(const i32x4*)(dsel + (size_t)(nB < TLM ? nB : nA) * 4); } }
        e5_store(vA, out, fga, grp, tlA, C.lane);
        if (hasB) e5_store(vB, out, fga, grp, tlB, C.lane);
    }
}
#ifndef PH_MASK
#define PH_MASK 0xFFFFFFFFu
#endif
#define EN(k) ((PH_MASK >> (k)) & 1u)
constexpr int NM = 8, NE = 4, NSGS = 2 * NM + NE, NSTEPS = 1 + NSG * NSGS;
#ifndef MK_ONE_LAUNCH
#define MK_ONE_LAUNCH 1
#endif

__global__ void __launch_bounds__(512, 2) fwd_kernel(Params P) {
    extern __shared__ __attribute__((aligned(16))) unsigned char lds_raw[];
    Ctx C; C.lds = (LAS unsigned char*)lds_raw; C.tid = threadIdx.x; C.lane = C.tid & 63; C.wave = __builtin_amdgcn_readfirstlane(C.tid >> 6);
    C.G = gridDim.x; C.gw = blockIdx.x * 8 + C.wave; C.NGW = C.G * 8; int wave_s = C.wave;
    volatile LAS unsigned* MISC = (volatile LAS unsigned*)(C.lds + MISC_OFF);
    if (C.tid < 4) MISC[C.tid] = 0u;
    if (C.tid == 0) { volatile LAS unsigned long long* PT = (volatile LAS unsigned long long*)(C.lds + MISC_OFF + MISC_PT);
#pragma unroll
        for (int i = 0; i < 25; ++i) PT[i] = (unsigned long long)P.in[i];
        PT[25] = (unsigned long long)P.out; PT[26] = (unsigned long long)P.ws; }
    __syncthreads();
    const int lo = P.ph_lo, hi = P.ph_hi;
    if (hi - lo > 1) (void)xcd_barrier_post((unsigned*)((unsigned char*)C.p(26) + WS_CTL) + CW_BAR, MISC);
#define IN(k) (lo <= (k) && (k) < hi)
#define NOCONT pg8::Cont{nullptr, nullptr, 0, 0}
#define OPAQ() { int l_; asm volatile("v_mbcnt_lo_u32_b32 %0, -1, 0\n\tv_mbcnt_hi_u32_b32 %0, -1, %0" : "=v"(l_)); asm volatile("" : "+s"(wave_s)); \
      C.lane = l_; C.wave = wave_s; C.tid = wave_s * 64 + l_; C.gw = blockIdx.x * 8 + wave_s; } \
    unsigned char* ws = (unsigned char*)C.p(26); unsigned char* ar = ws + WS_ARENA; (void)ar; \
    const float2* tabr = (const float2*)(ws + WS_TABR); const float2* tabm = (const float2*)(ws + WS_TABM); const float* lg = (const float*)(ws + WS_LG); (void)tabr; (void)tabm; (void)lg
#define SEAM(k) do { if (IN((k) + 1)) { XcdBarrier b2_; b2_.bar = (unsigned*)((unsigned char*)C.p(26) + WS_CTL) + CW_BAR; b2_.x = xb_xcc_id(); b2_.st = MISC; xcd_barrier(b2_, wave_s * 64 + lane_id_asm()); } } while (0)
    LAS unsigned char* ring = C.lds;
    const int G = C.G, cb = (int)blockIdx.x;

    if (EN(0) && IN(0)) { OPAQ(); p0_weights(C); __syncthreads(); p0_ada(C); SEAM(0); }

    for (int sg = 0; sg < NSG; ++sg) {
      const int b0 = 1 + sg * NSGS;
      if (hi <= b0 || lo >= b0 + NSGS) continue;
      for (int gi = 0; gi < 2; ++gi) {
        const int grp = sg * 2 + gi, s0 = b0 + gi * NM;
        if (hi <= s0 || lo >= s0 + NM) continue;
        if (EN(1) && grp == 0 && IN(s0 + 0)) { OPAQ(); p1_hext(C, grp); SEAM(s0 + 0); }
        if (EN(2) && IN(s0 + 1)) { OPAQ();
            { SchedGAV S{(const char*)(ar + AR_H), (const char*)(ws + WS_WIN), G, cb};
              EpiGAV E{EpiGA{(bf16*)(ar + AR_Q), (bf16*)(ar + AR_K), (bf16*)(ar + AR_ACAT), (bf16*)(ar + AR_MLAIN), tabr, tabm, lg, (float*)(ar + AR_SSQ)}, EpiStore<LocGV>{LocGV{(bf16*)(ar + AR_BCAT)}}};
              pg8::gemm_phase<EpiGAV, SchedGAV, 1024, 1024, 16>(ring, S, E, wave_s); }
            SEAM(s0 + 1); }
        if (EN(3) && IN(s0 + 2)) { OPAQ();
            const int gemm_first = (cb >> 3) & 1;
#pragma unroll 1
            for (int half = 0; half < 2; ++half) {
                int do_gemm = (half ^ gemm_first) ^ 1; asm volatile("" : "+s"(do_gemm));
                if (!do_gemm) { int l_; asm volatile("v_mbcnt_lo_u32_b32 %0, -1, 0\n\tv_mbcnt_hi_u32_b32 %0, -1, %0" : "=v"(l_)); C.lane = l_; C.tid = wave_s * 64 + l_; p_kt2(C); }
                else {
                       Sched2D<true, false> S2{(const char*)(ar + AR_H), (const char*)(ws + WS_WIN + (size_t)WIN_GATE * 1024 * 2), (size_t)256 * 1024 * 2, (size_t)256 * 1024 * 2, TL / 256, 8, G, cb};
                       pg8::Unit nu; const bool hn = S2.next(0, nu); bool ps;
                       { SchedRT4 S{(const char*)(ar + AR_Q), (const char*)(ar + AR_K), G, cb}; EpiRT4 E{(bf16*)(ar + AR_ACAT), lg};
                         ps = pg8::gemm_phase<EpiRT4, SchedRT4, 1024, 1024, 4>(ring, S, E, wave_s, hn ? pg8::Cont{nu.a, nu.b, 1024, 1024} : NOCONT); }
                       { EpiStore<LocGB> E{LocGB{(bf16*)(ar + AR_GATE), (bf16*)(ar + AR_GRET), (bf16*)(ar + AR_GMLA)}};
                         pg8::gemm_phase<EpiStore<LocGB>, Sched2D<true, false>, 1024, 1024, 16>(ring, S2, E, wave_s, NOCONT, ps); } }
                __syncthreads();
            }
            SEAM(s0 + 2); }
        if (EN(4) && IN(s0 + 3)) { OPAQ();
            Sched2D<true, false> SM2{(const char*)(ar + AR_MLAIN), (const char*)(ws + WS_WUQ), (size_t)256 * 768 * 2, (size_t)256 * 384 * 2, TL / 256, 6, G, cb};
            Sched2D<false, false> SM3{(const char*)(ar + AR_MLAIN) + 384 * 2, (const char*)(ws + WS_WUKV), (size_t)256 * 768 * 2, (size_t)256 * 256 * 2, TE / 256, 8, G, G == 256 ? ((cb + 128) & 255) : cb};
            pg8::Unit nu2, nu3; const bool hn2 = SM2.next(0, nu2), hn3 = SM3.next(0, nu3); bool ps2, ps3;
            { SchedRT2 S{(const char*)(ar + AR_BCAT), (const char*)(ar + AR_KT2), G, cb}; EpiStore<LocRT2> E{LocRT2{(bf16*)(ar + AR_BCAT)}};
              ps2 = pg8::gemm_phase<EpiStore<LocRT2>, SchedRT2, 768, 256, 4>(ring, S, E, wave_s, hn2 ? pg8::Cont{nu2.a, nu2.b, 768, 384} : NOCONT); }
            { EpiM2 E{(bf16*)(ar + AR_QMLA), tabm, (const float*)(ar + AR_SSQ)};
              ps3 = pg8::gemm_phase<EpiM2, Sched2D<true, false>, 768, 384, 6>(ring, SM2, E, wave_s, hn3 ? pg8::Cont{nu3.a, nu3.b, 768, 256} : NOCONT, ps2); }
            { const Sched2D<false, false>& S = SM3;
              EpiM3 E{(bf16*)(ar + AR_KVMLA), (const float*)(ar + AR_SSQ)};
              pg8::gemm_phase<EpiM3, Sched2D<false, false>, 768, 256, 4>(ring, S, E, wave_s, NOCONT, ps3); }
            SEAM(s0 + 3); }
        if (EN(5) && IN(s0 + 4)) { OPAQ();
            const int att_first = (cb >> 3) & 1;
#pragma unroll 1
            for (int half = 0; half < 2; ++half) {
                int do_att = (half ^ att_first) ^ 1; asm volatile("" : "+s"(do_att));
                if (!do_att) { int l_; asm volatile("v_mbcnt_lo_u32_b32 %0, -1, 0\n\tv_mbcnt_hi_u32_b32 %0, -1, %0" : "=v"(l_)); C.lane = l_; C.tid = wave_s * 64 + l_; p_scan(C); }
                else {
                    const bf16* qm = (const bf16*)(ar + AR_QMLA); const bf16* kv = (const bf16*)(ar + AR_KVMLA); const bf16* mi = (const bf16*)(ar + AR_MLAIN); bf16* ao = (bf16*)(ar + AR_ATTO);
                    for (int it0 = cb; it0 < NBG * 8 * 16; it0 += G) {
                        int it = it0; if (G == 256) { const int xcd = cb & 7, slot = cb >> 3, hp = (it0 >> 8) * 16 + xcd * 2 + (slot >> 4); it = hp * 16 + (slot & 15); }
                        const int qb = it & 15, h = (it >> 4) & 7, bl = it >> 7; const size_t rb = (size_t)bl * LE, rq = rb + CTX + qb * 256;
                        att::attn_body(qm + rq * 1536 + h * 192, kv + rb * 2048 + h * 256, mi + rb * 768 + 640, kv + rb * 2048 + h * 256 + 128, ao + rq * 1024 + h * 128, LE, (char*)lds_raw, wave_s);
                        __syncthreads(); }
                }
                __syncthreads();
            }
            SEAM(s0 + 4); }
        if (EN(6) && IN(s0 + 5)) { OPAQ();
            Sched2D<true, false> SG{(const char*)(ar + AR_H), (const char*)(ws + WS_WIN + (size_t)WIN_GATE * 1024 * 2), (size_t)256 * 1024 * 2, (size_t)256 * 1024 * 2, TL / 256, 8, G, cb, 8};
            pg8::Unit nu; const bool hn = SG.next(0, nu); bool ps;
            { SchedRT5 S{(const char*)(ar + AR_ACAT), (const char*)(ar + AR_BCAT), G, cb}; EpiRT5F E{(bf16*)(ar + AR_O), (const bf16*)(ar + AR_GATE), (float*)(ar + AR_SSQ)};
              ps = pg8::gemm_phase<EpiRT5F, SchedRT5, 3072, 768, 12>(ring, S, E, wave_s, hn ? pg8::Cont{nu.a, nu.b, 1024, 1024} : NOCONT); }
            { EpiStore<LocGB> E{LocGB{(bf16*)(ar + AR_GATE), (bf16*)(ar + AR_GRET), (bf16*)(ar + AR_GMLA)}};
              pg8::gemm_phase<EpiStore<LocGB>, Sched2D<true, false>, 1024, 1024, 16>(ring, SG, E, wave_s, NOCONT, ps); }
            SEAM(s0 + 5); }
        if (EN(8) && IN(s0 + 6)) { OPAQ();
            Sched2D<true, false> S2{(const char*)(ar + AR_ATTO), (const char*)(ws + WS_WBM), (size_t)256 * 1024 * 2, (size_t)256 * 1024 * 2, TL / 256, 4, G, cb};
            pg8::Unit nu; const bool hn = S2.next(0, nu); bool ps;
            { Sched2D<true, false> S{(const char*)(ar + AR_O), (const char*)(ws + WS_WBR), (size_t)256 * 2048 * 2, (size_t)256 * 2048 * 2, TL / 256, 4, G, cb};
              EpiG1 E{(const bf16*)(ar + AR_GRET), (bf16*)(ar + AR_T1), (const float*)(ar + AR_SSQ)};
              ps = pg8::gemm_phase<EpiG1, Sched2D<true, false>, 2048, 2048, 32>(ring, S, E, wave_s, hn ? pg8::Cont{nu.a, nu.b, 1024, 1024} : NOCONT); }
            asm volatile("s_waitcnt vmcnt(0)" ::: "memory");
            { EpiGate<true> E{(const bf16*)(ar + AR_GMLA), (const bf16*)(ar + AR_T1), (bf16*)(ar + AR_MERGED)};
              pg8::gemm_phase<EpiGate<true>, Sched2D<true, false>, 1024, 1024, 16>(ring, S2, E, wave_s, NOCONT, ps); }
            SEAM(s0 + 6); }
        if (EN(9) && IN(s0 + 7)) { OPAQ();
            const int gemm_first = (cb >> 3) & 1;
#pragma unroll 1
            for (int half = 0; half < 2; ++half) {
                int do_gemm = (half ^ gemm_first) ^ 1; asm volatile("" : "+s"(do_gemm));
                if (do_gemm) {
                    Sched2D<true, false> S{(const char*)(ar + AR_MERGED), (const char*)(ws + WS_WO), (size_t)256 * 1024 * 2, (size_t)256 * 1024 * 2, TL / 256, 4, G, cb};
                    EpiG3 E{((const float*)C.p(0)), (const float*)(ws + WS_ADA), ((float*)C.p(25)), grp * NBG};
                    pg8::gemm_phase<EpiG3, Sched2D<true, false>, 1024, 1024, 16>(ring, S, E, wave_s); }
                else if (gi == 0) { int l_; asm volatile("v_mbcnt_lo_u32_b32 %0, -1, 0\n\tv_mbcnt_hi_u32_b32 %0, -1, %0" : "=v"(l_)); C.lane = l_; C.tid = wave_s * 64 + l_; p1_hext(C, grp + 1); }
                __syncthreads();
            }
            SEAM(s0 + 7); }
      }
      const int e0 = b0 + 2 * NM;
      if (EN(12) && IN(e0 + 0)) { OPAQ(); p_e1(C, sg); SEAM(e0 + 0); }
      if (EN(14) && IN(e0 + 1)) { OPAQ();
          const unsigned* cnt = (const unsigned*)(ws + WS_CTL) + CW_CNT + sg * 64; build_ptab(C, cnt);
          volatile LAS int* T = (volatile LAS int*)(C.lds + MISC_OFF);
          SchedMoEG S{(const char*)(ar + AR_H2), (const unsigned short*)(ar + AR_ROWTOK), (const char*)(ws + WS_WGU), (size_t)2048 * 1024 * 2, T + 64, T[16 + NEXP], G, cb, TLM};
          EpiE3 E{(bf16*)(ar + AR_ACT), ((const float*)C.p(21))};
          pg8::gemm_phase<EpiE3, SchedMoEG, 1024, 1024, 16, true, true>(ring, S, E, wave_s);
          SEAM(e0 + 1); }
      if (EN(15) && IN(e0 + 2)) { OPAQ();
          const unsigned* cnt = (const unsigned*)(ws + WS_CTL) + CW_CNT + sg * 64; build_ptab(C, cnt);
          volatile LAS int* T = (volatile LAS int*)(C.lds + MISC_OFF);
          SchedMoE<4> S{(const char*)(ar + AR_ACT), (const char*)(ws + WS_WD), (size_t)1024 * 1024 * 2, T + 64, T[16 + NEXP], G, cb};
          EpiE4 E{(bf16*)(ar + AR_XS), ((const float*)C.p(23)), (const float*)(ar + AR_ROWG)};
          pg8::gemm_phase<EpiE4, SchedMoE<4>, 1024, 1024, 16, false, true>(ring, S, E, wave_s);
          SEAM(e0 + 2); }
      if (EN(16) && IN(e0 + 3)) { OPAQ(); p_e5(C, sg); if (sg + 1 < NSG) p1_hext(C, 2 * (sg + 1)); SEAM(e0 + 3); }
    }
#undef IN
#undef NOCONT
#undef SEAM
}

extern "C" void kernel_launch(void* const* d_in, const int* in_sizes, int n_in, void* d_out, int out_size, void* d_ws, size_t ws_size, hipStream_t stream) {
    static int grid = 0;
    if (grid == 0) {
        if (n_in != 25 || in_sizes[0] != BATCH * SEQ * D || out_size != BATCH * SEQ * D || ws_size < WS_END) {
            fprintf(stderr, "kernel_launch: shape mismatch: n_in %d in0 %d out %d ws %zu (need %zu)\n", n_in, n_in > 0 ? in_sizes[0] : -1, out_size, ws_size, (size_t)WS_END); grid = -1; return; }
        int dev = 0, cus = 0, per_cu = 0;
        if (hipGetDevice(&dev) != hipSuccess || hipDeviceGetAttribute(&cus, hipDeviceAttributeMultiprocessorCount, dev) != hipSuccess) { grid = -1; return; }
        if (hipFuncSetAttribute((const void*)fwd_kernel, hipFuncAttributeMaxDynamicSharedMemorySize, LDS_BYTES) != hipSuccess) { fprintf(stderr, "kernel_launch: hipFuncSetAttribute failed\n"); grid = -1; return; }
        if (hipOccupancyMaxActiveBlocksPerMultiprocessor(&per_cu, (const void*)fwd_kernel, 512, LDS_BYTES) != hipSuccess || per_cu < 1) fprintf(stderr, "kernel_launch: occupancy query reports %d\n", per_cu);
        (void)hipGetLastError();
        grid = cus < 256 ? cus : 256;
    }
    if (grid < 0) return;
    if (hipMemsetAsync((char*)d_ws + WS_CTL, 0, CTL_ZERO_BYTES, stream) != hipSuccess) return;
    Params p{};
    for (int i = 0; i < 25; ++i) p.in[i] = (const float*)d_in[i];
    p.out = (float*)d_out; p.ws = (unsigned char*)d_ws;
#if MK_ONE_LAUNCH
    p.ph_lo = 0; p.ph_hi = NSTEPS;
    hipLaunchKernelGGL(fwd_kernel, dim3(grid), dim3(512), LDS_BYTES, stream, p);
#else
    for (int s = 0; s < NSTEPS; ++s) { p.ph_lo = s; p.ph_hi = s + 1; hipLaunchKernelGGL(fwd_kernel, dim3(grid), dim3(512), LDS_BYTES, stream, p); }
#endif
}
```

```cpp
#include <hip/hip_runtime.h>
#include <cstdio>
#include <cstdint>

#define GAS __attribute__((address_space(1)))
#define LAS __attribute__((address_space(3)))
typedef unsigned short bf16;
typedef unsigned v4u __attribute__((ext_vector_type(4)));
typedef unsigned v2u __attribute__((ext_vector_type(2)));
typedef float f32x4 __attribute__((ext_vector_type(4)));
typedef float f32x2 __attribute__((ext_vector_type(2)));
typedef float f32x16 __attribute__((ext_vector_type(16)));
typedef short bf16x8 __attribute__((ext_vector_type(8)));
typedef short s16x4 __attribute__((ext_vector_type(4)));
typedef GAS unsigned gu32;
#define RLX_AGENT __ATOMIC_RELAXED, __HIP_MEMORY_SCOPE_AGENT
#define LDS_WAIT() asm volatile("s_waitcnt lgkmcnt(0)" ::: "memory")
#define VM_WAIT() asm volatile("s_waitcnt vmcnt(0)" ::: "memory")

constexpr int D = 1024, BATCH = 16, SEQ = 4096, CTX = 256, LE = SEQ + CTX;
constexpr int NBG = 4, NGROUPS = BATCH / NBG;
constexpr int TE = NBG * LE, TL = NBG * SEQ;
constexpr int NCH = LE / 256;
constexpr int NEXP = 32, TOPK = 4;
constexpr float EPS = 1e-6f;
constexpr int NBM = 8, NSG = BATCH / NBM, TLM = NBM * SEQ;
constexpr int MOE_ROWS = TLM * TOPK + NEXP * 256;
constexpr int MAXPANELS = MOE_ROWS / 256;

__device__ __forceinline__ unsigned f2bf(float f) { unsigned u = __builtin_bit_cast(unsigned, f); return (u + 0x7fffu + ((u >> 16) & 1u)) >> 16; }
__device__ __forceinline__ unsigned cvt_pk_bf16(float lo, float hi) { unsigned r; asm volatile("v_cvt_pk_bf16_f32 %0, %1, %2" : "=v"(r) : "v"(lo), "v"(hi)); return r; }
__device__ __forceinline__ unsigned pk2(float lo, float hi) { return cvt_pk_bf16(lo, hi); }
__device__ __forceinline__ float bf2f(unsigned short b) { return __builtin_bit_cast(float, ((unsigned)b) << 16); }
__device__ __forceinline__ float bflo(unsigned w) { return __builtin_bit_cast(float, w << 16); }
__device__ __forceinline__ float bfhi(unsigned w) { return __builtin_bit_cast(float, w & 0xffff0000u); }
#define SWZ_XOR(v, k) __builtin_bit_cast(float, __builtin_amdgcn_ds_swizzle(__builtin_bit_cast(int, (v)), 0x1f | ((k) << 10)))
#define DPP_ADD(v, ctrl) (v) += __builtin_bit_cast(float, __builtin_amdgcn_update_dpp(0, __builtin_bit_cast(int, (v)), (ctrl), 0xF, 0xF, true))
__device__ __forceinline__ float wave_sum(float v) {
    DPP_ADD(v, 0xB1); DPP_ADD(v, 0x4E); DPP_ADD(v, 0x141); DPP_ADD(v, 0x140);
    v += SWZ_XOR(v, 16);
    { unsigned a_ = __builtin_bit_cast(unsigned, v), b_ = a_; asm volatile("" : "+v"(b_));
      auto rr = __builtin_amdgcn_permlane32_swap(a_, b_, false, false);
      unsigned r0_ = rr[0], r1_ = rr[1]; asm volatile("" : "+v"(r0_), "+v"(r1_));
      v = __builtin_bit_cast(float, r0_) + __builtin_bit_cast(float, r1_); }
    return v;
}
__device__ __forceinline__ float fast_sigmoid(float x) { return __builtin_amdgcn_rcpf(1.0f + __builtin_amdgcn_exp2f(-1.4426950408889634f * x)); }
__device__ __forceinline__ f32x2 sig2(f32x2 x) { const f32x2 z = x * (f32x2){-1.4426950408889634f, -1.4426950408889634f}; const f32x2 d = (f32x2){__builtin_amdgcn_exp2f(z.x), __builtin_amdgcn_exp2f(z.y)} + (f32x2){1.f, 1.f}; return (f32x2){__builtin_amdgcn_rcpf(d.x), __builtin_amdgcn_rcpf(d.y)}; }
__device__ __forceinline__ f32x2 bf2x2(unsigned u) { return (f32x2){bflo(u), bfhi(u)}; }

__device__ __forceinline__ int lane_id_asm() { int l; asm volatile("v_mbcnt_lo_u32_b32 %0, -1, 0\n\tv_mbcnt_hi_u32_b32 %0, -1, %0" : "=v"(l)); return l; }

#define XB_TMO      128
#define XB_XCNT(j)  (256  + 64 * (j))
#define XB_XSUB(j)  (1280 + 64 * (j))
#define XB_XGEN(j)  (2304 + 64 * (j))
#define XB_TOP      3328
#define XB_TOPGEN   3392
#define XCD_BAR_WORDS 3456
#define XB_SPIN_CAP (1u << 22)

__device__ __forceinline__ unsigned xb_ld(unsigned* p)              { return __hip_atomic_load(p, __ATOMIC_RELAXED, __HIP_MEMORY_SCOPE_AGENT); }
__device__ __forceinline__ unsigned xb_add(unsigned* p, unsigned v) { return __hip_atomic_fetch_add(p, v, __ATOMIC_RELAXED, __HIP_MEMORY_SCOPE_AGENT); }
__device__ __forceinline__ unsigned xb_xcc_id() { return (unsigned)__builtin_amdgcn_s_getreg((3 << 11) | 20) & 0xFu; }
#define XB_SPIN(cond, bar) do { unsigned _sp = 0; while (cond) { __builtin_amdgcn_s_sleep(1); \
    if ((++_sp & 255u) == 0u) { if (xb_ld(&(bar)[XB_TMO])) break; if (_sp > XB_SPIN_CAP) { atomicAdd(&(bar)[XB_TMO], 1u); break; } } } } while (0)

struct XcdBarrier { unsigned* bar; unsigned x; volatile LAS unsigned* st; };

__device__ __forceinline__ XcdBarrier xcd_barrier_post(unsigned* bar, volatile LAS unsigned* st) {
    XcdBarrier b; b.bar = bar; b.x = xb_xcc_id(); b.st = st;
    if (threadIdx.x == 0) (void)xb_add(&bar[XB_XCNT(b.x)], 1u);
    return b;
}
__device__ __forceinline__ void xcd_barrier_complete(unsigned* bar, unsigned x, unsigned& nloc, unsigned& nx) {
    const unsigned G = gridDim.x * gridDim.y * gridDim.z;
    unsigned sum, cnt, mine, sp = 0u;
    for (;;) {
        sum = 0u; cnt = 0u; mine = 0u;
#pragma unroll
        for (unsigned j = 0; j < 16; ++j) { const unsigned c = xb_ld(&bar[XB_XCNT(j)]); sum += c; cnt += (c > 0u) ? 1u : 0u; mine = (j == x) ? c : mine; }
        if (sum == G) break;
        __builtin_amdgcn_s_sleep(1);
        if ((++sp & 255u) == 0u) { if (xb_ld(&bar[XB_TMO])) break; if (sp > XB_SPIN_CAP) { atomicAdd(&bar[XB_TMO], 1u); break; } }
    }
    nloc = mine > 0u ? mine : 1u; nx = cnt > 0u ? cnt : 1u;
}
__device__ __forceinline__ void xcd_barrier(const XcdBarrier& b, int tid_b) {
    asm volatile("s_waitcnt vmcnt(0)" ::: "memory");
    __syncthreads();
    if (tid_b == 0) {
        unsigned* bar = b.bar;
        __builtin_amdgcn_s_waitcnt(0);
        unsigned nloc = b.st[0], nx = b.st[1];
        if (nloc == 0u) { xcd_barrier_complete(bar, b.x, nloc, nx); b.st[0] = nloc; b.st[1] = nx; }
        const unsigned old = xb_add(&bar[XB_XSUB(b.x)], 1u);
        const unsigned gen = old / nloc;
        if (old + 1u == (gen + 1u) * nloc) {
            __builtin_amdgcn_fence(__ATOMIC_RELEASE, "agent");
            asm volatile("s_waitcnt vmcnt(0)" ::: "memory");
            const unsigned og = xb_add(&bar[XB_TOP], 1u);
            const unsigned tg = og / nx;
            if (og + 1u == (tg + 1u) * nx) xb_add(&bar[XB_TOPGEN], 1u);
            else XB_SPIN(xb_ld(&bar[XB_TOPGEN]) == tg, bar);
            __builtin_amdgcn_fence(__ATOMIC_ACQUIRE, "agent");
            xb_add(&bar[XB_XGEN(b.x)], 1u);
            asm volatile("s_waitcnt vmcnt(0)" ::: "memory");
        } else {
            XB_SPIN(xb_ld(&bar[XB_XGEN(b.x)]) == gen, bar);
            __builtin_amdgcn_fence(__ATOMIC_ACQUIRE, "agent");
            asm volatile("s_waitcnt vmcnt(0)" ::: "memory");
        }
    }
    __syncthreads();
}

namespace pg8 {
constexpr int BM = 256, BK = 64, HALF = 128, HTB = HALF * BK * 2, STAGE_BYTES = 8 * HTB, NXCD = 8, WGM = 8;
constexpr int EPI_SLOT_OFF = STAGE_BYTES + 8192, EPI_SLOT_BYTES = 4096;
__host__ __device__ __forceinline__ int lds_byte(int r, int c) { const int pos = ((c >> 3) & 3) ^ (((r >> 2) & 1) << 1); return (r >> 3) * 1024 + ((c >> 5) & 1) * 512 + (r & 7) * 64 + pos * 16 + (c & 7) * 2; }
__host__ __device__ __forceinline__ void stage_rc(int b, int& R, int& C) { const int p = b / 1024, sb = b % 1024, pos = (sb >> 4) & 3; R = p * 8 + ((sb >> 6) & 7); C = (sb >> 9) * 32 + ((pos ^ (((R >> 2) & 1) << 1)) * 8) + (sb & 15) / 2; }
__host__ __device__ __forceinline__ int perm32(int rho) { const int n = rho >> 4, i = rho & 15; return 8 * (i >> 2) + 4 * n + (i & 3); }

struct Unit { const char* a; const char* b; int u0, u1, u2, u3, u4; };

__device__ __forceinline__ void tile2d(int L, int nM, int nN, int& pm, int& pn) {
    const int nwg = nM * nN; int wgid = L;
    { const int q = nwg / NXCD, r = nwg % NXCD, xcd = wgid % NXCD, off = wgid / NXCD; wgid = (xcd < r ? xcd * (q + 1) : r * (q + 1) + (xcd - r) * q) + off; }
    const int nig = WGM * nN, gid = wgid / nig, fm = gid * WGM, gsz = (nM - fm) < WGM ? (nM - fm) : WGM;
    pm = fm + ((wgid % nig) % gsz); pn = (wgid % nig) / gsz;
}

struct Cont { const char* a; const char* b; int lda, ldb; };
template <class Epi, class Sched, int LDA, int LDB, int KT, bool GATHER = false, bool STAGGER = false>
__device__ __forceinline__ bool gemm_phase(LAS unsigned char* lds, const Sched& S, const Epi& E, int tid_in, const Cont cont = Cont{nullptr, nullptr, 0, 0}, const bool prestaged = false) {
    static_assert(KT >= 4 && (KT % 2) == 0, "K multiple of 128, >= 256");
    const int tid_o = tid_in * 64 + lane_id_asm();
    const int tid = tid_o, wid = __builtin_amdgcn_readfirstlane(tid >> 6), lane = tid & 63, wr = wid >> 2, wc = wid & 3, fr = lane & 15, fq = lane >> 4;
    constexpr int nt = KT;
    unsigned voffA[2], voffB[2];
#pragma unroll
    for (int i = 0; i < 2; ++i) { int R, C; stage_rc(tid * 16 + i * 8192, R, C); const int Rb = Epi::PERM ? ((R & ~31) + perm32(R & 31)) : R;
        voffA[i] = (unsigned)(R * LDA + C) * 2u; voffB[i] = (unsigned)(Rb * LDB + C) * 2u; }
    constexpr size_t kstep = (size_t)(BK * 2);
    size_t hstepA = (size_t)HALF * LDA * 2, hstepB = (size_t)HALF * LDB * 2;
    const unsigned ldsw = (unsigned)wid * 1024u;
    const int aoff = lds_byte(wr * 64 + fr, fq * 8), boff = lds_byte(wc * 32 + fr, fq * 8);
#define PG8_SA(b, h) (((b) * 2 + (h)) * HTB)
#define PG8_SB(b, h) ((4 + (b) * 2 + (h)) * HTB)
#define PG8_STAGE(bufoff, gbase, voff) do { const char* _b = (const char*)(gbase); asm volatile("" : "+s"(_b)); _Pragma("unroll") for (int _i = 0; _i < 2; ++_i) { unsigned _v = (voff)[_i]; asm volatile("" : "+v"(_v)); \
        __builtin_amdgcn_global_load_lds((const unsigned*)(_b + _v), (LAS unsigned*)(lds + (bufoff) + ldsw + _i * 8192), 16, 0, 0); } } while (0)
    unsigned ogc[2] = {0u, 0u}, ogn[2] = {0u, 0u}; const unsigned gpk = (voffA[0] / (unsigned)(LDA * 2)) | ((voffA[0] % (unsigned)(LDA * 2)) << 8);
#define PG8_LOAD_OG(og, un) do { if constexpr (GATHER) { unsigned _g = gpk; asm volatile("" : "+v"(_g)); const int rA0 = (int)(_g & 255u); _Pragma("unroll") for (int _h = 0; _h < 2; ++_h) { const unsigned* _q = (const unsigned*)S.rowtok + ((((un).u4 + 128 * _h) >> 1) + rA0); unsigned _x; \
        asm volatile("global_load_dword %0, %1, off" : "=v"(_x) : "v"(_q) : "memory"); og[_h] = _x; } } } while (0)
#define PG8_MASK_OG(p, rem, h) ([&](unsigned _pp, int _rem, int _hh) { unsigned _gg = gpk; asm volatile("" : "+v"(_gg)); const int _r = (int)(_gg & 255u) + 128 * _hh; return ((_r < _rem) ? (_pp & 0xffffu) : (unsigned)S.zrow) | (((_r + 64 < _rem) ? (_pp >> 16) : (unsigned)S.zrow) << 16); }((p), (rem), (h)))
#define PG8_STAGE_A(bufoff, base, h, nx) do { if constexpr (GATHER) { const char* _bg = (const char*)(base); asm volatile("" : "+s"(_bg)); unsigned _pn = ogn[h], _g = gpk; asm volatile("" : "+v"(_pn), "+v"(_g)); const unsigned _p = (nx) ? PG8_MASK_OG(_pn, nxt.u3, h) : ogc[h], cbA = _g >> 8; \
        __builtin_amdgcn_global_load_lds((const unsigned*)(_bg + (size_t)((_p & 0xffffu) * (unsigned)(LDA * 2) + cbA)), (LAS unsigned*)(lds + (bufoff) + ldsw), 16, 0, 0); \
        __builtin_amdgcn_global_load_lds((const unsigned*)(_bg + (size_t)((_p >> 16) * (unsigned)(LDA * 2) + cbA)), (LAS unsigned*)(lds + (bufoff) + ldsw + 8192), 16, 0, 0); } \
        else { PG8_STAGE(bufoff, (base) + (h) * hstepA, voffA); } } while (0)
#define PG8_LDA(dst, b, h) do { _Pragma("unroll") for (int m = 0; m < 4; ++m) _Pragma("unroll") for (int k = 0; k < 2; ++k) dst[m][k] = *(const LAS bf16x8*)(lds + PG8_SA(b, h) + aoff + m * 2048 + k * 512); } while (0)
#define PG8_LDB(dst, b, h) do { _Pragma("unroll") for (int n = 0; n < 2; ++n) _Pragma("unroll") for (int k = 0; k < 2; ++k) dst[n][k] = *(const LAS bf16x8*)(lds + PG8_SB(b, h) + boff + n * 2048 + k * 512); } while (0)
#define PG8_MMA(ai, bj, At, Bt) do { __builtin_amdgcn_s_setprio(1); _Pragma("unroll") for (int m = 0; m < 4; ++m) _Pragma("unroll") for (int n = 0; n < 2; ++n) _Pragma("unroll") for (int k = 0; k < 2; ++k) \
        acc[ai][bj][m][n] = __builtin_amdgcn_mfma_f32_16x16x32_bf16(Bt[n][k], At[m][k], acc[ai][bj][m][n], 0, 0, 0); __builtin_amdgcn_s_setprio(0); } while (0)
#define PG8_WAIT_V(n) asm volatile("s_waitcnt vmcnt(" #n ")" ::: "memory")
#define PG8_WAIT_L(n) asm volatile("s_waitcnt lgkmcnt(" #n ")" ::: "memory")
#define PG8_BAR __builtin_amdgcn_s_barrier()
#define PG8_SCHED __builtin_amdgcn_sched_barrier(0)
    Unit cur, nxt; int ui = 0;
    if (!S.next(0, cur)) return false;
    bool cont_done = false;
    f32x4 acc[2][2][4][2];
#pragma unroll
    for (int a = 0; a < 2; ++a)
#pragma unroll
        for (int b = 0; b < 2; ++b)
#pragma unroll
            for (int m = 0; m < 4; ++m)
#pragma unroll
                for (int n = 0; n < 2; ++n) acc[a][b][m][n] = (f32x4){0.f, 0.f, 0.f, 0.f};
    bf16x8 At[4][2], B0[2][2], B1[2][2];
    const char* cA; if constexpr (GATHER) cA = S.gbase; else cA = cur.a;
    const char* cB = cur.b;
    PG8_LOAD_OG(ogc, cur);
    if constexpr (GATHER) { asm volatile("s_waitcnt vmcnt(0)" : "+v"(ogc[0]), "+v"(ogc[1]) :: "memory"); ogc[0] = PG8_MASK_OG(ogc[0], cur.u3, 0); ogc[1] = PG8_MASK_OG(ogc[1], cur.u3, 1); }
    if constexpr (STAGGER) { const int stag = ((int)blockIdx.x >> 3) & 3; for (int i = 0; i < stag; ++i) __builtin_amdgcn_s_sleep(45); }
    if (!prestaged) {
    PG8_STAGE(PG8_SB(0, 0), cB, voffB); PG8_STAGE(PG8_SB(0, 1), cB + hstepB, voffB); PG8_STAGE_A(PG8_SA(0, 0), cA, 0, false); PG8_STAGE_A(PG8_SA(0, 1), cA, 1, false);
    PG8_STAGE(PG8_SB(1, 0), cB + kstep, voffB); PG8_STAGE_A(PG8_SA(1, 0), cA + kstep, 0, false); PG8_STAGE(PG8_SB(1, 1), cB + hstepB + kstep, voffB); }
    if (wr == 1) PG8_BAR;
    PG8_WAIT_V(8); PG8_BAR;
    PG8_WAIT_V(6); PG8_BAR;
    for (;;) {
        if constexpr (Epi::PRE) { cur.u3 = ui & 1; E.pre(cur, lds + EPI_SLOT_OFF + (ui & 1) * EPI_SLOT_BYTES, wid); }
        const bool has_next = S.next(ui + 1, nxt);
        const char* nA; if constexpr (GATHER) nA = cA; else nA = has_next ? nxt.a : cA;
        const char* nB = has_next ? nxt.b : cB;
        const bool use_cont = !GATHER && !has_next && cont.a != nullptr;
        if constexpr (GATHER) { if (has_next) { PG8_LOAD_OG(ogn, nxt); } else { ogn[0] = ogc[0]; ogn[1] = ogc[1]; } }
#pragma unroll 1
        for (int t = 0; t < nt; t += 2) {
            const bool last = (t == nt - 2);
            if constexpr (Epi::KSCALE) { if (t != 0 && (t & 7) == 0) E.kscale(acc, wr, (t >> 3) - 1, lds + EPI_SLOT_OFF + cur.u3 * EPI_SLOT_BYTES); }
            const char* a1 = cA + (size_t)(t + 1) * kstep;
            PG8_LDB(B0, 0, 0); PG8_LDB(B1, 0, 1); PG8_SCHED; PG8_LDA(At, 0, 0); PG8_STAGE_A(PG8_SA(1, 1), a1, 1, false);
            if (last && use_cont) {
                const int tid2 = wid * 64 + lane_id_asm();
#pragma unroll
                for (int i = 0; i < 2; ++i) { int R, C; stage_rc(tid2 * 16 + i * 8192, R, C); const int Rb = Epi::PERM ? ((R & ~31) + perm32(R & 31)) : R;
                    voffA[i] = (unsigned)(R * cont.lda + C) * 2u; voffB[i] = (unsigned)(Rb * cont.ldb + C) * 2u; }
                hstepA = (size_t)HALF * cont.lda * 2; hstepB = (size_t)HALF * cont.ldb * 2; nA = cont.a; nB = cont.b; cont_done = true; }
            const char* a2 = last ? nA : cA + (size_t)(t + 2) * kstep; const char* b2 = last ? nB : cB + (size_t)(t + 2) * kstep;
            const char* a3 = a2 + kstep; const char* b3 = b2 + kstep;
            PG8_WAIT_V(8); PG8_WAIT_L(0); PG8_BAR; PG8_MMA(0, 0, At, B0); PG8_MMA(0, 1, At, B1); PG8_BAR; PG8_SCHED;
            PG8_LDA(At, 0, 1); PG8_STAGE(PG8_SB(0, 0), b2, voffB); PG8_STAGE(PG8_SB(0, 1), b2 + hstepB, voffB); PG8_STAGE_A(PG8_SA(0, 0), a2, 0, last);
            PG8_WAIT_V(8); PG8_WAIT_L(0); PG8_BAR; PG8_MMA(1, 0, At, B0); PG8_MMA(1, 1, At, B1); PG8_BAR; PG8_SCHED;
            PG8_LDB(B0, 1, 0); PG8_LDB(B1, 1, 1); PG8_SCHED; PG8_LDA(At, 1, 0); PG8_STAGE_A(PG8_SA(0, 1), a2, 1, last);
            PG8_WAIT_V(8); PG8_WAIT_L(0); PG8_BAR; PG8_MMA(0, 0, At, B0); PG8_MMA(0, 1, At, B1); PG8_BAR; PG8_SCHED;
            PG8_LDA(At, 1, 1); PG8_STAGE(PG8_SB(1, 0), b3, voffB); PG8_STAGE(PG8_SB(1, 1), b3 + hstepB, voffB); PG8_STAGE_A(PG8_SA(1, 0), a3, 0, last);
            PG8_WAIT_V(8); PG8_WAIT_L(0); PG8_BAR; PG8_MMA(1, 0, At, B0); PG8_MMA(1, 1, At, B1); PG8_BAR; PG8_SCHED;
        }
        if (wr == 0) PG8_BAR;
        { const int l_e = lane_id_asm(); int wr_e = wr, wc_e = wc, fr_e = l_e & 15, fq_e = l_e >> 4; asm volatile("" : "+s"(wr_e), "+s"(wc_e));
          if constexpr (Epi::PRE) E(acc, cur, wr_e, wc_e, fr_e, fq_e, lds + EPI_SLOT_OFF + cur.u3 * EPI_SLOT_BYTES); else E(acc, cur, wr_e, wc_e, fr_e, fq_e); }
        if (!has_next) break;
#pragma unroll
        for (int a = 0; a < 2; ++a)
#pragma unroll
            for (int b = 0; b < 2; ++b)
#pragma unroll
                for (int m = 0; m < 4; ++m)
#pragma unroll
                    for (int n = 0; n < 2; ++n) acc[a][b][m][n] = (f32x4){0.f, 0.f, 0.f, 0.f};
        cur = nxt; cA = nA; cB = nB; ++ui;
        if constexpr (GATHER) { ogc[0] = PG8_MASK_OG(ogn[0], cur.u3, 0); ogc[1] = PG8_MASK_OG(ogn[1], cur.u3, 1); }
        if (wr == 1) PG8_BAR;
    }
    PG8_WAIT_V(0);
    PG8_BAR;
    return cont_done;
#undef PG8_SA
#undef PG8_SB
#undef PG8_STAGE
#undef PG8_STAGE_A
#undef PG8_LOAD_OG
#undef PG8_MASK_OG
#undef PG8_LDA
#undef PG8_LDB
#undef PG8_MMA
#undef PG8_WAIT_V
#undef PG8_WAIT_L
#undef PG8_BAR
#undef PG8_SCHED
}
}
constexpr size_t MiB = 1u << 20;
constexpr size_t WS_CTL = 0, CTL_ZERO_BYTES = 1 * MiB;
constexpr size_t WS_ADA = 1 * MiB;
constexpr size_t WS_TABR = WS_ADA + 512 * 1024;
constexpr size_t WS_TABM = WS_TABR + 64 * 64 * 8;
constexpr size_t WS_LG = WS_TABM + 64 * 16 * 8;
constexpr size_t WS_WIN = 2 * MiB;
constexpr int    WIN_ROWS = 8960, WIN_Q = 0, WIN_K = 1024, WIN_MLA = 2048, WIN_V = 2816, WIN_GATE = 4864, WIN_GRET = 6912, WIN_GMLA = 7936;
constexpr size_t WS_WUQ = WS_WIN + (size_t)WIN_ROWS * 1024 * 2;
constexpr size_t WS_WUKV = WS_WUQ + (size_t)1536 * 384 * 2;
constexpr size_t WS_WBR = WS_WUKV + (size_t)2048 * 256 * 2;
constexpr size_t WS_WBM = WS_WBR + (size_t)1024 * 2048 * 2;
constexpr size_t WS_WO = WS_WBM + (size_t)1024 * 1024 * 2;
constexpr size_t WS_WGU = WS_WO + (size_t)1024 * 1024 * 2;
constexpr size_t WS_WD = WS_WGU + (size_t)32 * 2048 * 1024 * 2;
constexpr size_t WS_WEND = WS_WD + (size_t)32 * 1024 * 1024 * 2;
constexpr size_t WS_ARENA = (WS_WEND + MiB - 1) / MiB * MiB;
constexpr size_t AR_H = 0;
constexpr size_t AR_MLAIN = AR_H + (size_t)TE * 1024 * 2;
constexpr size_t AR_O = AR_MLAIN + (size_t)TE * 768 * 2;
constexpr size_t AR_Q = AR_O + (size_t)TE * 2048 * 2;
constexpr size_t AR_K = AR_Q + (size_t)TE * 1024 * 2;
constexpr size_t AR_ACAT = AR_K + (size_t)TE * 1024 * 2;
constexpr size_t AR_KT2 = AR_ACAT + (size_t)TE * 3072 * 2;
constexpr size_t KT2_DIR = (size_t)NBG * 4 * NCH * 256 * 256 * 2;
constexpr size_t AR_BCAT = AR_KT2 + 2 * KT2_DIR;
constexpr size_t BCAT_CH = (size_t)512 * 768 * 2;
constexpr size_t AR_MLAN = AR_BCAT + (size_t)NBG * 4 * NCH * BCAT_CH;
constexpr size_t AR_ATTO = AR_MLAN + (size_t)TE * 640 * 2;
constexpr size_t AR_GATE = AR_ATTO + (size_t)TE * 1024 * 2;
constexpr size_t AR_SSQ = AR_GATE + (size_t)TE * 2048 * 2;
constexpr size_t AR_END1 = AR_SSQ + (size_t)TE * 32 * 4;
constexpr size_t AR_QMLA = AR_O;
constexpr size_t AR_KVMLA = AR_Q;
constexpr size_t AR_GRET = AR_KT2;
constexpr size_t AR_GMLA = AR_GRET + (size_t)TE * 1024 * 2;
constexpr size_t AR_T1 = AR_ACAT;
constexpr size_t AR_MERGED = AR_T1 + (size_t)TE * 1024 * 2;
static_assert(AR_QMLA + (size_t)TE * 1536 * 2 <= AR_Q, "q_mla over o");
static_assert(AR_KVMLA + (size_t)TE * 2048 * 2 <= AR_ACAT, "kv_mla / gate over q,k");
static_assert(AR_GMLA + (size_t)TE * 1024 * 2 <= AR_BCAT, "g over kt2");
static_assert(AR_MERGED + (size_t)TE * 1024 * 2 <= AR_KT2, "t1/merged over acat");
constexpr size_t AR_H2 = 0;
constexpr size_t AR_XS = AR_H2 + (size_t)(TLM + 8) * 1024 * 2;
constexpr size_t AR_ACT = AR_XS + (size_t)MOE_ROWS * 1024 * 2;
constexpr size_t AR_SEL = AR_ACT + (size_t)MOE_ROWS * 1024 * 2;
constexpr size_t AR_ROWG = AR_SEL + (size_t)TLM * 4 * 4 * 4;
constexpr size_t AR_ROWTOK = AR_ROWG + (size_t)NEXP * TLM * 4;
constexpr size_t AR_END2 = AR_ROWTOK + (size_t)NEXP * TLM * 2;
constexpr size_t AR_SIZE = (AR_END1 > AR_END2 ? AR_END1 : AR_END2);
constexpr size_t WS_END = WS_ARENA + AR_SIZE;
constexpr int CW_BAR = 4096;
constexpr int CW_CNT = 16384;
constexpr int CW_BBASE = 32768;

constexpr int RING_BYTES = 131072;
constexpr int MISC_OFF = RING_BYTES; static_assert(pg8::EPI_SLOT_OFF == RING_BYTES + 8192 && pg8::STAGE_BYTES == RING_BYTES && RING_BYTES + 8192 + 2 * pg8::EPI_SLOT_BYTES <= 147456, "epilogue operand slots");
constexpr int MISC_LCNT = 3072, MISC_PT = 4096;
constexpr int LDS_BYTES = 147456;

struct Params {
    const float* in[25];
    float* out;
    unsigned char* ws;
    int ph_lo, ph_hi;
};
using pg8::Unit;
__device__ __forceinline__ int lat_panel_to_ext(int pml) { return (pml >> 4) * NCH + (pml & 15) + 1; }

template <bool LAT_A, bool LAT_B>
struct Sched2D {
    const char* A; const char* B; size_t sa, sb; int nM, nN, G, c, n0 = 0;
    __device__ __forceinline__ bool next(int i, Unit& u) const {
        const int L = i * G + c; if (L >= nM * nN) return false;
        int pm, pn; pg8::tile2d(L, nM, nN, pm, pn); pn += n0;
        const int am = LAT_A ? lat_panel_to_ext(pm) : pm, bn = LAT_B ? lat_panel_to_ext(pn) : pn;
        u.a = A + (size_t)am * sa; u.b = B + (size_t)bn * sb; u.u0 = am; u.u1 = bn; u.u2 = 0; u.u3 = 0; return true;
    }
};

struct EpiGA {
    static constexpr bool PERM = true; static constexpr bool PRE = false, KSCALE = false;
    bf16 *q, *k, *acat, *mlain; const float2* tabr; const float2* tabm; const float* lg; float* ssqm;
    __device__ __forceinline__ void operator()(const f32x4 (&acc)[2][2][4][2], const Unit& u, int wr, int wc, int fr, int fq) const {
        const int pm = u.u0, pn = u.u1;
        if (pn < 8) {
            const int h = pn & 3; const bool isq = pn < 4;
            const float lgf = lg[h], lgb = lg[4 + h];
#pragma unroll
            for (int ai = 0; ai < 2; ++ai) { f32x4 csa[4][2][2];
#pragma unroll
                for (int m = 0; m < 4; ++m) { const int r = pm * 256 + ai * 128 + wr * 64 + m * 16 + fr; const int p = r % LE; const int t = p >= CTX ? p - CTX : 0;
#pragma unroll
                    for (int bj = 0; bj < 2; ++bj) { const int pos = bj == 0 ? (t >> 6) : (t & 63); const f32x4* tp = (const f32x4*)(tabr + pos * 64 + 16 * wc + 4 * fq); csa[m][bj][0] = tp[0]; csa[m][bj][1] = tp[1]; } }
#pragma unroll
                for (int m = 0; m < 4; ++m) {
                    const int r = pm * 256 + ai * 128 + wr * 64 + m * 16 + fr;
                    const int p = r % LE; const bool lat = p >= CTX;
                    const int iloc = p & 255;
                    const float sf = isq ? __builtin_amdgcn_exp2f(lgf * (float)(iloc + 1)) : 0.0625f;
                    const float sb = __builtin_amdgcn_exp2f(lgb * (float)(256 - iloc));
#pragma unroll
                    for (int bj = 0; bj < 2; ++bj) {
                        f32x4 cs0 = csa[m][bj][0], cs1 = csa[m][bj][1];
                        if (!lat) { cs0 = (f32x4){1.f, 0.f, 1.f, 0.f}; cs1 = cs0; }
                        const f32x4 v0 = acc[ai][bj][m][0], v1 = acc[ai][bj][m][1];
                        float o[8];
                        o[0] = v0[0] * cs0[0] - v0[1] * cs0[1]; o[1] = v0[0] * cs0[1] + v0[1] * cs0[0];
                        o[2] = v0[2] * cs0[2] - v0[3] * cs0[3]; o[3] = v0[2] * cs0[3] + v0[3] * cs0[2];
                        o[4] = v1[0] * cs1[0] - v1[1] * cs1[1]; o[5] = v1[0] * cs1[1] + v1[1] * cs1[0];
                        o[6] = v1[2] * cs1[2] - v1[3] * cs1[3]; o[7] = v1[2] * cs1[3] + v1[3] * cs1[2];
                        const int col = bj * 128 + wc * 32 + 8 * fq;
                        if (isq) {
                            v4u w; w.x = cvt_pk_bf16(o[0], o[1]); w.y = cvt_pk_bf16(o[2], o[3]); w.z = cvt_pk_bf16(o[4], o[5]); w.w = cvt_pk_bf16(o[6], o[7]);
                            *(v4u*)(q + (size_t)r * 1024 + h * 256 + col) = w;
                            v4u wf; wf.x = cvt_pk_bf16(o[0] * sf, o[1] * sf); wf.y = cvt_pk_bf16(o[2] * sf, o[3] * sf); wf.z = cvt_pk_bf16(o[4] * sf, o[5] * sf); wf.w = cvt_pk_bf16(o[6] * sf, o[7] * sf);
                            *(v4u*)(acat + (size_t)r * 3072 + h * 768 + 256 + col) = wf;
                            v4u wb; wb.x = cvt_pk_bf16(o[0] * sb, o[1] * sb); wb.y = cvt_pk_bf16(o[2] * sb, o[3] * sb); wb.z = cvt_pk_bf16(o[4] * sb, o[5] * sb); wb.w = cvt_pk_bf16(o[6] * sb, o[7] * sb);
                            *(v4u*)(acat + (size_t)r * 3072 + h * 768 + 512 + col) = wb;
                        } else {
                            v4u w; w.x = cvt_pk_bf16(o[0] * sf, o[1] * sf); w.y = cvt_pk_bf16(o[2] * sf, o[3] * sf); w.z = cvt_pk_bf16(o[4] * sf, o[5] * sf); w.w = cvt_pk_bf16(o[6] * sf, o[7] * sf);
                            *(v4u*)(k + (size_t)r * 1024 + h * 256 + col) = w;
                        }
                    }
                } }
        } else {
            const int c0 = (pn - 8) * 256;
#pragma unroll
            for (int ai = 0; ai < 2; ++ai)
#pragma unroll
                for (int m = 0; m < 4; ++m) {
                    const int r = pm * 256 + ai * 128 + wr * 64 + m * 16 + fr;
                    const int p = r % LE; const bool lat = p >= CTX; const int t = lat ? p - CTX : 0;
#pragma unroll
                    for (int bj = 0; bj < 2; ++bj) {
                        const int col = c0 + bj * 128 + wc * 32 + 8 * fq;
                        const f32x4 v0 = acc[ai][bj][m][0], v1 = acc[ai][bj][m][1];
                        float o[8] = {v0[0], v0[1], v0[2], v0[3], v1[0], v1[1], v1[2], v1[3]};
                        if (col >= 640 && col < 704 && lat) {
                            const int pp0 = (col - 640) >> 1; const int pos = pp0 < 16 ? (t >> 6) : (t & 63);
                            const f32x4* tp = (const f32x4*)(tabm + pos * 16 + (pp0 & 15));
                            const f32x4 cs0 = tp[0], cs1 = tp[1];
                            o[0] = v0[0] * cs0[0] - v0[1] * cs0[1]; o[1] = v0[0] * cs0[1] + v0[1] * cs0[0];
                            o[2] = v0[2] * cs0[2] - v0[3] * cs0[3]; o[3] = v0[2] * cs0[3] + v0[3] * cs0[2];
                            o[4] = v1[0] * cs1[0] - v1[1] * cs1[1]; o[5] = v1[0] * cs1[1] + v1[1] * cs1[0];
                            o[6] = v1[2] * cs1[2] - v1[3] * cs1[3]; o[7] = v1[2] * cs1[3] + v1[3] * cs1[2];
                        }
                        v4u w; w.x = cvt_pk_bf16(o[0], o[1]); w.y = cvt_pk_bf16(o[2], o[3]); w.z = cvt_pk_bf16(o[4], o[5]); w.w = cvt_pk_bf16(o[6], o[7]);
                        *(v4u*)(mlain + (size_t)r * 768 + col) = w;
                        const int blk = (c0 >> 7) + bj;
                        if (blk < 5) { float sq = 0.f;
#pragma unroll
                            for (int x = 0; x < 8; ++x) sq += o[x] * o[x];
                            sq += SWZ_XOR(sq, 16);
                            { unsigned a_ = __builtin_bit_cast(unsigned, sq), b_ = a_; asm volatile("" : "+v"(b_));
                              auto rr = __builtin_amdgcn_permlane32_swap(a_, b_, false, false);
                              unsigned r0_ = rr[0], r1_ = rr[1]; asm volatile("" : "+v"(r0_), "+v"(r1_));
                              sq = __builtin_bit_cast(float, r0_) + __builtin_bit_cast(float, r1_); }
                            if (fq == 0) ssqm[(size_t)r * 32 + blk * 4 + wc] = sq; }
                    }
                }
        }
    }
};

struct SchedGAV { const char* H; const char* W; int G, c;
    __device__ __forceinline__ bool next(int i, Unit& u) const {
        const int L = i * G + c; int pm, pn;
        if (L < 476) { pg8::tile2d(L, TE / 256, 7, pm, pn); pn += 4; u.u2 = 0; }
        else if (L < 732) { pg8::tile2d(L - 476, TL / 256, 4, pm, pn); pm = lat_panel_to_ext(pm); u.u2 = 0; }
        else if (L < 1276) { pg8::tile2d(L - 732, 8, TE / 256, pm, pn); u.u2 = 1; }
        else return false;
        if (u.u2 == 0) { u.a = H + (size_t)pm * 256 * 1024 * 2; u.b = W + (size_t)pn * 256 * 1024 * 2; }
        else { u.a = W + (size_t)(WIN_V + pm * 256) * 1024 * 2; u.b = H + (size_t)pn * 256 * 1024 * 2; }
        u.u0 = pm; u.u1 = pn; u.u3 = 0; return true; } };

template <class Loc>
struct EpiStore {
    static constexpr bool PERM = true; static constexpr bool PRE = false, KSCALE = false;
    Loc loc;
    __device__ __forceinline__ void operator()(const f32x4 (&acc)[2][2][4][2], const Unit& u, int wr, int wc, int fr, int fq) const {
        bf16* base; int ldc; loc(u, base, ldc);
#pragma unroll
        for (int ai = 0; ai < 2; ++ai)
#pragma unroll
            for (int m = 0; m < 4; ++m) { bf16* rowp = base + (size_t)(ai * 128 + wr * 64 + m * 16 + fr) * ldc + wc * 32 + 8 * fq;
#pragma unroll
                for (int bj = 0; bj < 2; ++bj) { const f32x4 v0 = acc[ai][bj][m][0], v1 = acc[ai][bj][m][1];
                    v4u w; w.x = cvt_pk_bf16(v0[0], v0[1]); w.y = cvt_pk_bf16(v0[2], v0[3]); w.z = cvt_pk_bf16(v1[0], v1[1]); w.w = cvt_pk_bf16(v1[2], v1[3]);
                    *(v4u*)(rowp + bj * 128) = w; } }
    }
};

struct LocGV { bf16* bcat;
    __device__ __forceinline__ void operator()(const Unit& u, bf16*& base, int& ldc) const {
        const int vt = u.u0, tt = u.u1, bl = tt / NCH, e = tt % NCH, h = vt >> 1;
        base = bcat + ((size_t)((bl * 4 + h) * NCH + e) * 512 + (vt & 1) * 256) * 768; ldc = 768; } };
struct EpiGAV {
    static constexpr bool PERM = true; static constexpr bool PRE = false, KSCALE = false;
    EpiGA ga; EpiStore<LocGV> gv;
    __device__ __forceinline__ void operator()(const f32x4 (&acc)[2][2][4][2], const Unit& u, int wr, int wc, int fr, int fq) const {
        if (u.u2 == 0) ga(acc, u, wr, wc, fr, fq); else gv(acc, u, wr, wc, fr, fq); }
};
struct LocGB { bf16 *gate, *gret, *gmla;
    __device__ __forceinline__ void operator()(const Unit& u, bf16*& base, int& ldc) const {
        const int pn = u.u1; const size_t r0 = (size_t)u.u0 * 256;
        if (pn < 8) { base = gate + r0 * 2048 + pn * 256; ldc = 2048; }
        else if (pn < 12) { base = gret + r0 * 1024 + (pn - 8) * 256; ldc = 1024; }
        else { base = gmla + r0 * 1024 + (pn - 12) * 256; ldc = 1024; } } };
struct LocM3 { bf16* kv;
    __device__ __forceinline__ void operator()(const Unit& u, bf16*& base, int& ldc) const { base = kv + (size_t)u.u0 * 256 * 2048 + u.u1 * 256; ldc = 2048; } };

struct EpiM2 {
    static constexpr bool PERM = true; static constexpr bool PRE = true, KSCALE = false;
    bf16* qm; const float2* tabm; const float* ssqm;
    __device__ __forceinline__ void pre(const Unit& u, LAS unsigned char* slot, int wid) const {
        if (wid < 4) { const int rl = wid * 64 + lane_id_asm(); const float* p = ssqm + ((size_t)u.u0 * 256 + rl) * 32;
            const f32x4 a = *(const f32x4*)p, b = *(const f32x4*)(p + 4), c = *(const f32x4*)(p + 8);
            ((LAS float*)slot)[rl] = 1.0f / sqrtf(((((a.x + a.y) + (a.z + a.w)) + ((b.x + b.y) + (b.z + b.w))) + ((c.x + c.y) + (c.z + c.w))) * (1.f / 384.f) + EPS); } }
    __device__ __forceinline__ void operator()(const f32x4 (&acc)[2][2][4][2], const Unit& u, int wr, int wc, int fr, int fq, const LAS unsigned char* slot) const {
        const int pm = u.u0, pn = u.u1;
#pragma unroll
        for (int ai = 0; ai < 2; ++ai) { f32x4 csa[4][2][2];
#pragma unroll
            for (int m = 0; m < 4; ++m) { const int r = pm * 256 + ai * 128 + wr * 64 + m * 16 + fr; const int p = r % LE; const int t = p >= CTX ? p - CTX : 0;
#pragma unroll
                for (int bj = 0; bj < 2; ++bj) { const int jj = (pn * 256 + bj * 128 + wc * 32 + 8 * fq) % 192; const int pp0 = (jj >= 128 ? jj - 128 : 0) >> 1; const int pos = pp0 < 16 ? (t >> 6) : (t & 63);
                    const f32x4* tp = (const f32x4*)(tabm + pos * 16 + (pp0 & 15)); csa[m][bj][0] = tp[0]; csa[m][bj][1] = tp[1]; } }
#pragma unroll
            for (int m = 0; m < 4; ++m) {
                const int r = pm * 256 + ai * 128 + wr * 64 + m * 16 + fr;
                const int p = r % LE; const bool lat = p >= CTX;
#pragma unroll
                for (int bj = 0; bj < 2; ++bj) {
                    const int col = pn * 256 + bj * 128 + wc * 32 + 8 * fq; const int jj = col % 192;
                    const float rs = ((const LAS float*)slot)[ai * 128 + wr * 64 + m * 16 + fr];
                    const f32x4 v0 = acc[ai][bj][m][0] * rs, v1 = acc[ai][bj][m][1] * rs;
                    float o[8] = {v0[0], v0[1], v0[2], v0[3], v1[0], v1[1], v1[2], v1[3]};
                    if (jj >= 128 && lat) {
                        const f32x4 cs0 = csa[m][bj][0], cs1 = csa[m][bj][1];
                        o[0] = v0[0] * cs0[0] - v0[1] * cs0[1]; o[1] = v0[0] * cs0[1] + v0[1] * cs0[0];
                        o[2] = v0[2] * cs0[2] - v0[3] * cs0[3]; o[3] = v0[2] * cs0[3] + v0[3] * cs0[2];
                        o[4] = v1[0] * cs1[0] - v1[1] * cs1[1]; o[5] = v1[0] * cs1[1] + v1[1] * cs1[0];
                        o[6] = v1[2] * cs1[2] - v1[3] * cs1[3]; o[7] = v1[2] * cs1[3] + v1[3] * cs1[2];
                    }
                    v4u w; w.x = cvt_pk_bf16(o[0], o[1]); w.y = cvt_pk_bf16(o[2], o[3]); w.z = cvt_pk_bf16(o[4], o[5]); w.w = cvt_pk_bf16(o[6], o[7]);
                    *(v4u*)(qm + (size_t)r * 1536 + col) = w;
                }
            } }
    }
};

struct EpiM3 {
    static constexpr bool PERM = true; static constexpr bool PRE = true, KSCALE = false;
    bf16* kv; const float* ssqm;
    __device__ __forceinline__ void pre(const Unit& u, LAS unsigned char* slot, int wid) const {
        if (wid < 4) { const int rl = wid * 64 + lane_id_asm(); const float* p = ssqm + ((size_t)u.u0 * 256 + rl) * 32 + 12;
            const f32x4 a = *(const f32x4*)p, b = *(const f32x4*)(p + 4);
            ((LAS float*)slot)[rl] = 1.0f / sqrtf((((a.x + a.y) + (a.z + a.w)) + ((b.x + b.y) + (b.z + b.w))) * (1.f / 256.f) + EPS); } }
    __device__ __forceinline__ void operator()(const f32x4 (&acc)[2][2][4][2], const Unit& u, int wr, int wc, int fr, int fq, const LAS unsigned char* slot) const {
        bf16* base = kv + (size_t)u.u0 * 256 * 2048 + u.u1 * 256;
#pragma unroll
        for (int ai = 0; ai < 2; ++ai)
#pragma unroll
            for (int m = 0; m < 4; ++m) { const int rl = ai * 128 + wr * 64 + m * 16 + fr; const float rs = ((const LAS float*)slot)[rl]; bf16* rowp = base + (size_t)rl * 2048 + wc * 32 + 8 * fq;
#pragma unroll
                for (int bj = 0; bj < 2; ++bj) { const f32x4 v0 = acc[ai][bj][m][0] * rs, v1 = acc[ai][bj][m][1] * rs;
                    v4u w; w.x = cvt_pk_bf16(v0[0], v0[1]); w.y = cvt_pk_bf16(v0[2], v0[3]); w.z = cvt_pk_bf16(v1[0], v1[1]); w.w = cvt_pk_bf16(v1[2], v1[3]);
                    *(v4u*)(rowp + bj * 128) = w; } }
    }
};

struct SchedRT4 { const char* q; const char* k; int G, c;
    __device__ __forceinline__ bool next(int i, Unit& u) const {
        const int L = i * G + c; if (L >= NBG * 4 * 16) return false;
        const int e = (L & 15) + 1, h = (L >> 4) & 3, bl = L >> 6; const size_t r0 = (size_t)bl * LE + e * 256;
        u.a = q + (r0 * 1024 + h * 256) * 2; u.b = k + (r0 * 1024 + h * 256) * 2; u.u0 = (int)r0; u.u1 = h; u.u2 = 0; u.u3 = 0; return true; } };
struct EpiRT4 {
    static constexpr bool PERM = true; static constexpr bool PRE = false, KSCALE = false;
    bf16* acat; const float* lg;
    __device__ __forceinline__ void operator()(const f32x4 (&acc)[2][2][4][2], const Unit& u, int wr, int wc, int fr, int fq) const {
        const int r0 = u.u0, h = u.u1; const float lgf = lg[h], lgb = lg[4 + h];
#pragma unroll
        for (int ai = 0; ai < 2; ++ai)
#pragma unroll
            for (int m = 0; m < 4; ++m) { const int i = ai * 128 + wr * 64 + m * 16 + fr;
#pragma unroll
                for (int bj = 0; bj < 2; ++bj) { const int j0 = bj * 128 + wc * 32 + 8 * fq;
                    const f32x4 v0 = acc[ai][bj][m][0], v1 = acc[ai][bj][m][1];
                    float o[8] = {v0[0], v0[1], v0[2], v0[3], v1[0], v1[1], v1[2], v1[3]};
#pragma unroll
                    for (int x = 0; x < 8; ++x) { const int d = i - (j0 + x); const float e2 = d >= 0 ? lgf * (float)d : lgb * (float)(-d); o[x] *= __builtin_amdgcn_exp2f(e2); }
                    v4u w; w.x = cvt_pk_bf16(o[0], o[1]); w.y = cvt_pk_bf16(o[2], o[3]); w.z = cvt_pk_bf16(o[4], o[5]); w.w = cvt_pk_bf16(o[6], o[7]);
                    *(v4u*)(acat + (size_t)(r0 + i) * 3072 + h * 768 + j0) = w; } }
    }
};
struct SchedRT2 { const char* bcat; const char* kt2; int G, c;
    __device__ __forceinline__ bool next(int i, Unit& u) const {
        int L = i * G + c; if (L >= NBG * 4 * 2 * 16 * 2) return false;
        if (G == 256) L = i * 256 + (c & 7) * 32 + (c >> 3);
        const int s6 = L & 63, bh = L >> 6, h = bh & 3, bl = bh >> 2; int es, dir, pm = s6 & 1;
        if (s6 < 4) { es = 0; dir = s6 >> 1; } else if (s6 < 6) { es = 1; dir = 0; } else if (s6 < 62) { const int t = s6 - 6; es = 2 + (t >> 2); dir = (t >> 1) & 1; } else { es = 16; dir = 1; }
        const int ed = dir == 0 ? es + 1 : (es == 0 ? 16 : es - 1);
        const int ch = (bl * 4 + h) * NCH;
        u.a = bcat + (size_t)(ch + es) * BCAT_CH + (size_t)pm * 256 * 768 * 2;
        u.b = kt2 + (size_t)dir * KT2_DIR + (size_t)(ch + es) * 131072;
        u.u0 = ch + ed; u.u1 = pm; u.u2 = dir; u.u3 = 0; return true; } };
struct LocRT2 { bf16* bcat;
    __device__ __forceinline__ void operator()(const Unit& u, bf16*& base, int& ldc) const {
        base = bcat + ((size_t)u.u0 * 512 + u.u1 * 256) * 768 + 256 + u.u2 * 256; ldc = 768; } };
struct SchedRT5 { const char* acat; const char* bcat; int G, c;
    __device__ __forceinline__ bool next(int i, Unit& u) const {
        int L = i * G + c; if (L >= NBG * 4 * 16 * 2) return false;
        if (G == 256) { const int xcd = c & 7, slot = c >> 3; L = ((i * 128 + xcd * 16 + (slot >> 1)) << 1) | (slot & 1); }
        const int pn = L & 1, idx = L >> 1, e = (idx & 15) + 1, h = (idx >> 4) & 3, bl = idx >> 6; const size_t r0 = (size_t)bl * LE + e * 256;
        u.a = acat + (r0 * 3072 + h * 768) * 2; u.b = bcat + (size_t)((bl * 4 + h) * NCH + e) * BCAT_CH + (size_t)pn * 256 * 768 * 2;
        u.u0 = (int)r0; u.u1 = h * 512 + pn * 256; u.u2 = 0; u.u3 = 0; return true; } };
struct LocRT5 { bf16* o;
    __device__ __forceinline__ void operator()(const Unit& u, bf16*& base, int& ldc) const { base = o + (size_t)u.u0 * 2048 + u.u1; ldc = 2048; } };

struct EpiRT5F {
    static constexpr bool PERM = true; static constexpr bool PRE = false, KSCALE = false;
    bf16* o; const bf16* gate; float* ssq;
    __device__ __forceinline__ void operator()(const f32x4 (&acc)[2][2][4][2], const Unit& u, int wr, int wc, int fr, int fq) const {
        const int pidx = (u.u1 >> 8) * 4 + wc;
        v4u gwa[2][4][2];
#pragma unroll
        for (int ai = 0; ai < 2; ++ai)
#pragma unroll
            for (int m = 0; m < 4; ++m) { const size_t off = ((size_t)u.u0 + ai * 128 + wr * 64 + m * 16 + fr) * 2048 + u.u1 + wc * 32 + 8 * fq;
#pragma unroll
                for (int bj = 0; bj < 2; ++bj) gwa[ai][m][bj] = *(const v4u*)(gate + off + bj * 128); }
#pragma unroll
        for (int ai = 0; ai < 2; ++ai)
#pragma unroll
            for (int m = 0; m < 4; ++m) { const size_t row = (size_t)u.u0 + ai * 128 + wr * 64 + m * 16 + fr; const size_t off = row * 2048 + u.u1 + wc * 32 + 8 * fq;
                f32x2 s2 = {0.f, 0.f};
#pragma unroll
                for (int bj = 0; bj < 2; ++bj) { const f32x4 v0 = acc[ai][bj][m][0], v1 = acc[ai][bj][m][1];
                    const v4u gw = gwa[ai][m][bj];
                    const f32x2 vv[4] = {(f32x2){v0[0], v0[1]}, (f32x2){v0[2], v0[3]}, (f32x2){v1[0], v1[1]}, (f32x2){v1[2], v1[3]}}; const unsigned gd[4] = {gw.x, gw.y, gw.z, gw.w};
                    unsigned wv[4];
#pragma unroll
                    for (int q = 0; q < 4; ++q) { const f32x2 g2 = bf2x2(gd[q]); s2 += vv[q] * vv[q]; const f32x2 og = vv[q] * (g2 * sig2(g2)); wv[q] = cvt_pk_bf16(og.x, og.y); }
                    v4u w; w.x = wv[0]; w.y = wv[1]; w.z = wv[2]; w.w = wv[3];
                    *(v4u*)(o + off + bj * 128) = w; }
                float s = s2.x + s2.y;
                s += SWZ_XOR(s, 16);
                { unsigned a_ = __builtin_bit_cast(unsigned, s), b_ = a_; asm volatile("" : "+v"(b_));
                  auto rr = __builtin_amdgcn_permlane32_swap(a_, b_, false, false);
                  unsigned r0_ = rr[0], r1_ = rr[1]; asm volatile("" : "+v"(r0_), "+v"(r1_));
                  s = __builtin_bit_cast(float, r0_) + __builtin_bit_cast(float, r1_); }
                if (fq == 0) ssq[row * 32 + pidx] = s; }
    }
};
struct EpiG1 {
    static constexpr bool PERM = true; static constexpr bool PRE = true, KSCALE = true;
    const bf16* g; bf16* out; const float* ssq;
    __device__ __forceinline__ void pre(const Unit& u, LAS unsigned char* slot, int wid) const {
        if (wid < 4) { const int rl = wid * 64 + lane_id_asm(); const float* p = ssq + ((size_t)u.u0 * 256 + rl) * 32; float rs[4];
#pragma unroll
            for (int h = 0; h < 4; ++h) { const f32x4 a = *(const f32x4*)(p + h * 8), b = *(const f32x4*)(p + h * 8 + 4);
                rs[h] = 1.0f / sqrtf((((a.x + a.y) + (a.z + a.w)) + ((b.x + b.y) + (b.z + b.w))) * (1.f / 512.f) + EPS); }
            *(LAS f32x4*)(slot + rl * 16) = (f32x4){rs[0] / rs[1], rs[1] / rs[2], rs[2] / rs[3], rs[3]}; } }
    __device__ __forceinline__ void kscale(f32x4 (&acc)[2][2][4][2], int wr, int hidx, const LAS unsigned char* slot) const {
        const int fr = lane_id_asm() & 15; const LAS float* f = (const LAS float*)slot + hidx;
#pragma unroll
        for (int ai = 0; ai < 2; ++ai)
#pragma unroll
            for (int m = 0; m < 4; ++m) { const float sc = f[(ai * 128 + wr * 64 + m * 16 + fr) * 4];
#pragma unroll
                for (int bj = 0; bj < 2; ++bj)
#pragma unroll
                    for (int n = 0; n < 2; ++n) acc[ai][bj][m][n] *= sc; } }
    __device__ __forceinline__ void operator()(const f32x4 (&acc)[2][2][4][2], const Unit& u, int wr, int wc, int fr, int fq, const LAS unsigned char* slot) const {
        const LAS float* f = (const LAS float*)slot + 3;
        v4u gwa[2][4][2];
#pragma unroll
        for (int ai = 0; ai < 2; ++ai)
#pragma unroll
            for (int m = 0; m < 4; ++m) { const size_t off = (size_t)(u.u0 * 256 + ai * 128 + wr * 64 + m * 16 + fr) * 1024 + u.u1 * 256 + wc * 32 + 8 * fq;
#pragma unroll
                for (int bj = 0; bj < 2; ++bj) gwa[ai][m][bj] = *(const v4u*)(g + off + bj * 128); }
#pragma unroll
        for (int ai = 0; ai < 2; ++ai)
#pragma unroll
            for (int m = 0; m < 4; ++m) { const int rl = ai * 128 + wr * 64 + m * 16 + fr; const float sc = f[rl * 4];
                const size_t off = (size_t)(u.u0 * 256 + rl) * 1024 + u.u1 * 256 + wc * 32 + 8 * fq;
#pragma unroll
                for (int bj = 0; bj < 2; ++bj) { const f32x4 v0 = acc[ai][bj][m][0] * sc, v1 = acc[ai][bj][m][1] * sc;
                    const v4u gw = gwa[ai][m][bj];
                    const f32x2 o0 = (f32x2){v0[0], v0[1]} * sig2(bf2x2(gw.x)), o1 = (f32x2){v0[2], v0[3]} * sig2(bf2x2(gw.y)), o2 = (f32x2){v1[0], v1[1]} * sig2(bf2x2(gw.z)), o3 = (f32x2){v1[2], v1[3]} * sig2(bf2x2(gw.w));
                    v4u w; w.x = cvt_pk_bf16(o0.x, o0.y); w.y = cvt_pk_bf16(o1.x, o1.y); w.z = cvt_pk_bf16(o2.x, o2.y); w.w = cvt_pk_bf16(o3.x, o3.y);
                    *(v4u*)(out + off + bj * 128) = w; } }
    }
};

template <bool ADD>
struct EpiGate {
    static constexpr bool PERM = true; static constexpr bool PRE = false, KSCALE = false;
    const bf16* g; const bf16* prev; bf16* out;
    __device__ __forceinline__ void operator()(const f32x4 (&acc)[2][2][4][2], const Unit& u, int wr, int wc, int fr, int fq) const {
#pragma unroll
        for (int ai = 0; ai < 2; ++ai) { v4u gwa[4][2], pwa[4][2];
#pragma unroll
            for (int m = 0; m < 4; ++m) { const size_t off = (size_t)(u.u0 * 256 + ai * 128 + wr * 64 + m * 16 + fr) * 1024 + u.u1 * 256 + wc * 32 + 8 * fq;
#pragma unroll
                for (int bj = 0; bj < 2; ++bj) { gwa[m][bj] = *(const v4u*)(g + off + bj * 128); if (ADD) pwa[m][bj] = *(const v4u*)(prev + off + bj * 128); } }
#pragma unroll
            for (int m = 0; m < 4; ++m) { const size_t off = (size_t)(u.u0 * 256 + ai * 128 + wr * 64 + m * 16 + fr) * 1024 + u.u1 * 256 + wc * 32 + 8 * fq;
#pragma unroll
                for (int bj = 0; bj < 2; ++bj) { const f32x4 v0 = acc[ai][bj][m][0], v1 = acc[ai][bj][m][1];
                    const v4u gw = gwa[m][bj];
                    f32x2 o0 = (f32x2){v0[0], v0[1]} * sig2(bf2x2(gw.x)), o1 = (f32x2){v0[2], v0[3]} * sig2(bf2x2(gw.y)), o2 = (f32x2){v1[0], v1[1]} * sig2(bf2x2(gw.z)), o3 = (f32x2){v1[2], v1[3]} * sig2(bf2x2(gw.w));
                    if (ADD) { const v4u pw = pwa[m][bj]; o0 += bf2x2(pw.x); o1 += bf2x2(pw.y); o2 += bf2x2(pw.z); o3 += bf2x2(pw.w); }
                    v4u w; w.x = cvt_pk_bf16(o0.x, o0.y); w.y = cvt_pk_bf16(o1.x, o1.y); w.z = cvt_pk_bf16(o2.x, o2.y); w.w = cvt_pk_bf16(o3.x, o3.y);
                    *(v4u*)(out + off + bj * 128) = w; } } }
    }
};
struct EpiG3 {
    static constexpr bool PERM = true; static constexpr bool PRE = false, KSCALE = false;
    const float* x; const float* ada; float* out; int g0;
    __device__ __forceinline__ void operator()(const f32x4 (&acc)[2][2][4][2], const Unit& u, int wr, int wc, int fr, int fq) const {
        const int pe = u.u0, bl = pe / NCH, e = pe % NCH, b = g0 + bl;
        const float* gv = ada + (size_t)b * 6144 + 2048 + u.u1 * 256 + wc * 32 + 8 * fq;
        f32x4 gt[2][2];
#pragma unroll
        for (int bj = 0; bj < 2; ++bj)
#pragma unroll
            for (int n = 0; n < 2; ++n) gt[bj][n] = *(const f32x4*)(gv + bj * 128 + n * 4);
#pragma unroll
        for (int ai = 0; ai < 2; ++ai) { f32x4 xa[4][2][2];
#pragma unroll
            for (int m = 0; m < 4; ++m) { const size_t tok = (size_t)b * SEQ + (e - 1) * 256 + ai * 128 + wr * 64 + m * 16 + fr; const int col = u.u1 * 256 + wc * 32 + 8 * fq;
#pragma unroll
                for (int bj = 0; bj < 2; ++bj) { const float* xp = x + tok * 1024 + col + bj * 128; xa[m][bj][0] = *(const f32x4*)xp; xa[m][bj][1] = *(const f32x4*)(xp + 4); } }
#pragma unroll
            for (int m = 0; m < 4; ++m) { const size_t tok = (size_t)b * SEQ + (e - 1) * 256 + ai * 128 + wr * 64 + m * 16 + fr;
                const int col = u.u1 * 256 + wc * 32 + 8 * fq;
#pragma unroll
                for (int bj = 0; bj < 2; ++bj) {
                    const f32x4 v0 = xa[m][bj][0] + gt[bj][0] * acc[ai][bj][m][0], v1 = xa[m][bj][1] + gt[bj][1] * acc[ai][bj][m][1];
                    v4u w; w.x = cvt_pk_bf16(v0[0], v0[1]); w.y = cvt_pk_bf16(v0[2], v0[3]); w.z = cvt_pk_bf16(v1[0], v1[1]); w.w = cvt_pk_bf16(v1[2], v1[3]);
                    *(v4u*)((bf16*)(out + tok * 1024) + col + bj * 128) = w; } } }
    }
};

template <int NT>
struct SchedMoE { const char* A; const char* W; size_t wexp; const volatile LAS int* ptab; int npan, G, c;
    __device__ __forceinline__ bool next(int i, Unit& u) const {
        const int L = i * G + c; if (L >= npan * NT) return false;
        int pm, pn; pg8::tile2d(L, npan, NT, pm, pn);
        const int e = ptab[pm]; const int pl = pm - ptab[e - 48];
        u.a = A + (size_t)pm * 256 * 1024 * 2; u.b = W + (size_t)e * wexp + (size_t)pn * 256 * 1024 * 2; u.u0 = pm; u.u1 = pn; u.u2 = e; u.u3 = ptab[608 + e] - pl * 256; u.u4 = e * TLM + pl * 256; return true; } };
struct SchedMoEG { const char* gbase; const unsigned short* rowtok; const char* W; size_t wexp; const volatile LAS int* ptab; int npan, G, c, zrow;
    __device__ __forceinline__ bool next(int i, Unit& u) const {
        const int L = i * G + c; if (L >= npan * 8) return false;
        int pm, pn; pg8::tile2d(L, npan, 8, pm, pn);
        const int e = ptab[pm]; const int pl = pm - ptab[e - 48];
        u.a = gbase; u.b = W + (size_t)e * wexp + (size_t)pn * 256 * 1024 * 2; u.u0 = pm; u.u1 = pn; u.u2 = e; u.u3 = ptab[608 + e] - pl * 256; u.u4 = e * TLM + pl * 256; return true; } };
struct EpiE3 {
    static constexpr bool PERM = true; static constexpr bool PRE = false, KSCALE = false;
    bf16* act; const float* bgu;
    __device__ __forceinline__ void operator()(const f32x4 (&acc)[2][2][4][2], const Unit& u, int wr, int wc, int fr, int fq) const {
        const int jj = u.u1 * 128 + wc * 32 + 8 * fq; const float* bp = bgu + (size_t)u.u2 * 2048 + jj;
        const f32x4 bg0 = *(const f32x4*)bp, bg1 = *(const f32x4*)(bp + 4), bu0 = *(const f32x4*)(bp + 1024), bu1 = *(const f32x4*)(bp + 1028);
#pragma unroll
        for (int ai = 0; ai < 2; ++ai)
#pragma unroll
            for (int m = 0; m < 4; ++m) { const size_t row = (size_t)u.u0 * 256 + ai * 128 + wr * 64 + m * 16 + fr;
                const f32x4 gs[2] = {acc[ai][0][m][0], acc[ai][0][m][1]}, us[2] = {acc[ai][1][m][0], acc[ai][1][m][1]}, bgs[2] = {bg0, bg1}, bus[2] = {bu0, bu1};
                unsigned wv[4];
#pragma unroll
                for (int q = 0; q < 4; ++q) { const int hx = q >> 1, x0 = (q & 1) * 2;
                    const f32x2 g2 = (f32x2){gs[hx][x0], gs[hx][x0 + 1]} + (f32x2){bgs[hx][x0], bgs[hx][x0 + 1]}, u2 = (f32x2){us[hx][x0], us[hx][x0 + 1]} + (f32x2){bus[hx][x0], bus[hx][x0 + 1]};
                    const f32x2 ga = (f32x2){fminf(g2.x, 7.f), fminf(g2.y, 7.f)}, up = (f32x2){fminf(fmaxf(u2.x, -7.f), 7.f), fminf(fmaxf(u2.y, -7.f), 7.f)};
                    const f32x2 z = ga * (f32x2){-1.702f * 1.4426950408889634f, -1.702f * 1.4426950408889634f};
                    const f32x2 den = (f32x2){__builtin_amdgcn_exp2f(z.x), __builtin_amdgcn_exp2f(z.y)} + (f32x2){1.f, 1.f};
                    const f32x2 sg = (f32x2){__builtin_amdgcn_rcpf(den.x), __builtin_amdgcn_rcpf(den.y)};
                    const f32x2 o2 = (up + (f32x2){1.f, 1.f}) * (ga * sg);
                    wv[q] = cvt_pk_bf16(o2.x, o2.y); }
                v4u w; w.x = wv[0]; w.y = wv[1]; w.z = wv[2]; w.w = wv[3];
                *(v4u*)(act + row * 1024 + jj) = w; }
    }
};
struct EpiE4 {
    static constexpr bool PERM = true; static constexpr bool PRE = false, KSCALE = false;
    bf16* ys; const float* bd; const float* rowg;
    __device__ __forceinline__ void operator()(const f32x4 (&acc)[2][2][4][2], const Unit& u, int wr, int wc, int fr, int fq) const {
        const int c0 = u.u1 * 256 + wc * 32 + 8 * fq; const float* bp = bd + (size_t)u.u2 * 1024 + c0;
        f32x4 b[2][2];
#pragma unroll
        for (int bj = 0; bj < 2; ++bj) { b[bj][0] = *(const f32x4*)(bp + bj * 128); b[bj][1] = *(const f32x4*)(bp + bj * 128 + 4); }
        float rga[2][4];
#pragma unroll
        for (int ai = 0; ai < 2; ++ai)
#pragma unroll
            for (int m = 0; m < 4; ++m) rga[ai][m] = rowg[(size_t)u.u4 + ai * 128 + wr * 64 + m * 16 + fr];
#pragma unroll
        for (int ai = 0; ai < 2; ++ai)
#pragma unroll
            for (int m = 0; m < 4; ++m) { const size_t row = (size_t)u.u0 * 256 + ai * 128 + wr * 64 + m * 16 + fr; const float rg = rga[ai][m];
#pragma unroll
                for (int bj = 0; bj < 2; ++bj) { const f32x4 v0 = (acc[ai][bj][m][0] + b[bj][0]) * rg, v1 = (acc[ai][bj][m][1] + b[bj][1]) * rg;
                    v4u w; w.x = cvt_pk_bf16(v0[0], v0[1]); w.y = cvt_pk_bf16(v0[2], v0[3]); w.z = cvt_pk_bf16(v1[0], v1[1]); w.w = cvt_pk_bf16(v1[2], v1[3]);
                    *(v4u*)(ys + row * 1024 + c0 + bj * 128) = w; } }
    }
};
namespace att {
constexpr int NW = 8, QBLK = 32, KVBLK = 64;
constexpr float SCALE = 0.072168783648703220f;
constexpr float THR = 8.f;
constexpr int KROWB = 384;
constexpr size_t SHM_V = KVBLK * 128 * 2, SHM_K = KVBLK * KROWB, SHM_ATTN = 2 * SHM_V + 2 * SHM_K + NW * 64 * 4;
constexpr int OST_ROW = 72, OST_WAVE = 32 * OST_ROW * 2;
static_assert(SHM_ATTN + NW * OST_WAVE <= RING_BYTES, "attention LDS");
#define KSWZ(row, colB) ((row) * att::KROWB + ((colB) ^ (((row) & 7) << 4)))
#define SBAR() __builtin_amdgcn_sched_barrier(0)
__device__ __forceinline__ int crow(int r, int hi) { return (r & 3) + 8 * (r >> 2) + 4 * hi; }

__device__ __forceinline__ void partialSM(f32x16& p0, f32x16& p1, float& m_reg, float& mn, float& alpha) {
  constexpr float C = SCALE * 1.4426950408889634f;
  float pmax = p0[0];
#pragma unroll
  for (int r = 1; r < 16; ++r) pmax = fmaxf(pmax, p0[r]);
#pragma unroll
  for (int r = 0; r < 16; ++r) pmax = fmaxf(pmax, p1[r]);
  { unsigned a_ = __float_as_uint(pmax), b_ = a_; asm volatile("" : "+v"(b_));
    auto rr = __builtin_amdgcn_permlane32_swap(a_, b_, false, false);
    unsigned r0_ = rr[0], r1_ = rr[1]; asm volatile("" : "+v"(r0_), "+v"(r1_));
    pmax = fmaxf(__uint_as_float(r0_), __uint_as_float(r1_)); }
  if (__builtin_expect(__all(pmax - m_reg <= THR / SCALE), 1)) { mn = m_reg; alpha = 1.f; }
  else { mn = fmaxf(m_reg, pmax); alpha = __builtin_amdgcn_exp2f((m_reg - mn) * C); m_reg = mn; }
  float mnC = -mn * C;
#pragma unroll
  for (int r = 0; r < 16; ++r) p0[r] = fmaf(p0[r], C, mnC);
#pragma unroll
  for (int r = 0; r < 16; ++r) p1[r] = fmaf(p1[r], C, mnC);
#pragma unroll
  for (int r = 0; r < 16; ++r) p0[r] = __builtin_amdgcn_exp2f(p0[r]);
}
__device__ __forceinline__ void finishSM(f32x16& p0, f32x16& p1, float alpha, float& l_reg, bf16x8& pa0, bf16x8& pa1, bf16x8& pa2, bf16x8& pa3) {
#pragma unroll
  for (int r = 0; r < 16; ++r) p1[r] = __builtin_amdgcn_exp2f(p1[r]);
  float ps = 0;
#pragma unroll
  for (int r = 0; r < 16; ++r) ps += p0[r];
#pragma unroll
  for (int r = 0; r < 16; ++r) ps += p1[r];
  { unsigned a_ = __float_as_uint(ps), b_ = a_; asm volatile("" : "+v"(b_));
    auto rr = __builtin_amdgcn_permlane32_swap(a_, b_, false, false);
    unsigned r0_ = rr[0], r1_ = rr[1]; asm volatile("" : "+v"(r0_), "+v"(r1_));
    ps = __uint_as_float(r0_) + __uint_as_float(r1_); }
  l_reg = l_reg * alpha + ps;
#define PK4(P, BASE, OUT) do { unsigned a0 = cvt_pk_bf16(P[BASE + 0], P[BASE + 1]), a1 = cvt_pk_bf16(P[BASE + 2], P[BASE + 3]);   \
    unsigned b0 = cvt_pk_bf16(P[BASE + 4], P[BASE + 5]), b1 = cvt_pk_bf16(P[BASE + 6], P[BASE + 7]);                              \
    auto r0 = __builtin_amdgcn_permlane32_swap(a0, b0, false, false); auto r1 = __builtin_amdgcn_permlane32_swap(a1, b1, false, false); \
    v4u w = {r0[0], r1[0], r0[1], r1[1]}; OUT = *reinterpret_cast<bf16x8*>(&w); } while (0)
  PK4(p0, 0, pa0); PK4(p0, 8, pa1); PK4(p1, 0, pa2); PK4(p1, 8, pa3);
#undef PK4
}
__device__ __forceinline__ void qkt(f32x16& p0, f32x16& p1, const char* Ks, const bf16x8 (&qr)[12], int r32, int hi) {
  p0 = f32x16{}; p1 = f32x16{};
#pragma unroll
  for (int d0 = 0; d0 < 12; ++d0) { int cb = (d0 * 16 + hi * 8) * 2;
    bf16x8 b0 = *reinterpret_cast<const bf16x8*>(Ks + KSWZ(r32, cb));
    bf16x8 b1 = *reinterpret_cast<const bf16x8*>(Ks + KSWZ(32 + r32, cb));
    p0 = __builtin_amdgcn_mfma_f32_32x32x16_bf16(b0, qr[d0], p0, 0, 0, 0);
    p1 = __builtin_amdgcn_mfma_f32_32x32x16_bf16(b1, qr[d0], p1, 0, 0, 0); }
}
__device__ __forceinline__ int v_st(int k, int c) { const int kk = (k & ~0xC) | ((k & 4) << 1) | ((k & 8) >> 1); return ((kk >> 3) * 4 + (c >> 5)) * 512 + ((kk & 7) * 32 + (c & 31)) * 2; }
__device__ __forceinline__ int v_rd_base(int lane) { return ((lane & 3) << 3) | (((lane >> 2) & 3) << 6) | (((lane >> 4) & 1) << 5) | (((lane >> 5) & 1) << 8); }
constexpr int v_rd_off(int d0, int ks, int half) { return d0 * 512 + ks * 4096 + half * 2048; }
template <int OFF> __device__ __forceinline__ s16x4 tr_read(int vb) {
  s16x4 r; asm volatile("ds_read_b64_tr_b16 %0, %1 offset:%2" : "=&v"(r) : "v"(vb), "i"(OFF) : "memory"); return r;
}
template <int D0> __device__ __forceinline__ void pv_one(f32x16& od, int vb, bf16x8 pa0, bf16x8 pa1, bf16x8 pa2, bf16x8 pa3) {
  const s16x4 l0 = tr_read<v_rd_off(D0, 0, 0)>(vb), h0 = tr_read<v_rd_off(D0, 0, 1)>(vb), l1 = tr_read<v_rd_off(D0, 1, 0)>(vb), h1 = tr_read<v_rd_off(D0, 1, 1)>(vb);
  const s16x4 l2 = tr_read<v_rd_off(D0, 2, 0)>(vb), h2 = tr_read<v_rd_off(D0, 2, 1)>(vb), l3 = tr_read<v_rd_off(D0, 3, 0)>(vb), h3 = tr_read<v_rd_off(D0, 3, 1)>(vb);
  asm volatile("s_waitcnt lgkmcnt(0)" ::: "memory"); SBAR();
#define PK(L, H) (bf16x8){L[0], L[1], L[2], L[3], H[0], H[1], H[2], H[3]}
  od = __builtin_amdgcn_mfma_f32_32x32x16_bf16(pa0, PK(l0, h0), od, 0, 0, 0);
  od = __builtin_amdgcn_mfma_f32_32x32x16_bf16(pa1, PK(l1, h1), od, 0, 0, 0);
  od = __builtin_amdgcn_mfma_f32_32x32x16_bf16(pa2, PK(l2, h2), od, 0, 0, 0);
  od = __builtin_amdgcn_mfma_f32_32x32x16_bf16(pa3, PK(l3, h3), od, 0, 0, 0);
#undef PK
}
__device__ __forceinline__ void pv_d0(f32x16 (&o)[4], int vb, bf16x8 pa0, bf16x8 pa1, bf16x8 pa2, bf16x8 pa3) {
  pv_one<0>(o[0], vb, pa0, pa1, pa2, pa3); pv_one<1>(o[1], vb, pa0, pa1, pa2, pa3); pv_one<2>(o[2], vb, pa0, pa1, pa2, pa3); pv_one<3>(o[3], vb, pa0, pa1, pa2, pa3);
}

__device__ __forceinline__ void attn_body(const bf16* __restrict__ Qb, const bf16* __restrict__ Kn, const bf16* __restrict__ Kr, const bf16* __restrict__ Vh,
                                          bf16* __restrict__ Ob, int seq, char* lds, int tid_in) {
  constexpr int LDQ = 1536, LDKV = 2048, LDKR = 768, LDO = 1024;
  const int tid_o = tid_in * 64 + lane_id_asm();
  const int tid = tid_o, wid = tid >> 6, lane = tid & 63, r32 = lane & 31, hi = lane >> 5;
  if (tid_in >= 4) __builtin_amdgcn_s_setprio(1);
  char* V_lds = lds; char* K_lds = lds + 2 * SHM_V;
  float* ws = (float*)(lds + 2 * SHM_V + 2 * SHM_K) + wid * 64; float* li_l = ws; float* al_l = ws + 32;
  float m_reg = -1e30f, l_reg = 0; f32x16 o[4] = {}; bf16x8 qr[12];
  const bf16* Qw = Qb + (long)(wid * QBLK + r32) * LDQ + hi * 8;
#pragma unroll
  for (int d0 = 0; d0 < 12; ++d0) qr[d0] = *reinterpret_cast<const bf16x8*>(Qw + d0 * 16);
  const int sr = tid >> 4, sc = (tid & 15) * 8, vst0 = v_st(sr, sc), vst1 = v_st(32 + sr, sc);
  const int rr = tid >> 3, rc = (tid & 7) * 8;
  const int vb0 = (int)(uintptr_t)V_lds + v_rd_base(lane);
  bf16x8 vs0, vs1, ks0, ks1, kr0;
#define SLOAD(k0) do { vs0 = *(const bf16x8*)(&Vh[(long)((k0) + sr) * LDKV + sc]); vs1 = *(const bf16x8*)(&Vh[(long)((k0) + 32 + sr) * LDKV + sc]); \
    ks0 = *(const bf16x8*)(&Kn[(long)((k0) + sr) * LDKV + sc]); ks1 = *(const bf16x8*)(&Kn[(long)((k0) + 32 + sr) * LDKV + sc]); \
    kr0 = *(const bf16x8*)(&Kr[(long)((k0) + rr) * LDKR + rc]); } while (0)
#define SWRITE(b) do { *(bf16x8*)(V_lds + (b) * SHM_V + vst0) = vs0; *(bf16x8*)(V_lds + (b) * SHM_V + vst1) = vs1; int kc = sc * 2;               \
    *(bf16x8*)(K_lds + (b) * SHM_K + KSWZ(sr, kc)) = ks0; *(bf16x8*)(K_lds + (b) * SHM_K + KSWZ(32 + sr, kc)) = ks1;                              \
    *(bf16x8*)(K_lds + (b) * SHM_K + KSWZ(rr, 256 + rc * 2)) = kr0; } while (0)
#define SWAIT() asm volatile("s_waitcnt vmcnt(0)" ::: "memory")
#define RESC(a) do { if (__any((a) < 1.f)) { if (hi == 0) al_l[r32] = (a); asm volatile("s_waitcnt lgkmcnt(0)" ::: "memory"); \
    _Pragma("unroll") for (int d = 0; d < 4; ++d) _Pragma("unroll") for (int r = 0; r < 16; ++r) o[d][r] *= al_l[crow(r, hi)]; } } while (0)
  f32x16 pA0, pA1, pB0, pB1; float mnA, mnB, alA, alB; bf16x8 pa0, pa1, pa2, pa3; const int NT = seq / KVBLK;
  SLOAD(0); asm volatile("s_waitcnt vmcnt(0)" ::: "memory"); SWRITE(0); SLOAD(KVBLK); __syncthreads();
  qkt(pA0, pA1, K_lds, qr, r32, hi); partialSM(pA0, pA1, m_reg, mnA, alA);
  SWAIT(); SWRITE(1); __syncthreads();
  for (int j = 1; j + 1 < NT; j += 2) {
    SBAR(); qkt(pB0, pB1, K_lds + SHM_K, qr, r32, hi);
    finishSM(pA0, pA1, alA, l_reg, pa0, pa1, pa2, pa3); SBAR();
    SLOAD((j + 1) * KVBLK); SBAR();
    pv_d0(o, vb0, pa0, pa1, pa2, pa3); partialSM(pB0, pB1, m_reg, mnB, alB);
    __syncthreads(); SWAIT(); SWRITE(0);
    RESC(alB); __syncthreads();
    SBAR(); qkt(pA0, pA1, K_lds, qr, r32, hi);
    finishSM(pB0, pB1, alB, l_reg, pa0, pa1, pa2, pa3); SBAR();
    SLOAD((j + 2) * KVBLK); SBAR();
    pv_d0(o, vb0 + (int)SHM_V, pa0, pa1, pa2, pa3); partialSM(pA0, pA1, m_reg, mnA, alA);
    __syncthreads(); SWAIT(); SWRITE(1);
    RESC(alA); __syncthreads();
  }
  SBAR(); qkt(pB0, pB1, K_lds + SHM_K, qr, r32, hi);
  finishSM(pA0, pA1, alA, l_reg, pa0, pa1, pa2, pa3); SBAR();
  pv_d0(o, vb0, pa0, pa1, pa2, pa3); partialSM(pB0, pB1, m_reg, mnB, alB);
  __syncthreads(); RESC(alB);
  finishSM(pB0, pB1, alB, l_reg, pa0, pa1, pa2, pa3); SBAR();
  pv_d0(o, vb0 + (int)SHM_V, pa0, pa1, pa2, pa3);
  if (hi == 0) li_l[r32] = l_reg; asm volatile("s_waitcnt lgkmcnt(0)" ::: "memory");
  { const int l_e = lane_id_asm(), r32e = l_e & 31, hie = l_e >> 5;
    bf16* Obe = Ob; asm volatile("" : "+s"(Obe)); Obe = (bf16*)(GAS bf16*)(unsigned long long)Obe;
    float rli[16];
#pragma unroll
    for (int r = 0; r < 16; ++r) rli[r] = __builtin_amdgcn_rcpf(li_l[crow(r, hie)]);
    bf16* Ow = Obe + (long)(wid * QBLK) * LDO;
    unsigned short* stg = (unsigned short*)(lds + SHM_ATTN + wid * OST_WAVE);
#pragma unroll
    for (int p = 0; p < 2; ++p) {
#pragma unroll
      for (int r = 0; r < 16; ++r) { const int orow = crow(r, hie);
#pragma unroll
        for (int d = 0; d < 2; ++d) stg[orow * OST_ROW + d * 32 + r32e] = f2bf(o[2 * p + d][r] * rli[r]); }
      asm volatile("s_waitcnt lgkmcnt(0)" ::: "memory");
#pragma unroll
      for (int i = 0; i < 4; ++i) { const int row = i * 8 + (l_e >> 3), ch = l_e & 7; const v4u v = *(const v4u*)(stg + row * OST_ROW + ch * 8); *(v4u*)(Ow + (long)row * LDO + p * 64 + ch * 8) = v; }
      asm volatile("s_waitcnt lgkmcnt(0)" ::: "memory");
    } }
  __builtin_amdgcn_s_setprio(0);
#undef SLOAD
#undef SWRITE
#undef SWAIT
#undef RESC
}
}
struct Ctx {
    LAS unsigned char* lds; int tid, lane, wave, G, gw, NGW;
    __device__ __forceinline__ void* p(int i) const { asm volatile("" : "+s"(i));
        volatile LAS unsigned* T = (volatile LAS unsigned*)(lds + MISC_OFF + MISC_PT);
        const unsigned lo = __builtin_amdgcn_readfirstlane(T[2 * i]), hi = __builtin_amdgcn_readfirstlane(T[2 * i + 1]); return (void*)(GAS void*)(((unsigned long long)hi << 32) | lo); }
};

template <class Map>
__device__ __forceinline__ void transpose_item(const float* W, int K, int N, bf16* WT, const float* kscale, LAS float* scr, int item, int lane, Map map) {
    const int nblk = N / 32, kb = item / nblk, nb = item % nblk, k0 = 64 * kb, n0 = 32 * nb;
#pragma unroll 8
    for (int i = 0; i < 32; ++i) { const int kk = 2 * i + (lane >> 5); float v = W[(size_t)(k0 + kk) * N + n0 + (lane & 31)]; if (kscale) v *= kscale[k0 + kk]; scr[kk * 33 + (lane & 31)] = v; }
    LDS_WAIT(); asm volatile("" ::: "memory");
    const int c = lane & 7;
#pragma unroll
    for (int j = 0; j < 4; ++j) { const int n = (lane >> 3) + 8 * j; const LAS float* s = scr + (8 * c) * 33 + n;
        v4u o; o.x = pk2(s[0 * 33], s[1 * 33]); o.y = pk2(s[2 * 33], s[3 * 33]); o.z = pk2(s[4 * 33], s[5 * 33]); o.w = pk2(s[6 * 33], s[7 * 33]);
        const int dr = map(n0 + n);
        *(v4u*)(WT + (size_t)dr * K + k0 + 8 * c) = o; }
    LDS_WAIT(); asm volatile("" ::: "memory");
}
__device__ __forceinline__ int map_win(int n) {
    if (n < 2048) { const int seg = n >> 10, r = n & 1023, h = r >> 8, j = r & 255;
        const int jp = 2 * (64 * (j >> 7) + (j & 63)) + ((j >> 6) & 1); return seg * 1024 + h * 256 + jp; }
    if (n < 4096) return WIN_V + (n - 2048);
    if (n < 6144) return WIN_GATE + (n - 4096);
    if (n < 6528) return WIN_MLA + (n - 6144);
    if (n < 6784) return WIN_MLA + 384 + (n - 6528);
    if (n < 6848) { const int j = n - 6784; const int jp = 2 * (16 * (j >> 5) + (j & 15)) + ((j >> 4) & 1); return WIN_MLA + 640 + jp; }
    if (n < 7872) return WIN_GRET + (n - 6848);
    return WIN_GMLA + (n - 7872);
}
__device__ __forceinline__ int map_wuq(int n) { const int h = n / 192, jj = n % 192; if (jj < 128) return n; const int j = jj - 128; return h * 192 + 128 + 2 * (16 * (j >> 5) + (j & 15)) + ((j >> 4) & 1); }
__device__ __forceinline__ int map_id(int n) { return n; }
__device__ __forceinline__ int map_wgu(int n) { const int up = n >> 10, j = n & 1023; return 256 * (j >> 7) + 128 * up + (j & 127); }

__device__ __forceinline__ void p0_weights(const Ctx& C) {
    LAS float* scr = (LAS float*)(C.lds + C.wave * 16384);
    unsigned char* ws = ((unsigned char*)C.p(26));
    const float* w_in = ((const float*)C.p(8)); const float* w_uq = ((const float*)C.p(12)); const float* w_ukv = ((const float*)C.p(14)); const float* w_br = ((const float*)C.p(15)); const float* w_bm = ((const float*)C.p(16)); const float* w_o = ((const float*)C.p(17));
    const float* w_gu = ((const float*)C.p(20)); const float* w_d = ((const float*)C.p(22)); const float* qg = ((const float*)C.p(11)); const float* kvg = ((const float*)C.p(13));
    constexpr int I_IN = 16 * (8896 / 32), I_UQ = 6 * 48, I_UKV = 4 * 64, I_BR = 32 * 32, I_BM = 16 * 32, I_O = 16 * 32, I_GU1 = 16 * 64, I_D1 = 16 * 32;
    constexpr int NIT = I_IN + I_UQ + I_UKV + I_BR + I_BM + I_O + 32 * I_GU1 + 32 * I_D1;
    for (int it = C.gw; it < NIT; it += C.NGW) {
        int r = it;
        if (r < I_IN) { transpose_item(w_in, 1024, 8896, (bf16*)(ws + WS_WIN), nullptr, scr, r, C.lane, map_win); continue; } r -= I_IN;
        if (r < I_UQ) { transpose_item(w_uq, 384, 1536, (bf16*)(ws + WS_WUQ), qg, scr, r, C.lane, map_wuq); continue; } r -= I_UQ;
        if (r < I_UKV) { transpose_item(w_ukv, 256, 2048, (bf16*)(ws + WS_WUKV), kvg, scr, r, C.lane, map_id); continue; } r -= I_UKV;
        if (r < I_BR) { transpose_item(w_br, 2048, 1024, (bf16*)(ws + WS_WBR), nullptr, scr, r, C.lane, map_id); continue; } r -= I_BR;
        if (r < I_BM) { transpose_item(w_bm, 1024, 1024, (bf16*)(ws + WS_WBM), nullptr, scr, r, C.lane, map_id); continue; } r -= I_BM;
        if (r < I_O) { transpose_item(w_o, 1024, 1024, (bf16*)(ws + WS_WO), nullptr, scr, r, C.lane, map_id); continue; } r -= I_O;
        if (r < 32 * I_GU1) { const int e = r / I_GU1; transpose_item(w_gu + (size_t)e * 1024 * 2048, 1024, 2048, (bf16*)(ws + WS_WGU) + (size_t)e * 2048 * 1024, nullptr, scr, r % I_GU1, C.lane, map_wgu); continue; } r -= 32 * I_GU1;
        { const int e = r / I_D1; transpose_item(w_d + (size_t)e * 1024 * 1024, 1024, 1024, (bf16*)(ws + WS_WD) + (size_t)e * 1024 * 1024, nullptr, scr, r % I_D1, C.lane, map_id); }
    }
    { bf16* padp = (bf16*)(ws + WS_WIN) + (size_t)(WIN_MLA + 704) * 1024; const int n16 = 64 * 1024 * 2 / 16;
      for (int i = blockIdx.x * 512 + C.tid; i < n16; i += C.G * 512) ((v4u*)padp)[i] = (v4u){0u, 0u, 0u, 0u}; }
    { float2* tabr = (float2*)(ws + WS_TABR); float2* tabm = (float2*)(ws + WS_TABM); float* lg = (float*)(ws + WS_LG);
      for (int i = blockIdx.x * 512 + C.tid; i < 64 * 64 + 64 * 16 + 8; i += C.G * 512) {
        if (i < 4096) { const int pos = i >> 6, f = i & 63; const float fr = exp2f(-(float)f * (13.287712379549449f / 64.0f)); const float a = (float)pos * fr; tabr[i] = make_float2(cosf(a), sinf(a)); }
        else if (i < 4096 + 1024) { const int k = i - 4096, pos = k >> 4, f = k & 15; const float fr = exp2f(-(float)f * (13.287712379549449f / 16.0f)); const float a = (float)pos * fr; tabm[k] = make_float2(cosf(a), sinf(a)); }
        else { const int k = i - 5120; const float d = (k < 4 ? ((const float*)C.p(9)) : ((const float*)C.p(10)))[k & 3];
               lg[k] = -log2f(1.0f + expf(-d)); }
      } }
}
__device__ __forceinline__ void p0_ada(const Ctx& C) {
    if ((int)blockIdx.x >= 96) return;
    LAS float* sl = (LAS float*)C.lds;
    LAS float* red = sl + 17 * 1024;
    const float* cv = ((const float*)C.p(1)); const float* cc = ((const float*)C.p(3)); const float* aw = ((const float*)C.p(6)); const float* ab = ((const float*)C.p(7));
#pragma unroll 8
    for (int i = C.tid; i < 17 * 1024; i += 512) { const float v = i < 16 * 1024 ? cv[i] : cc[i - 16 * 1024]; sl[i] = v / (1.0f + expf(-v)); }
    __syncthreads();
    const int n = blockIdx.x * 64 + C.lane; float acc[17];
#pragma unroll
    for (int b = 0; b < 17; ++b) acc[b] = 0.f;
#pragma unroll 8
    for (int k = C.wave * 128; k < C.wave * 128 + 128; ++k) { const float w = aw[(size_t)k * 6144 + n];
#pragma unroll
        for (int b = 0; b < 17; ++b) acc[b] += sl[b * 1024 + k] * w; }
#pragma unroll
    for (int b = 0; b < 17; ++b) red[(C.wave * 17 + b) * 64 + C.lane] = acc[b];
    __syncthreads();
    float* m = (float*)(((unsigned char*)C.p(26)) + WS_ADA);
    for (int i = C.tid; i < 17 * 64; i += 512) { const int b = i >> 6, l = i & 63; float s = ab[blockIdx.x * 64 + l];
#pragma unroll
        for (int w = 0; w < 8; ++w) s += red[(w * 17 + b) * 64 + l];
        m[(size_t)b * 6144 + blockIdx.x * 64 + l] = s; }
    __syncthreads();
}

__device__ __forceinline__ const float* p1_src(const float* x, const float* ctx, int grp, int r) {
    const int bl = r / LE, p = r % LE, b = grp * NBG + bl; return p < CTX ? ctx + ((size_t)b * CTX + p) * D : x + ((size_t)b * SEQ + (p - CTX)) * D; }
__device__ __forceinline__ void p1_finish(const f32x4 (&v)[4], const float* g1, const float* ada, bf16* h, int grp, int r, int lane) {
    const int bl = r / LE, p = r % LE, b = grp * NBG + bl; const float* mod = ada + (size_t)(p < CTX ? 16 : b) * 6144;
    f32x4 ga[4], sha[4], sca[4];
#pragma unroll
    for (int j = 0; j < 4; ++j) { const int c = 4 * lane + 256 * j; ga[j] = *(const f32x4*)(g1 + c); sha[j] = *(const f32x4*)(mod + c); sca[j] = *(const f32x4*)(mod + 1024 + c); }
    float s = 0.f;
#pragma unroll
    for (int j = 0; j < 4; ++j) s += (v[j].x * v[j].x + v[j].y * v[j].y) + (v[j].z * v[j].z + v[j].w * v[j].w);
    const float rstd = 1.0f / sqrtf(wave_sum(s) * (1.f / D) + EPS);
#pragma unroll
    for (int j = 0; j < 4; ++j) { const int c = 4 * lane + 256 * j;
        const f32x4 g = ga[j], sh = sha[j], sc = sca[j];
        const f32x4 o = (v[j] * rstd * g) * (sc + 1.0f) + sh;
        v2u w; w.x = pk2(o.x, o.y); w.y = pk2(o.z, o.w); *(v2u*)(h + (size_t)r * 1024 + c) = w; }
}
__device__ __forceinline__ void p1_hext(const Ctx& C, int grp) {
    const float* x = ((const float*)C.p(0)); const float* ctx = ((const float*)C.p(2)); const float* g1 = ((const float*)C.p(4)); const float* ada = (const float*)(((unsigned char*)C.p(26)) + WS_ADA);
    bf16* h = (bf16*)(((unsigned char*)C.p(26)) + WS_ARENA + AR_H);
    for (int rA = C.gw; rA < TE; rA += 2 * C.NGW) {
        const int rB = rA + C.NGW; const bool hasB = rB < TE;
        const float* sA = p1_src(x, ctx, grp, rA); const float* sB = p1_src(x, ctx, grp, hasB ? rB : rA);
        f32x4 vA[4], vB[4];
#pragma unroll
        for (int j = 0; j < 4; ++j) { vA[j] = *(const f32x4*)(sA + 4 * C.lane + 256 * j); vB[j] = *(const f32x4*)(sB + 4 * C.lane + 256 * j); }
        p1_finish(vA, g1, ada, h, grp, rA, C.lane);
        if (hasB) p1_finish(vB, g1, ada, h, grp, rB, C.lane);
    }
}

__device__ __forceinline__ void p_kt2(const Ctx& C) {
    const bf16* k = (const bf16*)(((unsigned char*)C.p(26)) + WS_ARENA + AR_K); bf16* kt = (bf16*)(((unsigned char*)C.p(26)) + WS_ARENA + AR_KT2); const float* lg = (const float*)(((unsigned char*)C.p(26)) + WS_LG);
    LAS unsigned short* tile = (LAS unsigned short*)C.lds;
    const int nitems = NBG * 4 * NCH * 4;
    v4u wn[4];
#define KT2_LOAD(itx) do { const int db_ = (itx) & 3, chh_ = (itx) >> 2, e_ = chh_ % NCH, h_ = (chh_ / NCH) & 3, bl_ = chh_ / (NCH * 4); const size_t r0_ = (size_t)bl_ * LE + e_ * 256; \
        _Pragma("unroll") for (int i = 0; i < 4; ++i) { const int pc = C.tid + 512 * i, j = pc >> 3, dc = (pc & 7) * 8; wn[i] = *(const v4u*)(k + (r0_ + j) * 1024 + h_ * 256 + db_ * 64 + dc); } } while (0)
    if ((int)blockIdx.x < nitems) KT2_LOAD((int)blockIdx.x);
    for (int it = blockIdx.x; it < nitems; it += C.G) {
        const int db = it & 3, chh = it >> 2, e = chh % NCH, h = (chh / NCH) & 3, bl = chh / (NCH * 4); (void)e; (void)bl;
#pragma unroll
        for (int i = 0; i < 4; ++i) { const int pc = C.tid + 512 * i, j = pc >> 3, dc = (pc & 7) * 8; const v4u w = wn[i];
            LAS unsigned* tp = (LAS unsigned*)(tile + j * 66 + dc); tp[0] = w.x; tp[1] = w.y; tp[2] = w.z; tp[3] = w.w; }
        if (it + C.G < nitems) KT2_LOAD(it + C.G);
        __syncthreads();
        const float lgf = lg[h], lgb = lg[4 + h];
        const LAS unsigned* tile32 = (const LAS unsigned*)tile;
#pragma unroll
        for (int i = 0; i < 2; ++i) { const int dp = 4 * C.wave + (C.lane & 3), j0 = (16 * i + (C.lane >> 2)) * 8;
            unsigned w[8];
#pragma unroll
            for (int x = 0; x < 8; ++x) w[x] = tile32[(j0 + x) * 33 + dp];
            float f0[8], f1[8], g0[8], g1[8];
#pragma unroll
            for (int x = 0; x < 8; ++x) { const float ef = __builtin_amdgcn_exp2f(lgf * (float)(255 - (j0 + x))), eb = __builtin_amdgcn_exp2f(lgb * (float)(j0 + x)); const float lo = bflo(w[x]), hi = bfhi(w[x]);
                f0[x] = lo * ef; f1[x] = hi * ef; g0[x] = lo * eb; g1[x] = hi * eb; }
            v4u wf0, wf1, wb0, wb1;
            wf0.x = pk2(f0[0], f0[1]); wf0.y = pk2(f0[2], f0[3]); wf0.z = pk2(f0[4], f0[5]); wf0.w = pk2(f0[6], f0[7]);
            wf1.x = pk2(f1[0], f1[1]); wf1.y = pk2(f1[2], f1[3]); wf1.z = pk2(f1[4], f1[5]); wf1.w = pk2(f1[6], f1[7]);
            wb0.x = pk2(g0[0], g0[1]); wb0.y = pk2(g0[2], g0[3]); wb0.z = pk2(g0[4], g0[5]); wb0.w = pk2(g0[6], g0[7]);
            wb1.x = pk2(g1[0], g1[1]); wb1.y = pk2(g1[2], g1[3]); wb1.z = pk2(g1[4], g1[5]); wb1.w = pk2(g1[6], g1[7]);
            const size_t off = ((size_t)chh * 256 + db * 64 + 2 * dp) * 256 + j0;
            *(v4u*)(kt + off) = wf0; *(v4u*)(kt + off + 256) = wf1; *(v4u*)(kt + KT2_DIR / 2 + off) = wb0; *(v4u*)(kt + KT2_DIR / 2 + off + 256) = wb1; }
        __syncthreads();
    }
#undef KT2_LOAD
}

__device__ __forceinline__ void p_scan(const Ctx& C) {
    bf16* bcat = (bf16*)(((unsigned char*)C.p(26)) + WS_ARENA + AR_BCAT); const float* lg = (const float*)(((unsigned char*)C.p(26)) + WS_LG);
    const int nitems = NBG * 4 * 2 * 512 * 32;
    for (int it = blockIdx.x * 512 + C.tid; it < nitems; it += C.G * 512) {
        const int c8 = it & 31, dv = (it >> 5) & 511, dir = (it >> 14) & 1, bh = it >> 15, h = bh & 3;
        const float gC = __builtin_amdgcn_exp2f(lg[dir * 4 + h] * 256.0f);
        bf16* base = bcat + (size_t)bh * NCH * 512 * 768 + (size_t)dv * 768 + 256 + dir * 256 + c8 * 8;
        v4u w[16];
#pragma unroll
        for (int st = 0; st < 16; ++st) { const int e = dir == 0 ? 1 + st : 16 - st; w[st] = *(const v4u*)(base + (size_t)e * 512 * 768); }
        float s[8] = {bflo(w[0].x), bfhi(w[0].x), bflo(w[0].y), bfhi(w[0].y), bflo(w[0].z), bfhi(w[0].z), bflo(w[0].w), bfhi(w[0].w)};
#pragma unroll
        for (int st = 1; st < 16; ++st) { const int e = dir == 0 ? 1 + st : 16 - st;
            s[0] = gC * s[0] + bflo(w[st].x); s[1] = gC * s[1] + bfhi(w[st].x); s[2] = gC * s[2] + bflo(w[st].y); s[3] = gC * s[3] + bfhi(w[st].y);
            s[4] = gC * s[4] + bflo(w[st].z); s[5] = gC * s[5] + bfhi(w[st].z); s[6] = gC * s[6] + bflo(w[st].w); s[7] = gC * s[7] + bfhi(w[st].w);
            v4u o; o.x = pk2(s[0], s[1]); o.y = pk2(s[2], s[3]); o.z = pk2(s[4], s[5]); o.w = pk2(s[6], s[7]); *(v4u*)(base + (size_t)e * 512 * 768) = o; }
    }
}

__device__ __forceinline__ void rt6_finish(const v4u (&w)[4], const v4u (&gw)[4], bf16* o, size_t r, int lane) {
#pragma unroll
    for (int c = 0; c < 4; ++c) { const size_t off = r * 2048 + (size_t)(c * 64 + lane) * 8;
        float v[8] = {bflo(w[c].x), bfhi(w[c].x), bflo(w[c].y), bfhi(w[c].y), bflo(w[c].z), bfhi(w[c].z), bflo(w[c].w), bfhi(w[c].w)};
        float g[8] = {bflo(gw[c].x), bfhi(gw[c].x), bflo(gw[c].y), bfhi(gw[c].y), bflo(gw[c].z), bfhi(gw[c].z), bflo(gw[c].w), bfhi(gw[c].w)};
        float s = 0.f;
#pragma unroll
        for (int x = 0; x < 8; ++x) s += v[x] * v[x];
        const float rstd = 1.0f / sqrtf(wave_sum(s) * (1.f / 512.f) + EPS);
#pragma unroll
        for (int x = 0; x < 8; ++x) v[x] = v[x] * rstd * g[x] * fast_sigmoid(g[x]);
        v4u ow; ow.x = pk2(v[0], v[1]); ow.y = pk2(v[2], v[3]); ow.z = pk2(v[4], v[5]); ow.w = pk2(v[6], v[7]); *(v4u*)(o + off) = ow; }
}
__device__ __forceinline__ void p_rt6(const Ctx& C) {
    bf16* o = (bf16*)(((unsigned char*)C.p(26)) + WS_ARENA + AR_O); const bf16* gate = (const bf16*)(((unsigned char*)C.p(26)) + WS_ARENA + AR_GATE);
    for (int rlA = C.gw; rlA < TL; rlA += 2 * C.NGW) { const int rlB = rlA + C.NGW; const bool hasB = rlB < TL;
        const size_t rA = (size_t)(rlA >> 12) * LE + CTX + (rlA & 4095); const int rlb = hasB ? rlB : rlA; const size_t rB = (size_t)(rlb >> 12) * LE + CTX + (rlb & 4095);
        v4u wA[4], gA[4], wB[4], gB[4];
#pragma unroll
        for (int c = 0; c < 4; ++c) { const size_t oa = rA * 2048 + (size_t)(c * 64 + C.lane) * 8, ob = rB * 2048 + (size_t)(c * 64 + C.lane) * 8;
            wA[c] = *(const v4u*)(o + oa); gA[c] = *(const v4u*)(gate + oa); wB[c] = *(const v4u*)(o + ob); gB[c] = *(const v4u*)(gate + ob); }
        rt6_finish(wA, gA, o, rA, C.lane);
        if (hasB) rt6_finish(wB, gB, o, rB, C.lane);
    }
}

__device__ __forceinline__ void p_m1(const Ctx& C) {
    const bf16* mi = (const bf16*)(((unsigned char*)C.p(26)) + WS_ARENA + AR_MLAIN); bf16* mn = (bf16*)(((unsigned char*)C.p(26)) + WS_ARENA + AR_MLAN);
    for (int r0 = C.gw; r0 < TE; r0 += 4 * C.NGW) {
        unsigned w[4][5];
#pragma unroll
        for (int q = 0; q < 4; ++q) { const int r = r0 + q * C.NGW; const unsigned* src = (const unsigned*)(mi + (size_t)(r < TE ? r : r0) * 768);
#pragma unroll
            for (int i = 0; i < 5; ++i) w[q][i] = src[C.lane + 64 * i]; }
#pragma unroll
        for (int q = 0; q < 4; ++q) { const int r = r0 + q * C.NGW; float sq = 0.f, sk = 0.f;
#pragma unroll
            for (int i = 0; i < 5; ++i) { const float a = bflo(w[q][i]), b = bfhi(w[q][i]); if (i < 3) sq += a * a + b * b; else sk += a * a + b * b; }
            const float rq = 1.0f / sqrtf(wave_sum(sq) * (1.f / 384.f) + EPS), rk = 1.0f / sqrtf(wave_sum(sk) * (1.f / 256.f) + EPS);
            if (r < TE) { unsigned* dst = (unsigned*)(mn + (size_t)r * 640);
#pragma unroll
                for (int i = 0; i < 5; ++i) { const float sc = i < 3 ? rq : rk; dst[C.lane + 64 * i] = pk2(bflo(w[q][i]) * sc, bfhi(w[q][i]) * sc); } } }
    }
}
__device__ __forceinline__ void build_ptab(const Ctx& C, const unsigned* cnt) {
    volatile LAS int* T = (volatile LAS int*)(C.lds + MISC_OFF);
    __syncthreads();
    if (C.tid < NEXP) { const int c = (int)__hip_atomic_load(cnt + C.tid, RLX_AGENT); T[672 + C.tid] = c; T[640 + C.tid] = (c + 255) >> 8; }
    __syncthreads();
    if (C.tid < NEXP) { int acc = 0; for (int e = 0; e < C.tid; ++e) acc += T[640 + e]; const int np = T[640 + C.tid];
        T[16 + C.tid] = acc; for (int p = 0; p < np; ++p) T[64 + acc + p] = C.tid; if (C.tid == NEXP - 1) T[16 + NEXP] = acc + np; }
    __syncthreads();
}
#define LX1(v) __builtin_bit_cast(float, __builtin_amdgcn_update_dpp(0, __builtin_bit_cast(int, (v)), 0xB1, 0xF, 0xF, true))
#define LX2(v) __builtin_bit_cast(float, __builtin_amdgcn_update_dpp(0, __builtin_bit_cast(int, (v)), 0x4E, 0xF, 0xF, true))
#define LX8(v) __builtin_bit_cast(float, __builtin_amdgcn_update_dpp(0, __builtin_bit_cast(int, (v)), 0x128, 0xF, 0xF, true))
#define LX4(v) SWZ_XOR((v), 4)
#define LX16(v) SWZ_XOR((v), 16)
__device__ __forceinline__ float reduce32_transposed(const float (&L)[32], int lane) {
    float M[16], N[8], P[4], Q[2];
#pragma unroll
    for (int e = 0; e < 16; ++e) { unsigned a_ = __builtin_bit_cast(unsigned, L[e]), b_ = __builtin_bit_cast(unsigned, L[e + 16]);
        auto rr = __builtin_amdgcn_permlane32_swap(a_, b_, false, false); unsigned r0_ = rr[0], r1_ = rr[1]; asm volatile("" : "+v"(r0_), "+v"(r1_));
        M[e] = __builtin_bit_cast(float, r0_) + __builtin_bit_cast(float, r1_); }
    const bool b3 = (lane & 8) != 0, b2 = (lane & 4) != 0, b1 = (lane & 2) != 0;
#pragma unroll
    for (int e = 0; e < 8; ++e) { unsigned a_ = __builtin_bit_cast(unsigned, M[e]), b_ = __builtin_bit_cast(unsigned, M[e + 8]);
        auto rr = __builtin_amdgcn_permlane16_swap(a_, b_, false, false); unsigned r0_ = rr[0], r1_ = rr[1]; asm volatile("" : "+v"(r0_), "+v"(r1_));
        N[e] = __builtin_bit_cast(float, r0_) + __builtin_bit_cast(float, r1_); }
#pragma unroll
    for (int e = 0; e < 4; ++e) { const float snd = b3 ? N[e] : N[e + 4]; P[e] = (b3 ? N[e + 4] : N[e]) + LX8(snd); }
#pragma unroll
    for (int e = 0; e < 2; ++e) { const float snd = b2 ? P[e] : P[e + 2]; Q[e] = (b2 ? P[e + 2] : P[e]) + LX4(snd); }
    const float snd = b1 ? Q[0] : Q[1]; float R = (b1 ? Q[1] : Q[0]) + LX2(snd);
    R += LX1(R);
    return R;
}
__device__ __forceinline__ void e1_route_t(float v, int ridx0, bool hasB, int lane, LAS unsigned* lcnt, LAS unsigned* rec) {
    int se[4]; float sv[4]; const unsigned myi = (unsigned)lane >> 1;
    const unsigned kb = __builtin_bit_cast(unsigned, v); unsigned key = kb ^ ((unsigned)((int)kb >> 31) | 0x80000000u);
#define UX2(x) ((unsigned)__builtin_amdgcn_update_dpp(0, (int)(x), 0x4E, 0xF, 0xF, true))
#define UX8(x) ((unsigned)__builtin_amdgcn_update_dpp(0, (int)(x), 0x128, 0xF, 0xF, true))
#define UX4(x) ((unsigned)__builtin_amdgcn_update_dpp(0, __builtin_amdgcn_update_dpp(0, (int)(x), 0x141, 0xF, 0xF, true), 0x1B, 0xF, 0xF, true))
#define USWAP(x, OP, BI) { unsigned a_ = (x), b_ = a_; asm volatile("" : "+v"(b_)); auto rr = BI(a_, b_, false, false); unsigned r0_ = rr[0], r1_ = rr[1]; asm volatile("" : "+v"(r0_), "+v"(r1_)); (x) = OP(r0_, r1_); }
#define UMAX(a, b) ((a) > (b) ? (a) : (b))
#define UMIN(a, b) ((a) < (b) ? (a) : (b))
#pragma unroll
    for (int k = 0; k < 4; ++k) { unsigned mk = key;
        { const unsigned o = UX2(mk); mk = UMAX(mk, o); } { const unsigned o = UX4(mk); mk = UMAX(mk, o); } { const unsigned o = UX8(mk); mk = UMAX(mk, o); }
        USWAP(mk, UMAX, __builtin_amdgcn_permlane16_swap) USWAP(mk, UMAX, __builtin_amdgcn_permlane32_swap)
        unsigned ci = key == mk ? myi : 64u;
        { const unsigned o = UX2(ci); ci = UMIN(ci, o); } { const unsigned o = UX4(ci); ci = UMIN(ci, o); } { const unsigned o = UX8(ci); ci = UMIN(ci, o); }
        USWAP(ci, UMIN, __builtin_amdgcn_permlane16_swap) USWAP(ci, UMIN, __builtin_amdgcn_permlane32_swap)
        se[k] = (int)ci; sv[k] = __builtin_bit_cast(float, mk ^ ((mk >> 31) ? 0x80000000u : 0xFFFFFFFFu)); if (myi == ci) key = 0u; }
#undef UX2
#undef UX8
#undef UX4
#undef USWAP
#undef UMAX
#undef UMIN
    const float L2E = 1.4426950408889634f; const float e1 = __builtin_amdgcn_exp2f((sv[1] - sv[0]) * L2E), e2 = __builtin_amdgcn_exp2f((sv[2] - sv[0]) * L2E), e3 = __builtin_amdgcn_exp2f((sv[3] - sv[0]) * L2E); const float inv = __builtin_amdgcn_rcpf(1.0f + e1 + e2 + e3);
    const float gt[4] = {inv, e1 * inv, e2 * inv, e3 * inv};
    if (lane < 8 && (hasB || (lane & 1) == 0)) { const int k = lane >> 1, ridx = ridx0 + (lane & 1); const int e = k == 0 ? se[0] : k == 1 ? se[1] : k == 2 ? se[2] : se[3]; const float gk = k == 0 ? gt[0] : k == 1 ? gt[1] : k == 2 ? gt[2] : gt[3];
        const unsigned pos = __hip_atomic_fetch_add(lcnt + e, 1u, __ATOMIC_RELAXED, __HIP_MEMORY_SCOPE_WORKGROUP);
        LAS unsigned* rp = rec + (ridx * 4 + k) * 3; rp[0] = (unsigned)e; rp[1] = pos; rp[2] = __builtin_bit_cast(unsigned, gk); }
}
__device__ __forceinline__ void e1_route(const float (&lgt)[32], int ridx, int lane, LAS unsigned* lcnt, LAS unsigned* rec) {
    int se[4]; float sv[4];
#pragma unroll
    for (int k = 0; k < 4; ++k) { float best = -3.0e38f; int bi = 0;
#pragma unroll
        for (int e = 0; e < 32; ++e) { const bool taken = (k > 0 && se[0] == e) || (k > 1 && se[1] == e) || (k > 2 && se[2] == e); if (!taken && lgt[e] > best) { best = lgt[e]; bi = e; } }
        se[k] = bi; sv[k] = best; }
    const float e1 = expf(sv[1] - sv[0]), e2 = expf(sv[2] - sv[0]), e3 = expf(sv[3] - sv[0]); const float inv = 1.0f / (1.0f + e1 + e2 + e3);
    const float gt[4] = {inv, e1 * inv, e2 * inv, e3 * inv};
    if (lane < 4) { const int k = lane; const int e = k == 0 ? se[0] : k == 1 ? se[1] : k == 2 ? se[2] : se[3]; const float gk = k == 0 ? gt[0] : k == 1 ? gt[1] : k == 2 ? gt[2] : gt[3];
        const unsigned pos = __hip_atomic_fetch_add(lcnt + e, 1u, __ATOMIC_RELAXED, __HIP_MEMORY_SCOPE_WORKGROUP);
        LAS unsigned* rp = rec + (ridx * 4 + k) * 3; rp[0] = (unsigned)e; rp[1] = pos; rp[2] = __builtin_bit_cast(unsigned, gk); }
}
__device__ __forceinline__ void e1_rawload(v2u (&raw)[4], const float* x1, int grp, int tl, int lane) {
    const int bl = tl >> 12, b = grp * NBM + bl; const size_t tok = (size_t)b * SEQ + (tl & 4095);
#pragma unroll
    for (int j = 0; j < 4; ++j) raw[j] = *(const v2u*)((const bf16*)(x1 + tok * 1024) + 4 * lane + 256 * j);
}
struct E1Par { f32x4 gs[4], sha[4]; };
__device__ __forceinline__ void e1_params(E1Par& P, const float* g2, const float* ada, int grp, int tl, int lane) {
    const int bl = tl >> 12, b = grp * NBM + bl;
    const float* mod = ada + (size_t)b * 6144 + 3072;
    f32x4 ga[4], sca[4];
#pragma unroll
    for (int j = 0; j < 4; ++j) { const int c = 4 * lane + 256 * j; ga[j] = *(const f32x4*)(g2 + c); sca[j] = *(const f32x4*)(mod + 1024 + c); P.sha[j] = *(const f32x4*)(mod + c); }
#pragma unroll
    for (int j = 0; j < 4; ++j) P.gs[j] = ga[j] * (sca[j] + 1.0f);
}
__device__ __forceinline__ void e1_row(f32x4 (&v)[4], const v2u (&raw)[4], const E1Par& P, bf16* h2, int tl, int lane) {
    float s = 0.f;
#pragma unroll
    for (int j = 0; j < 4; ++j) { const v2u w = raw[j]; v[j] = (f32x4){bflo(w.x), bfhi(w.x), bflo(w.y), bfhi(w.y)}; s += (v[j].x * v[j].x + v[j].y * v[j].y) + (v[j].z * v[j].z + v[j].w * v[j].w); }
    const float rstd = __builtin_amdgcn_rsqf(wave_sum(s) * (1.f / D) + EPS);
#pragma unroll
    for (int j = 0; j < 4; ++j) { const int c = 4 * lane + 256 * j;
        v[j] = (v[j] * rstd) * P.gs[j] + P.sha[j];
        v2u w; w.x = cvt_pk_bf16(v[j].x, v[j].y); w.y = cvt_pk_bf16(v[j].z, v[j].w); *(v2u*)(h2 + (size_t)tl * 1024 + c) = w; }
}
__device__ __forceinline__ void p_e1(const Ctx& C, int grp) {
    const float* x1 = ((float*)C.p(25)); const float* g2 = ((const float*)C.p(5)); const float* ada = (const float*)(((unsigned char*)C.p(26)) + WS_ADA); const float* rwg = ((const float*)C.p(18)); const float* rb = ((const float*)C.p(19));
    bf16* h2 = (bf16*)(((unsigned char*)C.p(26)) + WS_ARENA + AR_H2); int* sel = (int*)(((unsigned char*)C.p(26)) + WS_ARENA + AR_SEL);
    unsigned* cnt = (unsigned*)(((unsigned char*)C.p(26)) + WS_CTL) + CW_CNT + grp * 64;
    LAS float* rw = (LAS float*)C.lds;
    LAS unsigned* lcnt = (LAS unsigned*)(C.lds + MISC_OFF + MISC_LCNT);
    LAS unsigned* rec = (LAS unsigned*)(C.lds + MISC_OFF + 8192);
    if (C.tid < 32) lcnt[C.tid] = 0u;
    const int tl0 = (int)blockIdx.x * 128 + 2 * C.wave; const bool live = 16 * 8 * C.G == TLM;
    E1Par P; e1_params(P, g2, ada, grp, live ? tl0 : 0, C.lane);
    const float be = rb[C.lane >> 1];
    v2u rawA[4], rawB[4];
    e1_rawload(rawA, x1, grp, live ? tl0 : 0, C.lane); e1_rawload(rawB, x1, grp, live ? tl0 + 1 : 0, C.lane);
    { f32x4 rv[16];
#pragma unroll
      for (int i = 0; i < 16; ++i) rv[i] = *(const f32x4*)(rwg + (size_t)(C.tid + 512 * i) * 4);
#pragma unroll
      for (int i = 0; i < 16; ++i) { const int q = C.tid + 512 * i, k = q >> 3, eg = q & 7; const int l = (k & 255) >> 2, j = k >> 8, c = k & 3; *(LAS f32x4*)(rw + (((j * 4 + c) * 8 + eg) * 64 + l) * 4) = rv[i]; } }
    __syncthreads();
    for (int trip = 0; live && trip < 8; ++trip) {
        const int tlA = tl0 + 16 * trip, tlB = tlA + 1; const bool hasB = true;
        f32x4 vA[4], vB[4]; v2u nxA[4], nxB[4];
        { const int nA = trip < 7 ? tlA + 16 : tlA;
          e1_rawload(nxA, x1, grp, nA, C.lane); e1_rawload(nxB, x1, grp, nA + 1, C.lane); }
        e1_row(vA, rawA, P, h2, tlA, C.lane);
        e1_row(vB, rawB, P, h2, tlB, C.lane);
        float lgA[32], lgB[32];
        { f32x4 rb0[8], rb1[8];
#define E1_LD8(buf, eg, h) _Pragma("unroll") for (int k = 0; k < 8; ++k) buf[k] = *(const LAS f32x4*)(rw + ((((h) * 8 + k) * 8 + (eg)) * 64 + C.lane) * 4);
#define E1_FM8(buf, h) _Pragma("unroll") for (int k = 0; k < 8; ++k) { const int kk = (h) * 8 + k; const float a_ = vA[kk >> 2][kk & 3], b_ = vB[kk >> 2][kk & 3];                  \
            const f32x2 r01 = {buf[k].x, buf[k].y}, r23 = {buf[k].z, buf[k].w}, a2 = {a_, a_}, b2 = {b_, b_};                                                                   \
            if (kk == 0) { aA0 = a2 * r01; aA1 = a2 * r23; aB0 = b2 * r01; aB1 = b2 * r23; }                                                                                   \
            else { aA0 = __builtin_elementwise_fma(a2, r01, aA0); aA1 = __builtin_elementwise_fma(a2, r23, aA1); aB0 = __builtin_elementwise_fma(b2, r01, aB0); aB1 = __builtin_elementwise_fma(b2, r23, aB1); } }
          E1_LD8(rb0, 0, 0)
#pragma unroll
          for (int eg = 0; eg < 8; ++eg) { f32x2 aA0, aA1, aB0, aB1;
              E1_LD8(rb1, eg, 1) __builtin_amdgcn_sched_barrier(0);
              E1_FM8(rb0, 0) __builtin_amdgcn_sched_barrier(0);
              if (eg < 7) { E1_LD8(rb0, eg + 1, 0) } __builtin_amdgcn_sched_barrier(0);
              E1_FM8(rb1, 1) __builtin_amdgcn_sched_barrier(0);
              lgA[eg * 4 + 0] = aA0.x; lgA[eg * 4 + 1] = aA0.y; lgA[eg * 4 + 2] = aA1.x; lgA[eg * 4 + 3] = aA1.y;
              lgB[eg * 4 + 0] = aB0.x; lgB[eg * 4 + 1] = aB0.y; lgB[eg * 4 + 2] = aB1.x; lgB[eg * 4 + 3] = aB1.y; }
#undef E1_LD8
#undef E1_FM8
        }
        {
          const float vA1 = reduce32_transposed(lgA, C.lane) + be, vB1 = reduce32_transposed(lgB, C.lane) + be;
          e1_route_t((C.lane & 1) ? vB1 : vA1, C.wave * 16 + 2 * trip, hasB, C.lane, lcnt, rec); }
#pragma unroll
        for (int j = 0; j < 4; ++j) { rawA[j] = nxA[j]; rawB[j] = nxB[j]; }
    }
    __syncthreads();
    if (C.tid < 32) lcnt[32 + C.tid] = __hip_atomic_fetch_add(cnt + C.tid, lcnt[C.tid], RLX_AGENT);
    __syncthreads();
    { const int i = C.tid, w = i >> 6, t = (i >> 2) & 15, k = i & 3; const int tl = (int)blockIdx.x * 128 + 16 * (t >> 1) + 2 * w + (t & 1);
      if (tl < TLM && 16 * 8 * C.G >= TLM) {
          const unsigned e = rec[i * 3], lp = rec[i * 3 + 1]; const float gk = __builtin_bit_cast(float, rec[i * 3 + 2]);
          const unsigned posg = lcnt[32 + e] + lp, d = e * (unsigned)TLM + posg;
          float* rowg = (float*)(((unsigned char*)C.p(26)) + WS_ARENA + AR_ROWG); unsigned short* rowtok = (unsigned short*)(((unsigned char*)C.p(26)) + WS_ARENA + AR_ROWTOK);
          rowtok[(d & ~127u) + 2 * (d & 63u) + ((d >> 6) & 1u)] = (unsigned short)tl; rowg[d] = gk; sel[(size_t)TLM * 12 + (size_t)tl * 4 + k] = (int)(e | (posg << 8)); } }
    if (blockIdx.x == 0 && C.tid < 128) { unsigned zz = 0u; asm volatile("" : "+v"(zz)); ((v4u*)(h2 + (size_t)TLM * 1024))[C.tid] = (v4u){zz, zz, zz, zz}; }
    __syncthreads();
}
typedef int i32x4 __attribute__((ext_vector_type(4)));
__device__ __forceinline__ void e5_load(f32x4 (&v)[4], const float* out, const float* ada, const bf16* ys, const i32x4 rec4, const volatile LAS int* T, int grp, int tl, int lane) {
    const int bl = tl >> 12, b = grp * NBM + bl; const size_t tok = (size_t)b * SEQ + (tl & 4095);
    const float* g2v = ada + (size_t)b * 6144 + 5120;
    i32x4 d4;
#pragma unroll
    for (int k = 0; k < 4; ++k) d4[k] = T[16 + (rec4[k] & 255)] * 256 + (int)((unsigned)rec4[k] >> 8);
#pragma unroll
    for (int j = 0; j < 2; ++j) { const int c = 8 * lane + 512 * j; f32x4 m0 = (f32x4){0.f, 0.f, 0.f, 0.f}, m1 = m0;
#pragma unroll
        for (int k = 0; k < 4; ++k) { const v4u w = *(const v4u*)(ys + (size_t)d4[k] * 1024 + c);
            m0 += (f32x4){bflo(w.x), bfhi(w.x), bflo(w.y), bfhi(w.y)}; m1 += (f32x4){bflo(w.z), bfhi(w.z), bflo(w.w), bfhi(w.w)}; }
        const v4u xw = *(const v4u*)((const bf16*)(out + tok * 1024) + c);
        v[2 * j] = (f32x4){bflo(xw.x), bfhi(xw.x), bflo(xw.y), bfhi(xw.y)} + *(const f32x4*)(g2v + c) * m0;
        v[2 * j + 1] = (f32x4){bflo(xw.z), bfhi(xw.z), bflo(xw.w), bfhi(xw.w)} + *(const f32x4*)(g2v + c + 4) * m1; }
}
__device__ __forceinline__ void e5_store(const f32x4 (&v)[4], float* out, const f32x4 (&fga)[4], int grp, int tl, int lane) {
    const int bl = tl >> 12, b = grp * NBM + bl; const size_t tok = (size_t)b * SEQ + (tl & 4095);
    float s = 0.f;
#pragma unroll
    for (int j = 0; j < 4; ++j) s += (v[j].x * v[j].x + v[j].y * v[j].y) + (v[j].z * v[j].z + v[j].w * v[j].w);
    const float rstd = 1.0f / sqrtf(wave_sum(s) * (1.f / D) + EPS);
#pragma unroll
    for (int j = 0; j < 4; ++j) { const int c = 8 * lane + 512 * (j >> 1) + 4 * (j & 1); *(f32x4*)(out + tok * 1024 + c) = v[j] * rstd * fga[j]; }
}
__device__ __forceinline__ void p_e5(const Ctx& C, int grp) {
    float* out = ((float*)C.p(25)); const float* ada = (const float*)(((unsigned char*)C.p(26)) + WS_ADA); const float* fg = ((const float*)C.p(24));
    const bf16* ys = (const bf16*)(((unsigned char*)C.p(26)) + WS_ARENA + AR_XS); const int* sel = (const int*)(((unsigned char*)C.p(26)) + WS_ARENA + AR_SEL);
    build_ptab(C, (const unsigned*)(((unsigned char*)C.p(26)) + WS_CTL) + CW_CNT + grp * 64);
    const volatile LAS int* T = (const volatile LAS int*)(C.lds + MISC_OFF);
    f32x4 fga[4];
#pragma unroll
    for (int j = 0; j < 4; ++j) fga[j] = *(const f32x4*)(fg + 8 * C.lane + 512 * (j >> 1) + 4 * (j & 1));
    const int* dsel = sel + (size_t)TLM * 12;
    i32x4 dA = {0, 0, 0, 0}, dB = {0, 0, 0, 0};
    if (C.gw < TLM) { dA = *(const i32x4*)(dsel + (size_t)C.gw * 4); const int tb = C.gw + C.NGW; dB = *(const i32x4*)(dsel + (size_t)(tb < TLM ? tb : C.gw) * 4); }
    for (int tlA = C.gw; tlA < TLM; tlA += 2 * C.NGW) {
        const int tlB = tlA + C.NGW; const bool hasB = tlB < TLM;
        f32x4 vA[4], vB[4];
        e5_load(vA, out, ada, ys, dA, T, grp, tlA, C.lane);
        if (hasB) e5_load(vB, out, ada, ys, dB, T, grp, tlB, C.lane);
        { const int nA = tlA + 2 * C.NGW, nB = nA + C.NGW; if (nA < TLM) { dA = *(const i32x4*)(dsel + (size_t)nA * 4); dB = *(const i32x4*)(dsel + (size_t)(nB < TLM ? nB : nA) * 4); } }
        e5_store(vA, out, fga, grp, tlA, C.lane);
        if (hasB) e5_store(vB, out, fga, grp, tlB, C.lane);
    }
}
#ifndef PH_MASK
#define PH_MASK 0xFFFFFFFFu
#endif
#define EN(k) ((PH_MASK >> (k)) & 1u)
constexpr int NM = 8, NE = 4, NSGS = 2 * NM + NE, NSTEPS = 1 + NSG * NSGS;
#ifndef MK_ONE_LAUNCH
#define MK_ONE_LAUNCH 1
#endif

__global__ void __launch_bounds__(512, 2) fwd_kernel(Params P) {
    extern __shared__ __attribute__((aligned(16))) unsigned char lds_raw[];
    Ctx C; C.lds = (LAS unsigned char*)lds_raw; C.tid = threadIdx.x; C.lane = C.tid & 63; C.wave = __builtin_amdgcn_readfirstlane(C.tid >> 6);
    C.G = gridDim.x; C.gw = blockIdx.x * 8 + C.wave; C.NGW = C.G * 8; int wave_s = C.wave;
    volatile LAS unsigned* MISC = (volatile LAS unsigned*)(C.lds + MISC_OFF);
    if (C.tid < 4) MISC[C.tid] = 0u;
    if (C.tid == 0) { volatile LAS unsigned long long* PT = (volatile LAS unsigned long long*)(C.lds + MISC_OFF + MISC_PT);
#pragma unroll
        for (int i = 0; i < 25; ++i) PT[i] = (unsigned long long)P.in[i];
        PT[25] = (unsigned long long)P.out; PT[26] = (unsigned long long)P.ws; }
    __syncthreads();
    const int lo = P.ph_lo, hi = P.ph_hi;
    if (hi - lo > 1) (void)xcd_barrier_post((unsigned*)((unsigned char*)C.p(26) + WS_CTL) + CW_BAR, MISC);
#define IN(k) (lo <= (k) && (k) < hi)
#define NOCONT pg8::Cont{nullptr, nullptr, 0, 0}
#define OPAQ() { int l_; asm volatile("v_mbcnt_lo_u32_b32 %0, -1, 0\n\tv_mbcnt_hi_u32_b32 %0, -1, %0" : "=v"(l_)); asm volatile("" : "+s"(wave_s)); \
      C.lane = l_; C.wave = wave_s; C.tid = wave_s * 64 + l_; C.gw = blockIdx.x * 8 + wave_s; } \
    unsigned char* ws = (unsigned char*)C.p(26); unsigned char* ar = ws + WS_ARENA; (void)ar; \
    const float2* tabr = (const float2*)(ws + WS_TABR); const float2* tabm = (const float2*)(ws + WS_TABM); const float* lg = (const float*)(ws + WS_LG); (void)tabr; (void)tabm; (void)lg
#define SEAM(k) do { if (IN((k) + 1)) { XcdBarrier b2_; b2_.bar = (unsigned*)((unsigned char*)C.p(26) + WS_CTL) + CW_BAR; b2_.x = xb_xcc_id(); b2_.st = MISC; xcd_barrier(b2_, wave_s * 64 + lane_id_asm()); } } while (0)
    LAS unsigned char* ring = C.lds;
    const int G = C.G, cb = (int)blockIdx.x;

    if (EN(0) && IN(0)) { OPAQ(); p0_weights(C); __syncthreads(); p0_ada(C); SEAM(0); }

    for (int sg = 0; sg < NSG; ++sg) {
      const int b0 = 1 + sg * NSGS;
      if (hi <= b0 || lo >= b0 + NSGS) continue;
      for (int gi = 0; gi < 2; ++gi) {
        const int grp = sg * 2 + gi, s0 = b0 + gi * NM;
        if (hi <= s0 || lo >= s0 + NM) continue;
        if (EN(1) && grp == 0 && IN(s0 + 0)) { OPAQ(); p1_hext(C, grp); SEAM(s0 + 0); }
        if (EN(2) && IN(s0 + 1)) { OPAQ();
            { SchedGAV S{(const char*)(ar + AR_H), (const char*)(ws + WS_WIN), G, cb};
              EpiGAV E{EpiGA{(bf16*)(ar + AR_Q), (bf16*)(ar + AR_K), (bf16*)(ar + AR_ACAT), (bf16*)(ar + AR_MLAIN), tabr, tabm, lg, (float*)(ar + AR_SSQ)}, EpiStore<LocGV>{LocGV{(bf16*)(ar + AR_BCAT)}}};
              pg8::gemm_phase<EpiGAV, SchedGAV, 1024, 1024, 16>(ring, S, E, wave_s); }
            SEAM(s0 + 1); }
        if (EN(3) && IN(s0 + 2)) { OPAQ();
            const int gemm_first = (cb >> 3) & 1;
#pragma unroll 1
            for (int half = 0; half < 2; ++half) {
                int do_gemm = (half ^ gemm_first) ^ 1; asm volatile("" : "+s"(do_gemm));
                if (!do_gemm) { int l_; asm volatile("v_mbcnt_lo_u32_b32 %0, -1, 0\n\tv_mbcnt_hi_u32_b32 %0, -1, %0" : "=v"(l_)); C.lane = l_; C.tid = wave_s * 64 + l_; p_kt2(C); }
                else {
                       Sched2D<true, false> S2{(const char*)(ar + AR_H), (const char*)(ws + WS_WIN + (size_t)WIN_GATE * 1024 * 2), (size_t)256 * 1024 * 2, (size_t)256 * 1024 * 2, TL / 256, 8, G, cb};
                       pg8::Unit nu; const bool hn = S2.next(0, nu); bool ps;
                       { SchedRT4 S{(const char*)(ar + AR_Q), (const char*)(ar + AR_K), G, cb}; EpiRT4 E{(bf16*)(ar + AR_ACAT), lg};
                         ps = pg8::gemm_phase<EpiRT4, SchedRT4, 1024, 1024, 4>(ring, S, E, wave_s, hn ? pg8::Cont{nu.a, nu.b, 1024, 1024} : NOCONT); }
                       { EpiStore<LocGB> E{LocGB{(bf16*)(ar + AR_GATE), (bf16*)(ar + AR_GRET), (bf16*)(ar + AR_GMLA)}};
                         pg8::gemm_phase<EpiStore<LocGB>, Sched2D<true, false>, 1024, 1024, 16>(ring, S2, E, wave_s, NOCONT, ps); } }
                __syncthreads();
            }
            SEAM(s0 + 2); }
        if (EN(4) && IN(s0 + 3)) { OPAQ();
            Sched2D<true, false> SM2{(const char*)(ar + AR_MLAIN), (const char*)(ws + WS_WUQ), (size_t)256 * 768 * 2, (size_t)256 * 384 * 2, TL / 256, 6, G, cb};
            Sched2D<false, false> SM3{(const char*)(ar + AR_MLAIN) + 384 * 2, (const char*)(ws + WS_WUKV), (size_t)256 * 768 * 2, (size_t)256 * 256 * 2, TE / 256, 8, G, G == 256 ? ((cb + 128) & 255) : cb};
            pg8::Unit nu2, nu3; const bool hn2 = SM2.next(0, nu2), hn3 = SM3.next(0, nu3); bool ps2, ps3;
            { SchedRT2 S{(const char*)(ar + AR_BCAT), (const char*)(ar + AR_KT2), G, cb}; EpiStore<LocRT2> E{LocRT2{(bf16*)(ar + AR_BCAT)}};
              ps2 = pg8::gemm_phase<EpiStore<LocRT2>, SchedRT2, 768, 256, 4>(ring, S, E, wave_s, hn2 ? pg8::Cont{nu2.a, nu2.b, 768, 384} : NOCONT); }
            { EpiM2 E{(bf16*)(ar + AR_QMLA), tabm, (const float*)(ar + AR_SSQ)};
              ps3 = pg8::gemm_phase<EpiM2, Sched2D<true, false>, 768, 384, 6>(ring, SM2, E, wave_s, hn3 ? pg8::Cont{nu3.a, nu3.b, 768, 256} : NOCONT, ps2); }
            { const Sched2D<false, false>& S = SM3;
              EpiM3 E{(bf16*)(ar + AR_KVMLA), (const float*)(ar + AR_SSQ)};
              pg8::gemm_phase<EpiM3, Sched2D<false, false>, 768, 256, 4>(ring, S, E, wave_s, NOCONT, ps3); }
            SEAM(s0 + 3); }
        if (EN(5) && IN(s0 + 4)) { OPAQ();
            const int att_first = (cb >> 3) & 1;
#pragma unroll 1
            for (int half = 0; half < 2; ++half) {
                int do_att = (half ^ att_first) ^ 1; asm volatile("" : "+s"(do_att));
                if (!do_att) { int l_; asm volatile("v_mbcnt_lo_u32_b32 %0, -1, 0\n\tv_mbcnt_hi_u32_b32 %0, -1, %0" : "=v"(l_)); C.lane = l_; C.tid = wave_s * 64 + l_; p_scan(C); }
                else {
                    const bf16* qm = (const bf16*)(ar + AR_QMLA); const bf16* kv = (const bf16*)(ar + AR_KVMLA); const bf16* mi = (const bf16*)(ar + AR_MLAIN); bf16* ao = (bf16*)(ar + AR_ATTO);
                    for (int it0 = cb; it0 < NBG * 8 * 16; it0 += G) {
                        int it = it0; if (G == 256) { const int xcd = cb & 7, slot = cb >> 3, hp = (it0 >> 8) * 16 + xcd * 2 + (slot >> 4); it = hp * 16 + (slot & 15); }
                        const int qb = it & 15, h = (it >> 4) & 7, bl = it >> 7; const size_t rb = (size_t)bl * LE, rq = rb + CTX + qb * 256;
                        att::attn_body(qm + rq * 1536 + h * 192, kv + rb * 2048 + h * 256, mi + rb * 768 + 640, kv + rb * 2048 + h * 256 + 128, ao + rq * 1024 + h * 128, LE, (char*)lds_raw, wave_s);
                        __syncthreads(); }
                }
                __syncthreads();
            }
            SEAM(s0 + 4); }
        if (EN(6) && IN(s0 + 5)) { OPAQ();
            Sched2D<true, false> SG{(const char*)(ar + AR_H), (const char*)(ws + WS_WIN + (size_t)WIN_GATE * 1024 * 2), (size_t)256 * 1024 * 2, (size_t)256 * 1024 * 2, TL / 256, 8, G, cb, 8};
            pg8::Unit nu; const bool hn = SG.next(0, nu); bool ps;
            { SchedRT5 S{(const char*)(ar + AR_ACAT), (const char*)(ar + AR_BCAT), G, cb}; EpiRT5F E{(bf16*)(ar + AR_O), (const bf16*)(ar + AR_GATE), (float*)(ar + AR_SSQ)};
              ps = pg8::gemm_phase<EpiRT5F, SchedRT5, 3072, 768, 12>(ring, S, E, wave_s, hn ? pg8::Cont{nu.a, nu.b, 1024, 1024} : NOCONT); }
            { EpiStore<LocGB> E{LocGB{(bf16*)(ar + AR_GATE), (bf16*)(ar + AR_GRET), (bf16*)(ar + AR_GMLA)}};
              pg8::gemm_phase<EpiStore<LocGB>, Sched2D<true, false>, 1024, 1024, 16>(ring, SG, E, wave_s, NOCONT, ps); }
            SEAM(s0 + 5); }
        if (EN(8) && IN(s0 + 6)) { OPAQ();
            Sched2D<true, false> S2{(const char*)(ar + AR_ATTO), (const char*)(ws + WS_WBM), (size_t)256 * 1024 * 2, (size_t)256 * 1024 * 2, TL / 256, 4, G, cb};
            pg8::Unit nu; const bool hn = S2.next(0, nu); bool ps;
            { Sched2D<true, false> S{(const char*)(ar + AR_O), (const char*)(ws + WS_WBR), (size_t)256 * 2048 * 2, (size_t)256 * 2048 * 2, TL / 256, 4, G, cb};
              EpiG1 E{(const bf16*)(ar + AR_GRET), (bf16*)(ar + AR_T1), (const float*)(ar + AR_SSQ)};
              ps = pg8::gemm_phase<EpiG1, Sched2D<true, false>, 2048, 2048, 32>(ring, S, E, wave_s, hn ? pg8::Cont{nu.a, nu.b, 1024, 1024} : NOCONT); }
            asm volatile("s_waitcnt vmcnt(0)" ::: "memory");
            { EpiGate<true> E{(const bf16*)(ar + AR_GMLA), (const bf16*)(ar + AR_T1), (bf16*)(ar + AR_MERGED)};
              pg8::gemm_phase<EpiGate<true>, Sched2D<true, false>, 1024, 1024, 16>(ring, S2, E, wave_s, NOCONT, ps); }
            SEAM(s0 + 6); }
        if (EN(9) && IN(s0 + 7)) { OPAQ();
            const int gemm_first = (cb >> 3) & 1;
#pragma unroll 1
            for (int half = 0; half < 2; ++half) {
                int do_gemm = (half ^ gemm_first) ^ 1; asm volatile("" : "+s"(do_gemm));
                if (do_gemm) {
                    Sched2D<true, false> S{(const char*)(ar + AR_MERGED), (const char*)(ws + WS_WO), (size_t)256 * 1024 * 2, (size_t)256 * 1024 * 2, TL / 256, 4, G, cb};
                    EpiG3 E{((const float*)C.p(0)), (const float*)(ws + WS_ADA), ((float*)C.p(25)), grp * NBG};
                    pg8::gemm_phase<EpiG3, Sched2D<true, false>, 1024, 1024, 16>(ring, S, E, wave_s); }
                else if (gi == 0) { int l_; asm volatile("v_mbcnt_lo_u32_b32 %0, -1, 0\n\tv_mbcnt_hi_u32_b32 %0, -1, %0" : "=v"(l_)); C.lane = l_; C.tid = wave_s * 64 + l_; p1_hext(C, grp + 1); }
                __syncthreads();
            }
            SEAM(s0 + 7); }
      }
      const int e0 = b0 + 2 * NM;
      if (EN(12) && IN(e0 + 0)) { OPAQ(); p_e1(C, sg); SEAM(e0 + 0); }
      if (EN(14) && IN(e0 + 1)) { OPAQ();
          const unsigned* cnt = (const unsigned*)(ws + WS_CTL) + CW_CNT + sg * 64; build_ptab(C, cnt);
          volatile LAS int* T = (volatile LAS int*)(C.lds + MISC_OFF);
          SchedMoEG S{(const char*)(ar + AR_H2), (const unsigned short*)(ar + AR_ROWTOK), (const char*)(ws + WS_WGU), (size_t)2048 * 1024 * 2, T + 64, T[16 + NEXP], G, cb, TLM};
          EpiE3 E{(bf16*)(ar + AR_ACT), ((const float*)C.p(21))};
          pg8::gemm_phase<EpiE3, SchedMoEG, 1024, 1024, 16, true, true>(ring, S, E, wave_s);
          SEAM(e0 + 1); }
      if (EN(15) && IN(e0 + 2)) { OPAQ();
          const unsigned* cnt = (const unsigned*)(ws + WS_CTL) + CW_CNT + sg * 64; build_ptab(C, cnt);
          volatile LAS int* T = (volatile LAS int*)(C.lds + MISC_OFF);
          SchedMoE<4> S{(const char*)(ar + AR_ACT), (const char*)(ws + WS_WD), (size_t)1024 * 1024 * 2, T + 64, T[16 + NEXP], G, cb};
          EpiE4 E{(bf16*)(ar + AR_XS), ((const float*)C.p(23)), (const float*)(ar + AR_ROWG)};
          pg8::gemm_phase<EpiE4, SchedMoE<4>, 1024, 1024, 16, false, true>(ring, S, E, wave_s);
          SEAM(e0 + 2); }
      if (EN(16) && IN(e0 + 3)) { OPAQ(); p_e5(C, sg); if (sg + 1 < NSG) p1_hext(C, 2 * (sg + 1)); SEAM(e0 + 3); }
    }
#undef IN
#undef NOCONT
#undef SEAM
}

extern "C" void kernel_launch(void* const* d_in, const int* in_sizes, int n_in, void* d_out, int out_size, void* d_ws, size_t ws_size, hipStream_t stream) {
    static int grid = 0;
    if (grid == 0) {
        if (n_in != 25 || in_sizes[0] != BATCH * SEQ * D || out_size != BATCH * SEQ * D || ws_size < WS_END) {
            fprintf(stderr, "kernel_launch: shape mismatch: n_in %d in0 %d out %d ws %zu (need %zu)\n", n_in, n_in > 0 ? in_sizes[0] : -1, out_size, ws_size, (size_t)WS_END); grid = -1; return; }
        int dev = 0, cus = 0, per_cu = 0;
        if (hipGetDevice(&dev) != hipSuccess || hipDeviceGetAttribute(&cus, hipDeviceAttributeMultiprocessorCount, dev) != hipSuccess) { grid = -1; return; }
        if (hipFuncSetAttribute((const void*)fwd_kernel, hipFuncAttributeMaxDynamicSharedMemorySize, LDS_BYTES) != hipSuccess) { fprintf(stderr, "kernel_launch: hipFuncSetAttribute failed\n"); grid = -1; return; }
        if (hipOccupancyMaxActiveBlocksPerMultiprocessor(&per_cu, (const void*)fwd_kernel, 512, LDS_BYTES) != hipSuccess || per_cu < 1) fprintf(stderr, "kernel_launch: occupancy query reports %d\n", per_cu);
        (void)hipGetLastError();
        grid = cus < 256 ? cus : 256;
    }
    if (grid < 0) return;
    if (hipMemsetAsync((char*)d_ws + WS_CTL, 0, CTL_ZERO_BYTES, stream) != hipSuccess) return;
    Params p{};
    for (int i = 0; i < 25; ++i) p.in[i] = (const float*)d_in[i];
    p.out = (float*)d_out; p.ws = (unsigned char*)d_ws;
#if MK_ONE_LAUNCH
    p.ph_lo = 0; p.ph_hi = NSTEPS;
    hipLaunchKernelGGL(fwd_kernel, dim3(grid), dim3(512), LDS_BYTES, stream, p);
#else
    for (int s = 0; s < NSTEPS; ++s) { p.ph_lo = s; p.ph_hi = s + 1; hipLaunchKernelGGL(fwd_kernel, dim3(grid), dim3(512), LDS_BYTES, stream, p); }
#endif
}
```

```cpp
#include <hip/hip_runtime.h>
#include <cstdio>
#include <cstdint>

#define GAS __attribute__((address_space(1)))
#define LAS __attribute__((address_space(3)))
typedef unsigned short bf16;
typedef unsigned v4u __attribute__((ext_vector_type(4)));
typedef unsigned v2u __attribute__((ext_vector_type(2)));
typedef float f32x4 __attribute__((ext_vector_type(4)));
typedef float f32x2 __attribute__((ext_vector_type(2)));
typedef float f32x16 __attribute__((ext_vector_type(16)));
typedef short bf16x8 __attribute__((ext_vector_type(8)));
typedef short s16x4 __attribute__((ext_vector_type(4)));
typedef GAS unsigned gu32;
#define RLX_AGENT __ATOMIC_RELAXED, __HIP_MEMORY_SCOPE_AGENT
#define LDS_WAIT() asm volatile("s_waitcnt lgkmcnt(0)" ::: "memory")
#define VM_WAIT() asm volatile("s_waitcnt vmcnt(0)" ::: "memory")

constexpr int D = 1024, BATCH = 16, SEQ = 4096, CTX = 256, LE = SEQ + CTX;
constexpr int NBG = 4, NGROUPS = BATCH / NBG;
constexpr int TE = NBG * LE, TL = NBG * SEQ;
constexpr int NCH = LE / 256;
constexpr int NEXP = 32, TOPK = 4;
constexpr float EPS = 1e-6f;
constexpr int NBM = 8, NSG = BATCH / NBM, TLM = NBM * SEQ;
constexpr int MOE_ROWS = TLM * TOPK + NEXP * 256;
constexpr int MAXPANELS = MOE_ROWS / 256;

__device__ __forceinline__ unsigned f2bf(float f) { unsigned u = __builtin_bit_cast(unsigned, f); return (u + 0x7fffu + ((u >> 16) & 1u)) >> 16; }
__device__ __forceinline__ unsigned cvt_pk_bf16(float lo, float hi) { unsigned r; asm volatile("v_cvt_pk_bf16_f32 %0, %1, %2" : "=v"(r) : "v"(lo), "v"(hi)); return r; }
__device__ __forceinline__ unsigned pk2(float lo, float hi) { return cvt_pk_bf16(lo, hi); }
__device__ __forceinline__ float bf2f(unsigned short b) { return __builtin_bit_cast(float, ((unsigned)b) << 16); }
__device__ __forceinline__ float bflo(unsigned w) { return __builtin_bit_cast(float, w << 16); }
__device__ __forceinline__ float bfhi(unsigned w) { return __builtin_bit_cast(float, w & 0xffff0000u); }
#define SWZ_XOR(v, k) __builtin_bit_cast(float, __builtin_amdgcn_ds_swizzle(__builtin_bit_cast(int, (v)), 0x1f | ((k) << 10)))
#define DPP_ADD(v, ctrl) (v) += __builtin_bit_cast(float, __builtin_amdgcn_update_dpp(0, __builtin_bit_cast(int, (v)), (ctrl), 0xF, 0xF, true))
__device__ __forceinline__ float wave_sum(float v) {
    DPP_ADD(v, 0xB1); DPP_ADD(v, 0x4E); DPP_ADD(v, 0x141); DPP_ADD(v, 0x140);
    v += SWZ_XOR(v, 16);
    { unsigned a_ = __builtin_bit_cast(unsigned, v), b_ = a_; asm volatile("" : "+v"(b_));
      auto rr = __builtin_amdgcn_permlane32_swap(a_, b_, false, false);
      unsigned r0_ = rr[0], r1_ = rr[1]; asm volatile("" : "+v"(r0_), "+v"(r1_));
      v = __builtin_bit_cast(float, r0_) + __builtin_bit_cast(float, r1_); }
    return v;
}
__device__ __forceinline__ float fast_sigmoid(float x) { return __builtin_amdgcn_rcpf(1.0f + __builtin_amdgcn_exp2f(-1.4426950408889634f * x)); }
__device__ __forceinline__ f32x2 sig2(f32x2 x) { const f32x2 z = x * (f32x2){-1.4426950408889634f, -1.4426950408889634f}; const f32x2 d = (f32x2){__builtin_amdgcn_exp2f(z.x), __builtin_amdgcn_exp2f(z.y)} + (f32x2){1.f, 1.f}; return (f32x2){__builtin_amdgcn_rcpf(d.x), __builtin_amdgcn_rcpf(d.y)}; }
__device__ __forceinline__ f32x2 bf2x2(unsigned u) { return (f32x2){bflo(u), bfhi(u)}; }

__device__ __forceinline__ int lane_id_asm() { int l; asm volatile("v_mbcnt_lo_u32_b32 %0, -1, 0\n\tv_mbcnt_hi_u32_b32 %0, -1, %0" : "=v"(l)); return l; }

#define XB_TMO      128
#define XB_XCNT(j)  (256  + 64 * (j))
#define XB_XSUB(j)  (1280 + 64 * (j))
#define XB_XGEN(j)  (2304 + 64 * (j))
#define XB_TOP      3328
#define XB_TOPGEN   3392
#define XCD_BAR_WORDS 3456
#define XB_SPIN_CAP (1u << 22)

__device__ __forceinline__ unsigned xb_ld(unsigned* p)              { return __hip_atomic_load(p, __ATOMIC_RELAXED, __HIP_MEMORY_SCOPE_AGENT); }
__device__ __forceinline__ unsigned xb_add(unsigned* p, unsigned v) { return __hip_atomic_fetch_add(p, v, __ATOMIC_RELAXED, __HIP_MEMORY_SCOPE_AGENT); }
__device__ __forceinline__ unsigned xb_xcc_id() { return (unsigned)__builtin_amdgcn_s_getreg((3 << 11) | 20) & 0xFu; }
#define XB_SPIN(cond, bar) do { unsigned _sp = 0; while (cond) { __builtin_amdgcn_s_sleep(1); \
    if ((++_sp & 255u) == 0u) { if (xb_ld(&(bar)[XB_TMO])) break; if (_sp > XB_SPIN_CAP) { atomicAdd(&(bar)[XB_TMO], 1u); break; } } } } while (0)

struct XcdBarrier { unsigned* bar; unsigned x; volatile LAS unsigned* st; };

__device__ __forceinline__ XcdBarrier xcd_barrier_post(unsigned* bar, volatile LAS unsigned* st) {
    XcdBarrier b; b.bar = bar; b.x = xb_xcc_id(); b.st = st;
    if (threadIdx.x == 0) (void)xb_add(&bar[XB_XCNT(b.x)], 1u);
    return b;
}
__device__ __forceinline__ void xcd_barrier_complete(unsigned* bar, unsigned x, unsigned& nloc, unsigned& nx) {
    const unsigned G = gridDim.x * gridDim.y * gridDim.z;
    unsigned sum, cnt, mine, sp = 0u;
    for (;;) {
        sum = 0u; cnt = 0u; mine = 0u;
#pragma unroll
        for (unsigned j = 0; j < 16; ++j) { const unsigned c = xb_ld(&bar[XB_XCNT(j)]); sum += c; cnt += (c > 0u) ? 1u : 0u; mine = (j == x) ? c : mine; }
        if (sum == G) break;
        __builtin_amdgcn_s_sleep(1);
        if ((++sp & 255u) == 0u) { if (xb_ld(&bar[XB_TMO])) break; if (sp > XB_SPIN_CAP) { atomicAdd(&bar[XB_TMO], 1u); break; } }
    }
    nloc = mine > 0u ? mine : 1u; nx = cnt > 0u ? cnt : 1u;
}
__device__ __forceinline__ void xcd_barrier(const XcdBarrier& b, int tid_b) {
    asm volatile("s_waitcnt vmcnt(0)" ::: "memory");
    __syncthreads();
    if (tid_b == 0) {
        unsigned* bar = b.bar;
        __builtin_amdgcn_s_waitcnt(0);
        unsigned nloc = b.st[0], nx = b.st[1];
        if (nloc == 0u) { xcd_barrier_complete(bar, b.x, nloc, nx); b.st[0] = nloc; b.st[1] = nx; }
        const unsigned old = xb_add(&bar[XB_XSUB(b.x)], 1u);
        const unsigned gen = old / nloc;
        if (old + 1u == (gen + 1u) * nloc) {
            __builtin_amdgcn_fence(__ATOMIC_RELEASE, "agent");
            asm volatile("s_waitcnt vmcnt(0)" ::: "memory");
            const unsigned og = xb_add(&bar[XB_TOP], 1u);
            const unsigned tg = og / nx;
            if (og + 1u == (tg + 1u) * nx) xb_add(&bar[XB_TOPGEN], 1u);
            else XB_SPIN(xb_ld(&bar[XB_TOPGEN]) == tg, bar);
            __builtin_amdgcn_fence(__ATOMIC_ACQUIRE, "agent");
            xb_add(&bar[XB_XGEN(b.x)], 1u);
            asm volatile("s_waitcnt vmcnt(0)" ::: "memory");
        } else {
            XB_SPIN(xb_ld(&bar[XB_XGEN(b.x)]) == gen, bar);
            __builtin_amdgcn_fence(__ATOMIC_ACQUIRE, "agent");
            asm volatile("s_waitcnt vmcnt(0)" ::: "memory");
        }
    }
    __syncthreads();
}

namespace pg8 {
constexpr int BM = 256, BK = 64, HALF = 128, HTB = HALF * BK * 2, STAGE_BYTES = 8 * HTB, NXCD = 8, WGM = 8;
constexpr int EPI_SLOT_OFF = STAGE_BYTES + 8192, EPI_SLOT_BYTES = 4096;
__host__ __device__ __forceinline__ int lds_byte(int r, int c) { const int pos = ((c >> 3) & 3) ^ (((r >> 2) & 1) << 1); return (r >> 3) * 1024 + ((c >> 5) & 1) * 512 + (r & 7) * 64 + pos * 16 + (c & 7) * 2; }
__host__ __device__ __forceinline__ void stage_rc(int b, int& R, int& C) { const int p = b / 1024, sb = b % 1024, pos = (sb >> 4) & 3; R = p * 8 + ((sb >> 6) & 7); C = (sb >> 9) * 32 + ((pos ^ (((R >> 2) & 1) << 1)) * 8) + (sb & 15) / 2; }
__host__ __device__ __forceinline__ int perm32(int rho) { const int n = rho >> 4, i = rho & 15; return 8 * (i >> 2) + 4 * n + (i & 3); }

struct Unit { const char* a; const char* b; int u0, u1, u2, u3, u4; };

__device__ __forceinline__ void tile2d(int L, int nM, int nN, int& pm, int& pn) {
    const int nwg = nM * nN; int wgid = L;
    { const int q = nwg / NXCD, r = nwg % NXCD, xcd = wgid % NXCD, off = wgid / NXCD; wgid = (xcd < r ? xcd * (q + 1) : r * (q + 1) + (xcd - r) * q) + off; }
    const int nig = WGM * nN, gid = wgid / nig, fm = gid * WGM, gsz = (nM - fm) < WGM ? (nM - fm) : WGM;
    pm = fm + ((wgid % nig) % gsz); pn = (wgid % nig) / gsz;
}

struct Cont { const char* a; const char* b; int lda, ldb; };
template <class Epi, class Sched, int LDA, int LDB, int KT, bool GATHER = false, bool STAGGER = false>
__device__ __forceinline__ bool gemm_phase(LAS unsigned char* lds, const Sched& S, const Epi& E, int tid_in, const Cont cont = Cont{nullptr, nullptr, 0, 0}, const bool prestaged = false) {
    static_assert(KT >= 4 && (KT % 2) == 0, "K multiple of 128, >= 256");
    const int tid_o = tid_in * 64 + lane_id_asm();
    const int tid = tid_o, wid = __builtin_amdgcn_readfirstlane(tid >> 6), lane = tid & 63, wr = wid >> 2, wc = wid & 3, fr = lane & 15, fq = lane >> 4;
    constexpr int nt = KT;
    unsigned voffA[2], voffB[2];
#pragma unroll
    for (int i = 0; i < 2; ++i) { int R, C; stage_rc(tid * 16 + i * 8192, R, C); const int Rb = Epi::PERM ? ((R & ~31) + perm32(R & 31)) : R;
        voffA[i] = (unsigned)(R * LDA + C) * 2u; voffB[i] = (unsigned)(Rb * LDB + C) * 2u; }
    constexpr size_t kstep = (size_t)(BK * 2);
    size_t hstepA = (size_t)HALF * LDA * 2, hstepB = (size_t)HALF * LDB * 2;
    const unsigned ldsw = (unsigned)wid * 1024u;
    const int aoff = lds_byte(wr * 64 + fr, fq * 8), boff = lds_byte(wc * 32 + fr, fq * 8);
#define PG8_SA(b, h) (((b) * 2 + (h)) * HTB)
#define PG8_SB(b, h) ((4 + (b) * 2 + (h)) * HTB)
#define PG8_STAGE(bufoff, gbase, voff) do { const char* _b = (const char*)(gbase); asm volatile("" : "+s"(_b)); _Pragma("unroll") for (int _i = 0; _i < 2; ++_i) { unsigned _v = (voff)[_i]; asm volatile("" : "+v"(_v)); \
        __builtin_amdgcn_global_load_lds((const unsigned*)(_b + _v), (LAS unsigned*)(lds + (bufoff) + ldsw + _i * 8192), 16, 0, 0); } } while (0)
    unsigned ogc[2] = {0u, 0u}, ogn[2] = {0u, 0u}; const unsigned gpk = (voffA[0] / (unsigned)(LDA * 2)) | ((voffA[0] % (unsigned)(LDA * 2)) << 8);
#define PG8_LOAD_OG(og, un) do { if constexpr (GATHER) { unsigned _g = gpk; asm volatile("" : "+v"(_g)); const int rA0 = (int)(_g & 255u); _Pragma("unroll") for (int _h = 0; _h < 2; ++_h) { const unsigned* _q = (const unsigned*)S.rowtok + ((((un).u4 + 128 * _h) >> 1) + rA0); unsigned _x; \
        asm volatile("global_load_dword %0, %1, off" : "=v"(_x) : "v"(_q) : "memory"); og[_h] = _x; } } } while (0)
#define PG8_MASK_OG(p, rem, h) ([&](unsigned _pp, int _rem, int _hh) { unsigned _gg = gpk; asm volatile("" : "+v"(_gg)); const int _r = (int)(_gg & 255u) + 128 * _hh; return ((_r < _rem) ? (_pp & 0xffffu) : (unsigned)S.zrow) | (((_r + 64 < _rem) ? (_pp >> 16) : (unsigned)S.zrow) << 16); }((p), (rem), (h)))
#define PG8_STAGE_A(bufoff, base, h, nx) do { if constexpr (GATHER) { const char* _bg = (const char*)(base); asm volatile("" : "+s"(_bg)); unsigned _pn = ogn[h], _g = gpk; asm volatile("" : "+v"(_pn), "+v"(_g)); const unsigned _p = (nx) ? PG8_MASK_OG(_pn, nxt.u3, h) : ogc[h], cbA = _g >> 8; \
        __builtin_amdgcn_global_load_lds((const unsigned*)(_bg + (size_t)((_p & 0xffffu) * (unsigned)(LDA * 2) + cbA)), (LAS unsigned*)(lds + (bufoff) + ldsw), 16, 0, 0); \
        __builtin_amdgcn_global_load_lds((const unsigned*)(_bg + (size_t)((_p >> 16) * (unsigned)(LDA * 2) + cbA)), (LAS unsigned*)(lds + (bufoff) + ldsw + 8192), 16, 0, 0); } \
        else { PG8_STAGE(bufoff, (base) + (h) * hstepA, voffA); } } while (0)
#define PG8_LDA(dst, b, h) do { _Pragma("unroll") for (int m = 0; m < 4; ++m) _Pragma("unroll") for (int k = 0; k < 2; ++k) dst[m][k] = *(const LAS bf16x8*)(lds + PG8_SA(b, h) + aoff + m * 2048 + k * 512); } while (0)
#define PG8_LDB(dst, b, h) do { _Pragma("unroll") for (int n = 0; n < 2; ++n) _Pragma("unroll") for (int k = 0; k < 2; ++k) dst[n][k] = *(const LAS bf16x8*)(lds + PG8_SB(b, h) + boff + n * 2048 + k * 512); } while (0)
#define PG8_MMA(ai, bj, At, Bt) do { __builtin_amdgcn_s_setprio(1); _Pragma("unroll") for (int m = 0; m < 4; ++m) _Pragma("unroll") for (int n = 0; n < 2; ++n) _Pragma("unroll") for (int k = 0; k < 2; ++k) \
        acc[ai][bj][m][n] = __builtin_amdgcn_mfma_f32_16x16x32_bf16(Bt[n][k], At[m][k], acc[ai][bj][m][n], 0, 0, 0); __builtin_amdgcn_s_setprio(0); } while (0)
#define PG8_WAIT_V(n) asm volatile("s_waitcnt vmcnt(" #n ")" ::: "memory")
#define PG8_WAIT_L(n) asm volatile("s_waitcnt lgkmcnt(" #n ")" ::: "memory")
#define PG8_BAR __builtin_amdgcn_s_barrier()
#define PG8_SCHED __builtin_amdgcn_sched_barrier(0)
    Unit cur, nxt; int ui = 0;
    if (!S.next(0, cur)) return false;
    bool cont_done = false;
    f32x4 acc[2][2][4][2];
#pragma unroll
    for (int a = 0; a < 2; ++a)
#pragma unroll
        for (int b = 0; b < 2; ++b)
#pragma unroll
            for (int m = 0; m < 4; ++m)
#pragma unroll
                for (int n = 0; n < 2; ++n) acc[a][b][m][n] = (f32x4){0.f, 0.f, 0.f, 0.f};
    bf16x8 At[4][2], B0[2][2], B1[2][2];
    const char* cA; if constexpr (GATHER) cA = S.gbase; else cA = cur.a;
    const char* cB = cur.b;
    PG8_LOAD_OG(ogc, cur);
    if constexpr (GATHER) { asm volatile("s_waitcnt vmcnt(0)" : "+v"(ogc[0]), "+v"(ogc[1]) :: "memory"); ogc[0] = PG8_MASK_OG(ogc[0], cur.u3, 0); ogc[1] = PG8_MASK_OG(ogc[1], cur.u3, 1); }
    if constexpr (STAGGER) { const int stag = ((int)blockIdx.x >> 3) & 3; for (int i = 0; i < stag; ++i) __builtin_amdgcn_s_sleep(45); }
    if (!prestaged) {
    PG8_STAGE(PG8_SB(0, 0), cB, voffB); PG8_STAGE(PG8_SB(0, 1), cB + hstepB, voffB); PG8_STAGE_A(PG8_SA(0, 0), cA, 0, false); PG8_STAGE_A(PG8_SA(0, 1), cA, 1, false);
    PG8_STAGE(PG8_SB(1, 0), cB + kstep, voffB); PG8_STAGE_A(PG8_SA(1, 0), cA + kstep, 0, false); PG8_STAGE(PG8_SB(1, 1), cB + hstepB + kstep, voffB); }
    if (wr == 1) PG8_BAR;
    PG8_WAIT_V(8); PG8_BAR;
    PG8_WAIT_V(6); PG8_BAR;
    for (;;) {
        if constexpr (Epi::PRE) { cur.u3 = ui & 1; E.pre(cur, lds + EPI_SLOT_OFF + (ui & 1) * EPI_SLOT_BYTES, wid); }
        const bool has_next = S.next(ui + 1, nxt);
        const char* nA; if constexpr (GATHER) nA = cA; else nA = has_next ? nxt.a : cA;
        const char* nB = has_next ? nxt.b : cB;
        const bool use_cont = !GATHER && !has_next && cont.a != nullptr;
        if constexpr (GATHER) { if (has_next) { PG8_LOAD_OG(ogn, nxt); } else { ogn[0] = ogc[0]; ogn[1] = ogc[1]; } }
#pragma unroll 1
        for (int t = 0; t < nt; t += 2) {
            const bool last = (t == nt - 2);
            if constexpr (Epi::KSCALE) { if (t != 0 && (t & 7) == 0) E.kscale(acc, wr, (t >> 3) - 1, lds + EPI_SLOT_OFF + cur.u3 * EPI_SLOT_BYTES); }
            const char* a1 = cA + (size_t)(t + 1) * kstep;
            PG8_LDB(B0, 0, 0); PG8_LDB(B1, 0, 1); PG8_SCHED; PG8_LDA(At, 0, 0); PG8_STAGE_A(PG8_SA(1, 1), a1, 1, false);
            if (last && use_cont) {
                const int tid2 = wid * 64 + lane_id_asm();
#pragma unroll
                for (int i = 0; i < 2; ++i) { int R, C; stage_rc(tid2 * 16 + i * 8192, R, C); const int Rb = Epi::PERM ? ((R & ~31) + perm32(R & 31)) : R;
                    voffA[i] = (unsigned)(R * cont.lda + C) * 2u; voffB[i] = (unsigned)(Rb * cont.ldb + C) * 2u; }
                hstepA = (size_t)HALF * cont.lda * 2; hstepB = (size_t)HALF * cont.ldb * 2; nA = cont.a; nB = cont.b; cont_done = true; }
            const char* a2 = last ? nA : cA + (size_t)(t + 2) * kstep; const char* b2 = last ? nB : cB + (size_t)(t + 2) * kstep;
            const char* a3 = a2 + kstep; const char* b3 = b2 + kstep;
            PG8_WAIT_V(8); PG8_WAIT_L(0); PG8_BAR; PG8_MMA(0, 0, At, B0); PG8_MMA(0, 1, At, B1); PG8_BAR; PG8_SCHED;
            PG8_LDA(At, 0, 1); PG8_STAGE(PG8_SB(0, 0), b2, voffB); PG8_STAGE(PG8_SB(0, 1), b2 + hstepB, voffB); PG8_STAGE_A(PG8_SA(0, 0), a2, 0, last);
            PG8_WAIT_V(8); PG8_WAIT_L(0); PG8_BAR; PG8_MMA(1, 0, At, B0); PG8_MMA(1, 1, At, B1); PG8_BAR; PG8_SCHED;
            PG8_LDB(B0, 1, 0); PG8_LDB(B1, 1, 1); PG8_SCHED; PG8_LDA(At, 1, 0); PG8_STAGE_A(PG8_SA(0, 1), a2, 1, last);
            PG8_WAIT_V(8); PG8_WAIT_L(0); PG8_BAR; PG8_MMA(0, 0, At, B0); PG8_MMA(0, 1, At, B1); PG8_BAR; PG8_SCHED;
            PG8_LDA(At, 1, 1); PG8_STAGE(PG8_SB(1, 0), b3, voffB); PG8_STAGE(PG8_SB(1, 1), b3 + hstepB, voffB); PG8_STAGE_A(PG8_SA(1, 0), a3, 0, last);
            PG8_WAIT_V(8); PG8_WAIT_L(0); PG8_BAR; PG8_MMA(1, 0, At, B0); PG8_MMA(1, 1, At, B1); PG8_BAR; PG8_SCHED;
        }
        if (wr == 0) PG8_BAR;
        { const int l_e = lane_id_asm(); int wr_e = wr, wc_e = wc, fr_e = l_e & 15, fq_e = l_e >> 4; asm volatile("" : "+s"(wr_e), "+s"(wc_e));
          if constexpr (Epi::PRE) E(acc, cur, wr_e, wc_e, fr_e, fq_e, lds + EPI_SLOT_OFF + cur.u3 * EPI_SLOT_BYTES); else E(acc, cur, wr_e, wc_e, fr_e, fq_e); }
        if (!has_next) break;
#pragma unroll
        for (int a = 0; a < 2; ++a)
#pragma unroll
            for (int b = 0; b < 2; ++b)
#pragma unroll
                for (int m = 0; m < 4; ++m)
#pragma unroll
                    for (int n = 0; n < 2; ++n) acc[a][b][m][n] = (f32x4){0.f, 0.f, 0.f, 0.f};
        cur = nxt; cA = nA; cB = nB; ++ui;
        if constexpr (GATHER) { ogc[0] = PG8_MASK_OG(ogn[0], cur.u3, 0); ogc[1] = PG8_MASK_OG(ogn[1], cur.u3, 1); }
        if (wr == 1) PG8_BAR;
    }
    PG8_WAIT_V(0);
    PG8_BAR;
    return cont_done;
#undef PG8_SA
#undef PG8_SB
#undef PG8_STAGE
#undef PG8_STAGE_A
#undef PG8_LOAD_OG
#undef PG8_MASK_OG
#undef PG8_LDA
#undef PG8_LDB
#undef PG8_MMA
#undef PG8_WAIT_V
#undef PG8_WAIT_L
#undef PG8_BAR
#undef PG8_SCHED
}
}
constexpr size_t MiB = 1u << 20;
constexpr size_t WS_CTL = 0, CTL_ZERO_BYTES = 1 * MiB;
constexpr size_t WS_ADA = 1 * MiB;
constexpr size_t WS_TABR = WS_ADA + 512 * 1024;
constexpr size_t WS_TABM = WS_TABR + 64 * 64 * 8;
constexpr size_t WS_LG = WS_TABM + 64 * 16 * 8;
constexpr size_t WS_WIN = 2 * MiB;
constexpr int    WIN_ROWS = 8960, WIN_Q = 0, WIN_K = 1024, WIN_MLA = 2048, WIN_V = 2816, WIN_GATE = 4864, WIN_GRET = 6912, WIN_GMLA = 7936;
constexpr size_t WS_WUQ = WS_WIN + (size_t)WIN_ROWS * 1024 * 2;
constexpr size_t WS_WUKV = WS_WUQ + (size_t)1536 * 384 * 2;
constexpr size_t WS_WBR = WS_WUKV + (size_t)2048 * 256 * 2;
constexpr size_t WS_WBM = WS_WBR + (size_t)1024 * 2048 * 2;
constexpr size_t WS_WO = WS_WBM + (size_t)1024 * 1024 * 2;
constexpr size_t WS_WGU = WS_WO + (size_t)1024 * 1024 * 2;
constexpr size_t WS_WD = WS_WGU + (size_t)32 * 2048 * 1024 * 2;
constexpr size_t WS_WEND = WS_WD + (size_t)32 * 1024 * 1024 * 2;
constexpr size_t WS_ARENA = (WS_WEND + MiB - 1) / MiB * MiB;
constexpr size_t AR_H = 0;
constexpr size_t AR_MLAIN = AR_H + (size_t)TE * 1024 * 2;
constexpr size_t AR_O = AR_MLAIN + (size_t)TE * 768 * 2;
constexpr size_t AR_Q = AR_O + (size_t)TE * 2048 * 2;
constexpr size_t AR_K = AR_Q + (size_t)TE * 1024 * 2;
constexpr size_t AR_ACAT = AR_K + (size_t)TE * 1024 * 2;
constexpr size_t AR_KT2 = AR_ACAT + (size_t)TE * 3072 * 2;
constexpr size_t KT2_DIR = (size_t)NBG * 4 * NCH * 256 * 256 * 2;
constexpr size_t AR_BCAT = AR_KT2 + 2 * KT2_DIR;
constexpr size_t BCAT_CH = (size_t)512 * 768 * 2;
constexpr size_t AR_MLAN = AR_BCAT + (size_t)NBG * 4 * NCH * BCAT_CH;
constexpr size_t AR_ATTO = AR_MLAN + (size_t)TE * 640 * 2;
constexpr size_t AR_GATE = AR_ATTO + (size_t)TE * 1024 * 2;
constexpr size_t AR_SSQ = AR_GATE + (size_t)TE * 2048 * 2;
constexpr size_t AR_END1 = AR_SSQ + (size_t)TE * 32 * 4;
constexpr size_t AR_QMLA = AR_O;
constexpr size_t AR_KVMLA = AR_Q;
constexpr size_t AR_GRET = AR_KT2;
constexpr size_t AR_GMLA = AR_GRET + (size_t)TE * 1024 * 2;
constexpr size_t AR_T1 = AR_ACAT;
constexpr size_t AR_MERGED = AR_T1 + (size_t)TE * 1024 * 2;
static_assert(AR_QMLA + (size_t)TE * 1536 * 2 <= AR_Q, "q_mla over o");
static_assert(AR_KVMLA + (size_t)TE * 2048 * 2 <= AR_ACAT, "kv_mla / gate over q,k");
static_assert(AR_GMLA + (size_t)TE * 1024 * 2 <= AR_BCAT, "g over kt2");
static_assert(AR_MERGED + (size_t)TE * 1024 * 2 <= AR_KT2, "t1/merged over acat");
constexpr size_t AR_H2 = 0;
constexpr size_t AR_XS = AR_H2 + (size_t)(TLM + 8) * 1024 * 2;
constexpr size_t AR_ACT = AR_XS + (size_t)MOE_ROWS * 1024 * 2;
constexpr size_t AR_SEL = AR_ACT + (size_t)MOE_ROWS * 1024 * 2;
constexpr size_t AR_ROWG = AR_SEL + (size_t)TLM * 4 * 4 * 4;
constexpr size_t AR_ROWTOK = AR_ROWG + (size_t)NEXP * TLM * 4;
constexpr size_t AR_END2 = AR_ROWTOK + (size_t)NEXP * TLM * 2;
constexpr size_t AR_SIZE = (AR_END1 > AR_END2 ? AR_END1 : AR_END2);
constexpr size_t WS_END = WS_ARENA + AR_SIZE;
constexpr int CW_BAR = 4096;
constexpr int CW_CNT = 16384;
constexpr int CW_BBASE = 32768;

constexpr int RING_BYTES = 131072;
constexpr int MISC_OFF = RING_BYTES; static_assert(pg8::EPI_SLOT_OFF == RING_BYTES + 8192 && pg8::STAGE_BYTES == RING_BYTES && RING_BYTES + 8192 + 2 * pg8::EPI_SLOT_BYTES <= 147456, "epilogue operand slots");
constexpr int MISC_LCNT = 3072, MISC_PT = 4096;
constexpr int LDS_BYTES = 147456;

struct Params {
    const float* in[25];
    float* out;
    unsigned char* ws;
    int ph_lo, ph_hi;
};
using pg8::Unit;
__device__ __forceinline__ int lat_panel_to_ext(int pml) { return (pml >> 4) * NCH + (pml & 15) + 1; }

template <bool LAT_A, bool LAT_B>
struct Sched2D {
    const char* A; const char* B; size_t sa, sb; int nM, nN, G, c, n0 = 0;
    __device__ __forceinline__ bool next(int i, Unit& u) const {
        const int L = i * G + c; if (L >= nM * nN) return false;
        int pm, pn; pg8::tile2d(L, nM, nN, pm, pn); pn += n0;
        const int am = LAT_A ? lat_panel_to_ext(pm) : pm, bn = LAT_B ? lat_panel_to_ext(pn) : pn;
        u.a = A + (size_t)am * sa; u.b = B + (size_t)bn * sb; u.u0 = am; u.u1 = bn; u.u2 = 0; u.u3 = 0; return true;
    }
};

struct EpiGA {
    static constexpr bool PERM = true; static constexpr bool PRE = false, KSCALE = false;
    bf16 *q, *k, *acat, *mlain; const float2* tabr; const float2* tabm; const float* lg; float* ssqm;
    __device__ __forceinline__ void operator()(const f32x4 (&acc)[2][2][4][2], const Unit& u, int wr, int wc, int fr, int fq) const {
        const int pm = u.u0, pn = u.u1;
        if (pn < 8) {
            const int h = pn & 3; const bool isq = pn < 4;
            const float lgf = lg[h], lgb = lg[4 + h];
#pragma unroll
            for (int ai = 0; ai < 2; ++ai) { f32x4 csa[4][2][2];
#pragma unroll
                for (int m = 0; m < 4; ++m) { const int r = pm * 256 + ai * 128 + wr * 64 + m * 16 + fr; const int p = r % LE; const int t = p >= CTX ? p - CTX : 0;
#pragma unroll
                    for (int bj = 0; bj < 2; ++bj) { const int pos = bj == 0 ? (t >> 6) : (t & 63); const f32x4* tp = (const f32x4*)(tabr + pos * 64 + 16 * wc + 4 * fq); csa[m][bj][0] = tp[0]; csa[m][bj][1] = tp[1]; } }
#pragma unroll
                for (int m = 0; m < 4; ++m) {
                    const int r = pm * 256 + ai * 128 + wr * 64 + m * 16 + fr;
                    const int p = r % LE; const bool lat = p >= CTX;
                    const int iloc = p & 255;
                    const float sf = isq ? __builtin_amdgcn_exp2f(lgf * (float)(iloc + 1)) : 0.0625f;
                    const float sb = __builtin_amdgcn_exp2f(lgb * (float)(256 - iloc));
#pragma unroll
                    for (int bj = 0; bj < 2; ++bj) {
                        f32x4 cs0 = csa[m][bj][0], cs1 = csa[m][bj][1];
                        if (!lat) { cs0 = (f32x4){1.f, 0.f, 1.f, 0.f}; cs1 = cs0; }
                        const f32x4 v0 = acc[ai][bj][m][0], v1 = acc[ai][bj][m][1];
                        float o[8];
                        o[0] = v0[0] * cs0[0] - v0[1] * cs0[1]; o[1] = v0[0] * cs0[1] + v0[1] * cs0[0];
                        o[2] = v0[2] * cs0[2] - v0[3] * cs0[3]; o[3] = v0[2] * cs0[3] + v0[3] * cs0[2];
                        o[4] = v1[0] * cs1[0] - v1[1] * cs1[1]; o[5] = v1[0] * cs1[1] + v1[1] * cs1[0];
                        o[6] = v1[2] * cs1[2] - v1[3] * cs1[3]; o[7] = v1[2] * cs1[3] + v1[3] * cs1[2];
                        const int col = bj * 128 + wc * 32 + 8 * fq;
                        if (isq) {
                            v4u w; w.x = cvt_pk_bf16(o[0], o[1]); w.y = cvt_pk_bf16(o[2], o[3]); w.z = cvt_pk_bf16(o[4], o[5]); w.w = cvt_pk_bf16(o[6], o[7]);
                            *(v4u*)(q + (size_t)r * 1024 + h * 256 + col) = w;
                            v4u wf; wf.x = cvt_pk_bf16(o[0] * sf, o[1] * sf); wf.y = cvt_pk_bf16(o[2] * sf, o[3] * sf); wf.z = cvt_pk_bf16(o[4] * sf, o[5] * sf); wf.w = cvt_pk_bf16(o[6] * sf, o[7] * sf);
                            *(v4u*)(acat + (size_t)r * 3072 + h * 768 + 256 + col) = wf;
                            v4u wb; wb.x = cvt_pk_bf16(o[0] * sb, o[1] * sb); wb.y = cvt_pk_bf16(o[2] * sb, o[3] * sb); wb.z = cvt_pk_bf16(o[4] * sb, o[5] * sb); wb.w = cvt_pk_bf16(o[6] * sb, o[7] * sb);
                            *(v4u*)(acat + (size_t)r * 3072 + h * 768 + 512 + col) = wb;
                        } else {
                            v4u w; w.x = cvt_pk_bf16(o[0] * sf, o[1] * sf); w.y = cvt_pk_bf16(o[2] * sf, o[3] * sf); w.z = cvt_pk_bf16(o[4] * sf, o[5] * sf); w.w = cvt_pk_bf16(o[6] * sf, o[7] * sf);
                            *(v4u*)(k + (size_t)r * 1024 + h * 256 + col) = w;
                        }
                    }
                } }
        } else {
            const int c0 = (pn - 8) * 256;
#pragma unroll
            for (int ai = 0; ai < 2; ++ai)
#pragma unroll
                for (int m = 0; m < 4; ++m) {
                    const int r = pm * 256 + ai * 128 + wr * 64 + m * 16 + fr;
                    const int p = r % LE; const bool lat = p >= CTX; const int t = lat ? p - CTX : 0;
#pragma unroll
                    for (int bj = 0; bj < 2; ++bj) {
                        const int col = c0 + bj * 128 + wc * 32 + 8 * fq;
                        const f32x4 v0 = acc[ai][bj][m][0], v1 = acc[ai][bj][m][1];
                        float o[8] = {v0[0], v0[1], v0[2], v0[3], v1[0], v1[1], v1[2], v1[3]};
                        if (col >= 640 && col < 704 && lat) {
                            const int pp0 = (col - 640) >> 1; const int pos = pp0 < 16 ? (t >> 6) : (t & 63);
                            const f32x4* tp = (const f32x4*)(tabm + pos * 16 + (pp0 & 15));
                            const f32x4 cs0 = tp[0], cs1 = tp[1];
                            o[0] = v0[0] * cs0[0] - v0[1] * cs0[1]; o[1] = v0[0] * cs0[1] + v0[1] * cs0[0];
                            o[2] = v0[2] * cs0[2] - v0[3] * cs0[3]; o[3] = v0[2] * cs0[3] + v0[3] * cs0[2];
                            o[4] = v1[0] * cs1[0] - v1[1] * cs1[1]; o[5] = v1[0] * cs1[1] + v1[1] * cs1[0];
                            o[6] = v1[2] * cs1[2] - v1[3] * cs1[3]; o[7] = v1[2] * cs1[3] + v1[3] * cs1[2];
                        }
                        v4u w; w.x = cvt_pk_bf16(o[0], o[1]); w.y = cvt_pk_bf16(o[2], o[3]); w.z = cvt_pk_bf16(o[4], o[5]); w.w = cvt_pk_bf16(o[6], o[7]);
                        *(v4u*)(mlain + (size_t)r * 768 + col) = w;
                        const int blk = (c0 >> 7) + bj;
                        if (blk < 5) { float sq = 0.f;
#pragma unroll
                            for (int x = 0; x < 8; ++x) sq += o[x] * o[x];
                            sq += SWZ_XOR(sq, 16);
                            { unsigned a_ = __builtin_bit_cast(unsigned, sq), b_ = a_; asm volatile("" : "+v"(b_));
                              auto rr = __builtin_amdgcn_permlane32_swap(a_, b_, false, false);
                              unsigned r0_ = rr[0], r1_ = rr[1]; asm volatile("" : "+v"(r0_), "+v"(r1_));
                              sq = __builtin_bit_cast(float, r0_) + __builtin_bit_cast(float, r1_); }
                            if (fq == 0) ssqm[(size_t)r * 32 + blk * 4 + wc] = sq; }
                    }
                }
        }
    }
};

struct SchedGAV { const char* H; const char* W; int G, c;
    __device__ __forceinline__ bool next(int i, Unit& u) const {
        const int L = i * G + c; int pm, pn;
        if (L < 476) { pg8::tile2d(L, TE / 256, 7, pm, pn); pn += 4; u.u2 = 0; }
        else if (L < 732) { pg8::tile2d(L - 476, TL / 256, 4, pm, pn); pm = lat_panel_to_ext(pm); u.u2 = 0; }
        else if (L < 1276) { pg8::tile2d(L - 732, 8, TE / 256, pm, pn); u.u2 = 1; }
        else return false;
        if (u.u2 == 0) { u.a = H + (size_t)pm * 256 * 1024 * 2; u.b = W + (size_t)pn * 256 * 1024 * 2; }
        else { u.a = W + (size_t)(WIN_V + pm * 256) * 1024 * 2; u.b = H + (size_t)pn * 256 * 1024 * 2; }
        u.u0 = pm; u.u1 = pn; u.u3 = 0; return true; } };

template <class Loc>
struct EpiStore {
    static constexpr bool PERM = true; static constexpr bool PRE = false, KSCALE = false;
    Loc loc;
    __device__ __forceinline__ void operator()(const f32x4 (&acc)[2][2][4][2], const Unit& u, int wr, int wc, int fr, int fq) const {
        bf16* base; int ldc; loc(u, base, ldc);
#pragma unroll
        for (int ai = 0; ai < 2; ++ai)
#pragma unroll
            for (int m = 0; m < 4; ++m) { bf16* rowp = base + (size_t)(ai * 128 + wr * 64 + m * 16 + fr) * ldc + wc * 32 + 8 * fq;
#pragma unroll
                for (int bj = 0; bj < 2; ++bj) { const f32x4 v0 = acc[ai][bj][m][0], v1 = acc[ai][bj][m][1];
                    v4u w; w.x = cvt_pk_bf16(v0[0], v0[1]); w.y = cvt_pk_bf16(v0[2], v0[3]); w.z = cvt_pk_bf16(v1[0], v1[1]); w.w = cvt_pk_bf16(v1[2], v1[3]);
                    *(v4u*)(rowp + bj * 128) = w; } }
    }
};

struct LocGV { bf16* bcat;
    __device__ __forceinline__ void operator()(const Unit& u, bf16*& base, int& ldc) const {
        const int vt = u.u0, tt = u.u1, bl = tt / NCH, e = tt % NCH, h = vt >> 1;
        base = bcat + ((size_t)((bl * 4 + h) * NCH + e) * 512 + (vt & 1) * 256) * 768; ldc = 768; } };
struct EpiGAV {
    static constexpr bool PERM = true; static constexpr bool PRE = false, KSCALE = false;
    EpiGA ga; EpiStore<LocGV> gv;
    __device__ __forceinline__ void operator()(const f32x4 (&acc)[2][2][4][2], const Unit& u, int wr, int wc, int fr, int fq) const {
        if (u.u2 == 0) ga(acc, u, wr, wc, fr, fq); else gv(acc, u, wr, wc, fr, fq); }
};
struct LocGB { bf16 *gate, *gret, *gmla;
    __device__ __forceinline__ void operator()(const Unit& u, bf16*& base, int& ldc) const {
        const int pn = u.u1; const size_t r0 = (size_t)u.u0 * 256;
        if (pn < 8) { base = gate + r0 * 2048 + pn * 256; ldc = 2048; }
        else if (pn < 12) { base = gret + r0 * 1024 + (pn - 8) * 256; ldc = 1024; }
        else { base = gmla + r0 * 1024 + (pn - 12) * 256; ldc = 1024; } } };
struct LocM3 { bf16* kv;
    __device__ __forceinline__ void operator()(const Unit& u, bf16*& base, int& ldc) const { base = kv + (size_t)u.u0 * 256 * 2048 + u.u1 * 256; ldc = 2048; } };

struct EpiM2 {
    static constexpr bool PERM = true; static constexpr bool PRE = true, KSCALE = false;
    bf16* qm; const float2* tabm; const float* ssqm;
    __device__ __forceinline__ void pre(const Unit& u, LAS unsigned char* slot, int wid) const {
        if (wid < 4) { const int rl = wid * 64 + lane_id_asm(); const float* p = ssqm + ((size_t)u.u0 * 256 + rl) * 32;
            const f32x4 a = *(const f32x4*)p, b = *(const f32x4*)(p + 4), c = *(const f32x4*)(p + 8);
            ((LAS float*)slot)[rl] = 1.0f / sqrtf(((((a.x + a.y) + (a.z + a.w)) + ((b.x + b.y) + (b.z + b.w))) + ((c.x + c.y) + (c.z + c.w))) * (1.f / 384.f) + EPS); } }
    __device__ __forceinline__ void operator()(const f32x4 (&acc)[2][2][4][2], const Unit& u, int wr, int wc, int fr, int fq, const LAS unsigned char* slot) const {
        const int pm = u.u0, pn = u.u1;
#pragma unroll
        for (int ai = 0; ai < 2; ++ai) { f32x4 csa[4][2][2];
#pragma unroll
            for (int m = 0; m < 4; ++m) { const int r = pm * 256 + ai * 128 + wr * 64 + m * 16 + fr; const int p = r % LE; const int t = p >= CTX ? p - CTX : 0;
#pragma unroll
                for (int bj = 0; bj < 2; ++bj) { const int jj = (pn * 256 + bj * 128 + wc * 32 + 8 * fq) % 192; const int pp0 = (jj >= 128 ? jj - 128 : 0) >> 1; const int pos = pp0 < 16 ? (t >> 6) : (t & 63);
                    const f32x4* tp = (const f32x4*)(tabm + pos * 16 + (pp0 & 15)); csa[m][bj][0] = tp[0]; csa[m][bj][1] = tp[1]; } }
#pragma unroll
            for (int m = 0; m < 4; ++m) {
                const int r = pm * 256 + ai * 128 + wr * 64 + m * 16 + fr;
                const int p = r % LE; const bool lat = p >= CTX;
#pragma unroll
                for (int bj = 0; bj < 2; ++bj) {
                    const int col = pn * 256 + bj * 128 + wc * 32 + 8 * fq; const int jj = col % 192;
                    const float rs = ((const LAS float*)slot)[ai * 128 + wr * 64 + m * 16 + fr];
                    const f32x4 v0 = acc[ai][bj][m][0] * rs, v1 = acc[ai][bj][m][1] * rs;
                    float o[8] = {v0[0], v0[1], v0[2], v0[3], v1[0], v1[1], v1[2], v1[3]};
                    if (jj >= 128 && lat) {
                        const f32x4 cs0 = csa[m][bj][0], cs1 = csa[m][bj][1];
                        o[0] = v0[0] * cs0[0] - v0[1] * cs0[1]; o[1] = v0[0] * cs0[1] + v0[1] * cs0[0];
                        o[2] = v0[2] * cs0[2] - v0[3] * cs0[3]; o[3] = v0[2] * cs0[3] + v0[3] * cs0[2];
                        o[4] = v1[0] * cs1[0] - v1[1] * cs1[1]; o[5] = v1[0] * cs1[1] + v1[1] * cs1[0];
                        o[6] = v1[2] * cs1[2] - v1[3] * cs1[3]; o[7] = v1[2] * cs1[3] + v1[3] * cs1[2];
                    }
                    v4u w; w.x = cvt_pk_bf16(o[0], o[1]); w.y = cvt_pk_bf16(o[2], o[3]); w.z = cvt_pk_bf16(o[4], o[5]); w.w = cvt_pk_bf16(o[6], o[7]);
                    *(v4u*)(qm + (size_t)r * 1536 + col) = w;
                }
            } }
    }
};

struct EpiM3 {
    static constexpr bool PERM = true; static constexpr bool PRE = true, KSCALE = false;
    bf16* kv; const float* ssqm;
    __device__ __forceinline__ void pre(const Unit& u, LAS unsigned char* slot, int wid) const {
        if (wid < 4) { const int rl = wid * 64 + lane_id_asm(); const float* p = ssqm + ((size_t)u.u0 * 256 + rl) * 32 + 12;
            const f32x4 a = *(const f32x4*)p, b = *(const f32x4*)(p + 4);
            ((LAS float*)slot)[rl] = 1.0f / sqrtf((((a.x + a.y) + (a.z + a.w)) + ((b.x + b.y) + (b.z + b.w))) * (1.f / 256.f) + EPS); } }
    __device__ __forceinline__ void operator()(const f32x4 (&acc)[2][2][4][2], const Unit& u, int wr, int wc, int fr, int fq, const LAS unsigned char* slot) const {
        bf16* base = kv + (size_t)u.u0 * 256 * 2048 + u.u1 * 256;
#pragma unroll
        for (int ai = 0; ai < 2; ++ai)
#pragma unroll
            for (int m = 0; m < 4; ++m) { const int rl = ai * 128 + wr * 64 + m * 16 + fr; const float rs = ((const LAS float*)slot)[rl]; bf16* rowp = base + (size_t)rl * 2048 + wc * 32 + 8 * fq;
#pragma unroll
                for (int bj = 0; bj < 2; ++bj) { const f32x4 v0 = acc[ai][bj][m][0] * rs, v1 = acc[ai][bj][m][1] * rs;
                    v4u w; w.x = cvt_pk_bf16(v0[0], v0[1]); w.y = cvt_pk_bf16(v0[2], v0[3]); w.z = cvt_pk_bf16(v1[0], v1[1]); w.w = cvt_pk_bf16(v1[2], v1[3]);
                    *(v4u*)(rowp + bj * 128) = w; } }
    }
};

struct SchedRT4 { const char* q; const char* k; int G, c;
    __device__ __forceinline__ bool next(int i, Unit& u) const {
        const int L = i * G + c; if (L >= NBG * 4 * 16) return false;
        const int e = (L & 15) + 1, h = (L >> 4) & 3, bl = L >> 6; const size_t r0 = (size_t)bl * LE + e * 256;
        u.a = q + (r0 * 1024 + h * 256) * 2; u.b = k + (r0 * 1024 + h * 256) * 2; u.u0 = (int)r0; u.u1 = h; u.u2 = 0; u.u3 = 0; return true; } };
struct EpiRT4 {
    static constexpr bool PERM = true; static constexpr bool PRE = false, KSCALE = false;
    bf16* acat; const float* lg;
    __device__ __forceinline__ void operator()(const f32x4 (&acc)[2][2][4][2], const Unit& u, int wr, int wc, int fr, int fq) const {
        const int r0 = u.u0, h = u.u1; const float lgf = lg[h], lgb = lg[4 + h];
#pragma unroll
        for (int ai = 0; ai < 2; ++ai)
#pragma unroll
            for (int m = 0; m < 4; ++m) { const int i = ai * 128 + wr * 64 + m * 16 + fr;
#pragma unroll
                for (int bj = 0; bj < 2; ++bj) { const int j0 = bj * 128 + wc * 32 + 8 * fq;
                    const f32x4 v0 = acc[ai][bj][m][0], v1 = acc[ai][bj][m][1];
                    float o[8] = {v0[0], v0[1], v0[2], v0[3], v1[0], v1[1], v1[2], v1[3]};
#pragma unroll
                    for (int x = 0; x < 8; ++x) { const int d = i - (j0 + x); const float e2 = d >= 0 ? lgf * (float)d : lgb * (float)(-d); o[x] *= __builtin_amdgcn_exp2f(e2); }
                    v4u w; w.x = cvt_pk_bf16(o[0], o[1]); w.y = cvt_pk_bf16(o[2], o[3]); w.z = cvt_pk_bf16(o[4], o[5]); w.w = cvt_pk_bf16(o[6], o[7]);
                    *(v4u*)(acat + (size_t)(r0 + i) * 3072 + h * 768 + j0) = w; } }
    }
};
struct SchedRT2 { const char* bcat; const char* kt2; int G, c;
    __device__ __forceinline__ bool next(int i, Unit& u) const {
        int L = i * G + c; if (L >= NBG * 4 * 2 * 16 * 2) return false;
        if (G == 256) L = i * 256 + (c & 7) * 32 + (c >> 3);
        const int s6 = L & 63, bh = L >> 6, h = bh & 3, bl = bh >> 2; int es, dir, pm = s6 & 1;
        if (s6 < 4) { es = 0; dir = s6 >> 1; } else if (s6 < 6) { es = 1; dir = 0; } else if (s6 < 62) { const int t = s6 - 6; es = 2 + (t >> 2); dir = (t >> 1) & 1; } else { es = 16; dir = 1; }
        const int ed = dir == 0 ? es + 1 : (es == 0 ? 16 : es - 1);
        const int ch = (bl * 4 + h) * NCH;
        u.a = bcat + (size_t)(ch + es) * BCAT_CH + (size_t)pm * 256 * 768 * 2;
        u.b = kt2 + (size_t)dir * KT2_DIR + (size_t)(ch + es) * 131072;
        u.u0 = ch + ed; u.u1 = pm; u.u2 = dir; u.u3 = 0; return true; } };
struct LocRT2 { bf16* bcat;
    __device__ __forceinline__ void operator()(const Unit& u, bf16*& base, int& ldc) const {
        base = bcat + ((size_t)u.u0 * 512 + u.u1 * 256) * 768 + 256 + u.u2 * 256; ldc = 768; } };
struct SchedRT5 { const char* acat; const char* bcat; int G, c;
    __device__ __forceinline__ bool next(int i, Unit& u) const {
        int L = i * G + c; if (L >= NBG * 4 * 16 * 2) return false;
        if (G == 256) { const int xcd = c & 7, slot = c >> 3; L = ((i * 128 + xcd * 16 + (slot >> 1)) << 1) | (slot & 1); }
        const int pn = L & 1, idx = L >> 1, e = (idx & 15) + 1, h = (idx >> 4) & 3, bl = idx >> 6; const size_t r0 = (size_t)bl * LE + e * 256;
        u.a = acat + (r0 * 3072 + h * 768) * 2; u.b = bcat + (size_t)((bl * 4 + h) * NCH + e) * BCAT_CH + (size_t)pn * 256 * 768 * 2;
        u.u0 = (int)r0; u.u1 = h * 512 + pn * 256; u.u2 = 0; u.u3 = 0; return true; } };
struct LocRT5 { bf16* o;
    __device__ __forceinline__ void operator()(const Unit& u, bf16*& base, int& ldc) const { base = o + (size_t)u.u0 * 2048 + u.u1; ldc = 2048; } };

struct EpiRT5F {
    static constexpr bool PERM = true; static constexpr bool PRE = false, KSCALE = false;
    bf16* o; const bf16* gate; float* ssq;
    __device__ __forceinline__ void operator()(const f32x4 (&acc)[2][2][4][2], const Unit& u, int wr, int wc, int fr, int fq) const {
        const int pidx = (u.u1 >> 8) * 4 + wc;
        v4u gwa[2][4][2];
#pragma unroll
        for (int ai = 0; ai < 2; ++ai)
#pragma unroll
            for (int m = 0; m < 4; ++m) { const size_t off = ((size_t)u.u0 + ai * 128 + wr * 64 + m * 16 + fr) * 2048 + u.u1 + wc * 32 + 8 * fq;
#pragma unroll
                for (int bj = 0; bj < 2; ++bj) gwa[ai][m][bj] = *(const v4u*)(gate + off + bj * 128); }
#pragma unroll
        for (int ai = 0; ai < 2; ++ai)
#pragma unroll
            for (int m = 0; m < 4; ++m) { const size_t row = (size_t)u.u0 + ai * 128 + wr * 64 + m * 16 + fr; const size_t off = row * 2048 + u.u1 + wc * 32 + 8 * fq;
                f32x2 s2 = {0.f, 0.f};
#pragma unroll
                for (int bj = 0; bj < 2; ++bj) { const f32x4 v0 = acc[ai][bj][m][0], v1 = acc[ai][bj][m][1];
                    const v4u gw = gwa[ai][m][bj];
                    const f32x2 vv[4] = {(f32x2){v0[0], v0[1]}, (f32x2){v0[2], v0[3]}, (f32x2){v1[0], v1[1]}, (f32x2){v1[2], v1[3]}}; const unsigned gd[4] = {gw.x, gw.y, gw.z, gw.w};
                    unsigned wv[4];
#pragma unroll
                    for (int q = 0; q < 4; ++q) { const f32x2 g2 = bf2x2(gd[q]); s2 += vv[q] * vv[q]; const f32x2 og = vv[q] * (g2 * sig2(g2)); wv[q] = cvt_pk_bf16(og.x, og.y); }
                    v4u w; w.x = wv[0]; w.y = wv[1]; w.z = wv[2]; w.w = wv[3];
                    *(v4u*)(o + off + bj * 128) = w; }
                float s = s2.x + s2.y;
                s += SWZ_XOR(s, 16);
                { unsigned a_ = __builtin_bit_cast(unsigned, s), b_ = a_; asm volatile("" : "+v"(b_));
                  auto rr = __builtin_amdgcn_permlane32_swap(a_, b_, false, false);
                  unsigned r0_ = rr[0], r1_ = rr[1]; asm volatile("" : "+v"(r0_), "+v"(r1_));
                  s = __builtin_bit_cast(float, r0_) + __builtin_bit_cast(float, r1_); }
                if (fq == 0) ssq[row * 32 + pidx] = s; }
    }
};
struct EpiG1 {
    static constexpr bool PERM = true; static constexpr bool PRE = true, KSCALE = true;
    const bf16* g; bf16* out; const float* ssq;
    __device__ __forceinline__ void pre(const Unit& u, LAS unsigned char* slot, int wid) const {
        if (wid < 4) { const int rl = wid * 64 + lane_id_asm(); const float* p = ssq + ((size_t)u.u0 * 256 + rl) * 32; float rs[4];
#pragma unroll
            for (int h = 0; h < 4; ++h) { const f32x4 a = *(const f32x4*)(p + h * 8), b = *(const f32x4*)(p + h * 8 + 4);
                rs[h] = 1.0f / sqrtf((((a.x + a.y) + (a.z + a.w)) + ((b.x + b.y) + (b.z + b.w))) * (1.f / 512.f) + EPS); }
            *(LAS f32x4*)(slot + rl * 16) = (f32x4){rs[0] / rs[1], rs[1] / rs[2], rs[2] / rs[3], rs[3]}; } }
    __device__ __forceinline__ void kscale(f32x4 (&acc)[2][2][4][2], int wr, int hidx, const LAS unsigned char* slot) const {
        const int fr = lane_id_asm() & 15; const LAS float* f = (const LAS float*)slot + hidx;
#pragma unroll
        for (int ai = 0; ai < 2; ++ai)
#pragma unroll
            for (int m = 0; m < 4; ++m) { const float sc = f[(ai * 128 + wr * 64 + m * 16 + fr) * 4];
#pragma unroll
                for (int bj = 0; bj < 2; ++bj)
#pragma unroll
                    for (int n = 0; n < 2; ++n) acc[ai][bj][m][n] *= sc; } }
    __device__ __forceinline__ void operator()(const f32x4 (&acc)[2][2][4][2], const Unit& u, int wr, int wc, int fr, int fq, const LAS unsigned char* slot) const {
        const LAS float* f = (const LAS float*)slot + 3;
        v4u gwa[2][4][2];
#pragma unroll
        for (int ai = 0; ai < 2; ++ai)
#pragma unroll
            for (int m = 0; m < 4; ++m) { const size_t off = (size_t)(u.u0 * 256 + ai * 128 + wr * 64 + m * 16 + fr) * 1024 + u.u1 * 256 + wc * 32 + 8 * fq;
#pragma unroll
                for (int bj = 0; bj < 2; ++bj) gwa[ai][m][bj] = *(const v4u*)(g + off + bj * 128); }
#pragma unroll
        for (int ai = 0; ai < 2; ++ai)
#pragma unroll
            for (int m = 0; m < 4; ++m) { const int rl = ai * 128 + wr * 64 + m * 16 + fr; const float sc = f[rl * 4];
                const size_t off = (size_t)(u.u0 * 256 + rl) * 1024 + u.u1 * 256 + wc * 32 + 8 * fq;
#pragma unroll
                for (int bj = 0; bj < 2; ++bj) { const f32x4 v0 = acc[ai][bj][m][0] * sc, v1 = acc[ai][bj][m][1] * sc;
                    const v4u gw = gwa[ai][m][bj];
                    const f32x2 o0 = (f32x2){v0[0], v0[1]} * sig2(bf2x2(gw.x)), o1 = (f32x2){v0[2], v0[3]} * sig2(bf2x2(gw.y)), o2 = (f32x2){v1[0], v1[1]} * sig2(bf2x2(gw.z)), o3 = (f32x2){v1[2], v1[3]} * sig2(bf2x2(gw.w));
                    v4u w; w.x = cvt_pk_bf16(o0.x, o0.y); w.y = cvt_pk_bf16(o1.x, o1.y); w.z = cvt_pk_bf16(o2.x, o2.y); w.w = cvt_pk_bf16(o3.x, o3.y);
                    *(v4u*)(out + off + bj * 128) = w; } }
    }
};

template <bool ADD>
struct EpiGate {
    static constexpr bool PERM = true; static constexpr bool PRE = false, KSCALE = false;
    const bf16* g; const bf16* prev; bf16* out;
    __device__ __forceinline__ void operator()(const f32x4 (&acc)[2][2][4][2], const Unit& u, int wr, int wc, int fr, int fq) const {
#pragma unroll
        for (int ai = 0; ai < 2; ++ai) { v4u gwa[4][2], pwa[4][2];
#pragma unroll
            for (int m = 0; m < 4; ++m) { const size_t off = (size_t)(u.u0 * 256 + ai * 128 + wr * 64 + m * 16 + fr) * 1024 + u.u1 * 256 + wc * 32 + 8 * fq;
#pragma unroll
                for (int bj = 0; bj < 2; ++bj) { gwa[m][bj] = *(const v4u*)(g + off + bj * 128); if (ADD) pwa[m][bj] = *(const v4u*)(prev + off + bj * 128); } }
#pragma unroll
            for (int m = 0; m < 4; ++m) { const size_t off = (size_t)(u.u0 * 256 + ai * 128 + wr * 64 + m * 16 + fr) * 1024 + u.u1 * 256 + wc * 32 + 8 * fq;
#pragma unroll
                for (int bj = 0; bj < 2; ++bj) { const f32x4 v0 = acc[ai][bj][m][0], v1 = acc[ai][bj][m][1];
                    const v4u gw = gwa[m][bj];
                    f32x2 o0 = (f32x2){v0[0], v0[1]} * sig2(bf2x2(gw.x)), o1 = (f32x2){v0[2], v0[3]} * sig2(bf2x2(gw.y)), o2 = (f32x2){v1[0], v1[1]} * sig2(bf2x2(gw.z)), o3 = (f32x2){v1[2], v1[3]} * sig2(bf2x2(gw.w));
                    if (ADD) { const v4u pw = pwa[m][bj]; o0 += bf2x2(pw.x); o1 += bf2x2(pw.y); o2 += bf2x2(pw.z); o3 += bf2x2(pw.w); }
                    v4u w; w.x = cvt_pk_bf16(o0.x, o0.y); w.y = cvt_pk_bf16(o1.x, o1.y); w.z = cvt_pk_bf16(o2.x, o2.y); w.w = cvt_pk_bf16(o3.x, o3.y);
                    *(v4u*)(out + off + bj * 128) = w; } } }
    }
};
struct EpiG3 {
    static constexpr bool PERM = true; static constexpr bool PRE = false, KSCALE = false;
    const float* x; const float* ada; float* out; int g0;
    __device__ __forceinline__ void operator()(const f32x4 (&acc)[2][2][4][2], const Unit& u, int wr, int wc, int fr, int fq) const {
        const int pe = u.u0, bl = pe / NCH, e = pe % NCH, b = g0 + bl;
        const float* gv = ada + (size_t)b * 6144 + 2048 + u.u1 * 256 + wc * 32 + 8 * fq;
        f32x4 gt[2][2];
#pragma unroll
        for (int bj = 0; bj < 2; ++bj)
#pragma unroll
            for (int n = 0; n < 2; ++n) gt[bj][n] = *(const f32x4*)(gv + bj * 128 + n * 4);
#pragma unroll
        for (int ai = 0; ai < 2; ++ai) { f32x4 xa[4][2][2];
#pragma unroll
            for (int m = 0; m < 4; ++m) { const size_t tok = (size_t)b * SEQ + (e - 1) * 256 + ai * 128 + wr * 64 + m * 16 + fr; const int col = u.u1 * 256 + wc * 32 + 8 * fq;
#pragma unroll
                for (int bj = 0; bj < 2; ++bj) { const float* xp = x + tok * 1024 + col + bj * 128; xa[m][bj][0] = *(const f32x4*)xp; xa[m][bj][1] = *(const f32x4*)(xp + 4); } }
#pragma unroll
            for (int m = 0; m < 4; ++m) { const size_t tok = (size_t)b * SEQ + (e - 1) * 256 + ai * 128 + wr * 64 + m * 16 + fr;
                const int col = u.u1 * 256 + wc * 32 + 8 * fq;
#pragma unroll
                for (int bj = 0; bj < 2; ++bj) {
                    const f32x4 v0 = xa[m][bj][0] + gt[bj][0] * acc[ai][bj][m][0], v1 = xa[m][bj][1] + gt[bj][1] * acc[ai][bj][m][1];
                    v4u w; w.x = cvt_pk_bf16(v0[0], v0[1]); w.y = cvt_pk_bf16(v0[2], v0[3]); w.z = cvt_pk_bf16(v1[0], v1[1]); w.w = cvt_pk_bf16(v1[2], v1[3]);
                    *(v4u*)((bf16*)(out + tok * 1024) + col + bj * 128) = w; } } }
    }
};

template <int NT>
struct SchedMoE { const char* A; const char* W; size_t wexp; const volatile LAS int* ptab; int npan, G, c;
    __device__ __forceinline__ bool next(int i, Unit& u) const {
        const int L = i * G + c; if (L >= npan * NT) return false;
        int pm, pn; pg8::tile2d(L, npan, NT, pm, pn);
        const int e = ptab[pm]; const int pl = pm - ptab[e - 48];
        u.a = A + (size_t)pm * 256 * 1024 * 2; u.b = W + (size_t)e * wexp + (size_t)pn * 256 * 1024 * 2; u.u0 = pm; u.u1 = pn; u.u2 = e; u.u3 = ptab[608 + e] - pl * 256; u.u4 = e * TLM + pl * 256; return true; } };
struct SchedMoEG { const char* gbase; const unsigned short* rowtok; const char* W; size_t wexp; const volatile LAS int* ptab; int npan, G, c, zrow;
    __device__ __forceinline__ bool next(int i, Unit& u) const {
        const int L = i * G + c; if (L >= npan * 8) return false;
        int pm, pn; pg8::tile2d(L, npan, 8, pm, pn);
        const int e = ptab[pm]; const int pl = pm - ptab[e - 48];
        u.a = gbase; u.b = W + (size_t)e * wexp + (size_t)pn * 256 * 1024 * 2; u.u0 = pm; u.u1 = pn; u.u2 = e; u.u3 = ptab[608 + e] - pl * 256; u.u4 = e * TLM + pl * 256; return true; } };
struct EpiE3 {
    static constexpr bool PERM = true; static constexpr bool PRE = false, KSCALE = false;
    bf16* act; const float* bgu;
    __device__ __forceinline__ void operator()(const f32x4 (&acc)[2][2][4][2], const Unit& u, int wr, int wc, int fr, int fq) const {
        const int jj = u.u1 * 128 + wc * 32 + 8 * fq; const float* bp = bgu + (size_t)u.u2 * 2048 + jj;
        const f32x4 bg0 = *(const f32x4*)bp, bg1 = *(const f32x4*)(bp + 4), bu0 = *(const f32x4*)(bp + 1024), bu1 = *(const f32x4*)(bp + 1028);
#pragma unroll
        for (int ai = 0; ai < 2; ++ai)
#pragma unroll
            for (int m = 0; m < 4; ++m) { const size_t row = (size_t)u.u0 * 256 + ai * 128 + wr * 64 + m * 16 + fr;
                const f32x4 gs[2] = {acc[ai][0][m][0], acc[ai][0][m][1]}, us[2] = {acc[ai][1][m][0], acc[ai][1][m][1]}, bgs[2] = {bg0, bg1}, bus[2] = {bu0, bu1};
                unsigned wv[4];
#pragma unroll
                for (int q = 0; q < 4; ++q) { const int hx = q >> 1, x0 = (q & 1) * 2;
                    const f32x2 g2 = (f32x2){gs[hx][x0], gs[hx][x0 + 1]} + (f32x2){bgs[hx][x0], bgs[hx][x0 + 1]}, u2 = (f32x2){us[hx][x0], us[hx][x0 + 1]} + (f32x2){bus[hx][x0], bus[hx][x0 + 1]};
                    const f32x2 ga = (f32x2){fminf(g2.x, 7.f), fminf(g2.y, 7.f)}, up = (f32x2){fminf(fmaxf(u2.x, -7.f), 7.f), fminf(fmaxf(u2.y, -7.f), 7.f)};
                    const f32x2 z = ga * (f32x2){-1.702f * 1.4426950408889634f, -1.702f * 1.4426950408889634f};
                    const f32x2 den = (f32x2){__builtin_amdgcn_exp2f(z.x), __builtin_amdgcn_exp2f(z.y)} + (f32x2){1.f, 1.f};
                    const f32x2 sg = (f32x2){__builtin_amdgcn_rcpf(den.x), __builtin_amdgcn_rcpf(den.y)};
                    const f32x2 o2 = (up + (f32x2){1.f, 1.f}) * (ga * sg);
                    wv[q] = cvt_pk_bf16(o2.x, o2.y); }
                v4u w; w.x = wv[0]; w.y = wv[1]; w.z = wv[2]; w.w = wv[3];
                *(v4u*)(act + row * 1024 + jj) = w; }
    }
};
struct EpiE4 {
    static constexpr bool PERM = true; static constexpr bool PRE = false, KSCALE = false;
    bf16* ys; const float* bd; const float* rowg;
    __device__ __forceinline__ void operator()(const f32x4 (&acc)[2][2][4][2], const Unit& u, int wr, int wc, int fr, int fq) const {
        const int c0 = u.u1 * 256 + wc * 32 + 8 * fq; const float* bp = bd + (size_t)u.u2 * 1024 + c0;
        f32x4 b[2][2];
#pragma unroll
        for (int bj = 0; bj < 2; ++bj) { b[bj][0] = *(const f32x4*)(bp + bj * 128); b[bj][1] = *(const f32x4*)(bp + bj * 128 + 4); }
        float rga[2][4];
#pragma unroll
        for (int ai = 0; ai < 2; ++ai)
#pragma unroll
            for (int m = 0; m < 4; ++m) rga[ai][m] = rowg[(size_t)u.u4 + ai * 128 + wr * 64 + m * 16 + fr];
#pragma unroll
        for (int ai = 0; ai < 2; ++ai)
#pragma unroll
            for (int m = 0; m < 4; ++m) { const size_t row = (size_t)u.u0 * 256 + ai * 128 + wr * 64 + m * 16 + fr; const float rg = rga[ai][m];
#pragma unroll
                for (int bj = 0; bj < 2; ++bj) { const f32x4 v0 = (acc[ai][bj][m][0] + b[bj][0]) * rg, v1 = (acc[ai][bj][m][1] + b[bj][1]) * rg;
                    v4u w; w.x = cvt_pk_bf16(v0[0], v0[1]); w.y = cvt_pk_bf16(v0[2], v0[3]); w.z = cvt_pk_bf16(v1[0], v1[1]); w.w = cvt_pk_bf16(v1[2], v1[3]);
                    *(v4u*)(ys + row * 1024 + c0 + bj * 128) = w; } }
    }
};
namespace att {
constexpr int NW = 8, QBLK = 32, KVBLK = 64;
constexpr float SCALE = 0.072168783648703220f;
constexpr float THR = 8.f;
constexpr int KROWB = 384;
constexpr size_t SHM_V = KVBLK * 128 * 2, SHM_K = KVBLK * KROWB, SHM_ATTN = 2 * SHM_V + 2 * SHM_K + NW * 64 * 4;
constexpr int OST_ROW = 72, OST_WAVE = 32 * OST_ROW * 2;
static_assert(SHM_ATTN + NW * OST_WAVE <= RING_BYTES, "attention LDS");
#define KSWZ(row, colB) ((row) * att::KROWB + ((colB) ^ (((row) & 7) << 4)))
#define SBAR() __builtin_amdgcn_sched_barrier(0)
__device__ __forceinline__ int crow(int r, int hi) { return (r & 3) + 8 * (r >> 2) + 4 * hi; }

__device__ __forceinline__ void partialSM(f32x16& p0, f32x16& p1, float& m_reg, float& mn, float& alpha) {
  constexpr float C = SCALE * 1.4426950408889634f;
  float pmax = p0[0];
#pragma unroll
  for (int r = 1; r < 16; ++r) pmax = fmaxf(pmax, p0[r]);
#pragma unroll
  for (int r = 0; r < 16; ++r) pmax = fmaxf(pmax, p1[r]);
  { unsigned a_ = __float_as_uint(pmax), b_ = a_; asm volatile("" : "+v"(b_));
    auto rr = __builtin_amdgcn_permlane32_swap(a_, b_, false, false);
    unsigned r0_ = rr[0], r1_ = rr[1]; asm volatile("" : "+v"(r0_), "+v"(r1_));
    pmax = fmaxf(__uint_as_float(r0_), __uint_as_float(r1_)); }
  if (__builtin_expect(__all(pmax - m_reg <= THR / SCALE), 1)) { mn = m_reg; alpha = 1.f; }
  else { mn = fmaxf(m_reg, pmax); alpha = __builtin_amdgcn_exp2f((m_reg - mn) * C); m_reg = mn; }
  float mnC = -mn * C;
#pragma unroll
  for (int r = 0; r < 16; ++r) p0[r] = fmaf(p0[r], C, mnC);
#pragma unroll
  for (int r = 0; r < 16; ++r) p1[r] = fmaf(p1[r], C, mnC);
#pragma unroll
  for (int r = 0; r < 16; ++r) p0[r] = __builtin_amdgcn_exp2f(p0[r]);
}
__device__ __forceinline__ void finishSM(f32x16& p0, f32x16& p1, float alpha, float& l_reg, bf16x8& pa0, bf16x8& pa1, bf16x8& pa2, bf16x8& pa3) {
#pragma unroll
  for (int r = 0; r < 16; ++r) p1[r] = __builtin_amdgcn_exp2f(p1[r]);
  float ps = 0;
#pragma unroll
  for (int r = 0; r < 16; ++r) ps += p0[r];
#pragma unroll
  for (int r = 0; r < 16; ++r) ps += p1[r];
  { unsigned a_ = __float_as_uint(ps), b_ = a_; asm volatile("" : "+v"(b_));
    auto rr = __builtin_amdgcn_permlane32_swap(a_, b_, false, false);
    unsigned r0_ = rr[0], r1_ = rr[1]; asm volatile("" : "+v"(r0_), "+v"(r1_));
    ps = __uint_as_float(r0_) + __uint_as_float(r1_); }
  l_reg = l_reg * alpha + ps;
#define PK4(P, BASE, OUT) do { unsigned a0 = cvt_pk_bf16(P[BASE + 0], P[BASE + 1]), a1 = cvt_pk_bf16(P[BASE + 2], P[BASE + 3]);   \
    unsigned b0 = cvt_pk_bf16(P[BASE + 4], P[BASE + 5]), b1 = cvt_pk_bf16(P[BASE + 6], P[BASE + 7]);                              \
    auto r0 = __builtin_amdgcn_permlane32_swap(a0, b0, false, false); auto r1 = __builtin_amdgcn_permlane32_swap(a1, b1, false, false); \
    v4u w = {r0[0], r1[0], r0[1], r1[1]}; OUT = *reinterpret_cast<bf16x8*>(&w); } while (0)
  PK4(p0, 0, pa0); PK4(p0, 8, pa1); PK4(p1, 0, pa2); PK4(p1, 8, pa3);
#undef PK4
}
__device__ __forceinline__ void qkt(f32x16& p0, f32x16& p1, const char* Ks, const bf16x8 (&qr)[12], int r32, int hi) {
  p0 = f32x16{}; p1 = f32x16{};
#pragma unroll
  for (int d0 = 0; d0 < 12; ++d0) { int cb = (d0 * 16 + hi * 8) * 2;
    bf16x8 b0 = *reinterpret_cast<const bf16x8*>(Ks + KSWZ(r32, cb));
    bf16x8 b1 = *reinterpret_cast<const bf16x8*>(Ks + KSWZ(32 + r32, cb));
    p0 = __builtin_amdgcn_mfma_f32_32x32x16_bf16(b0, qr[d0], p0, 0, 0, 0);
    p1 = __builtin_amdgcn_mfma_f32_32x32x16_bf16(b1, qr[d0], p1, 0, 0, 0); }
}
__device__ __forceinline__ int v_st(int k, int c) { const int kk = (k & ~0xC) | ((k & 4) << 1) | ((k & 8) >> 1); return ((kk >> 3) * 4 + (c >> 5)) * 512 + ((kk & 7) * 32 + (c & 31)) * 2; }
__device__ __forceinline__ int v_rd_base(int lane) { return ((lane & 3) << 3) | (((lane >> 2) & 3) << 6) | (((lane >> 4) & 1) << 5) | (((lane >> 5) & 1) << 8); }
constexpr int v_rd_off(int d0, int ks, int half) { return d0 * 512 + ks * 4096 + half * 2048; }
template <int OFF> __device__ __forceinline__ s16x4 tr_read(int vb) {
  s16x4 r; asm volatile("ds_read_b64_tr_b16 %0, %1 offset:%2" : "=&v"(r) : "v"(vb), "i"(OFF) : "memory"); return r;
}
template <int D0> __device__ __forceinline__ void pv_one(f32x16& od, int vb, bf16x8 pa0, bf16x8 pa1, bf16x8 pa2, bf16x8 pa3) {
  const s16x4 l0 = tr_read<v_rd_off(D0, 0, 0)>(vb), h0 = tr_read<v_rd_off(D0, 0, 1)>(vb), l1 = tr_read<v_rd_off(D0, 1, 0)>(vb), h1 = tr_read<v_rd_off(D0, 1, 1)>(vb);
  const s16x4 l2 = tr_read<v_rd_off(D0, 2, 0)>(vb), h2 = tr_read<v_rd_off(D0, 2, 1)>(vb), l3 = tr_read<v_rd_off(D0, 3, 0)>(vb), h3 = tr_read<v_rd_off(D0, 3, 1)>(vb);
  asm volatile("s_waitcnt lgkmcnt(0)" ::: "memory"); SBAR();
#define PK(L, H) (bf16x8){L[0], L[1], L[2], L[3], H[0], H[1], H[2], H[3]}
  od = __builtin_amdgcn_mfma_f32_32x32x16_bf16(pa0, PK(l0, h0), od, 0, 0, 0);
  od = __builtin_amdgcn_mfma_f32_32x32x16_bf16(pa1, PK(l1, h1), od, 0, 0, 0);
  od = __builtin_amdgcn_mfma_f32_32x32x16_bf16(pa2, PK(l2, h2), od, 0, 0, 0);
  od = __builtin_amdgcn_mfma_f32_32x32x16_bf16(pa3, PK(l3, h3), od, 0, 0, 0);
#undef PK
}
__device__ __forceinline__ void pv_d0(f32x16 (&o)[4], int vb, bf16x8 pa0, bf16x8 pa1, bf16x8 pa2, bf16x8 pa3) {
  pv_one<0>(o[0], vb, pa0, pa1, pa2, pa3); pv_one<1>(o[1], vb, pa0, pa1, pa2, pa3); pv_one<2>(o[2], vb, pa0, pa1, pa2, pa3); pv_one<3>(o[3], vb, pa0, pa1, pa2, pa3);
}

__device__ __forceinline__ void attn_body(const bf16* __restrict__ Qb, const bf16* __restrict__ Kn, const bf16* __restrict__ Kr, const bf16* __restrict__ Vh,
                                          bf16* __restrict__ Ob, int seq, char* lds, int tid_in) {
  constexpr int LDQ = 1536, LDKV = 2048, LDKR = 768, LDO = 1024;
  const int tid_o = tid_in * 64 + lane_id_asm();
  const int tid = tid_o, wid = tid >> 6, lane = tid & 63, r32 = lane & 31, hi = lane >> 5;
  if (tid_in >= 4) __builtin_amdgcn_s_setprio(1);
  char* V_lds = lds; char* K_lds = lds + 2 * SHM_V;
  float* ws = (float*)(lds + 2 * SHM_V + 2 * SHM_K) + wid * 64; float* li_l = ws; float* al_l = ws + 32;
  float m_reg = -1e30f, l_reg = 0; f32x16 o[4] = {}; bf16x8 qr[12];
  const bf16* Qw = Qb + (long)(wid * QBLK + r32) * LDQ + hi * 8;
#pragma unroll
  for (int d0 = 0; d0 < 12; ++d0) qr[d0] = *reinterpret_cast<const bf16x8*>(Qw + d0 * 16);
  const int sr = tid >> 4, sc = (tid & 15) * 8, vst0 = v_st(sr, sc), vst1 = v_st(32 + sr, sc);
  const int rr = tid >> 3, rc = (tid & 7) * 8;
  const int vb0 = (int)(uintptr_t)V_lds + v_rd_base(lane);
  bf16x8 vs0, vs1, ks0, ks1, kr0;
#define SLOAD(k0) do { vs0 = *(const bf16x8*)(&Vh[(long)((k0) + sr) * LDKV + sc]); vs1 = *(const bf16x8*)(&Vh[(long)((k0) + 32 + sr) * LDKV + sc]); \
    ks0 = *(const bf16x8*)(&Kn[(long)((k0) + sr) * LDKV + sc]); ks1 = *(const bf16x8*)(&Kn[(long)((k0) + 32 + sr) * LDKV + sc]); \
    kr0 = *(const bf16x8*)(&Kr[(long)((k0) + rr) * LDKR + rc]); } while (0)
#define SWRITE(b) do { *(bf16x8*)(V_lds + (b) * SHM_V + vst0) = vs0; *(bf16x8*)(V_lds + (b) * SHM_V + vst1) = vs1; int kc = sc * 2;               \
    *(bf16x8*)(K_lds + (b) * SHM_K + KSWZ(sr, kc)) = ks0; *(bf16x8*)(K_lds + (b) * SHM_K + KSWZ(32 + sr, kc)) = ks1;                              \
    *(bf16x8*)(K_lds + (b) * SHM_K + KSWZ(rr, 256 + rc * 2)) = kr0; } while (0)
#define SWAIT() asm volatile("s_waitcnt vmcnt(0)" ::: "memory")
#define RESC(a) do { if (__any((a) < 1.f)) { if (hi == 0) al_l[r32] = (a); asm volatile("s_waitcnt lgkmcnt(0)" ::: "memory"); \
    _Pragma("unroll") for (int d = 0; d < 4; ++d) _Pragma("unroll") for (int r = 0; r < 16; ++r) o[d][r] *= al_l[crow(r, hi)]; } } while (0)
  f32x16 pA0, pA1, pB0, pB1; float mnA, mnB, alA, alB; bf16x8 pa0, pa1, pa2, pa3; const int NT = seq / KVBLK;
  SLOAD(0); asm volatile("s_waitcnt vmcnt(0)" ::: "memory"); SWRITE(0); SLOAD(KVBLK); __syncthreads();
  qkt(pA0, pA1, K_lds, qr, r32, hi); partialSM(pA0, pA1, m_reg, mnA, alA);
  SWAIT(); SWRITE(1); __syncthreads();
  for (int j = 1; j + 1 < NT; j += 2) {
    SBAR(); qkt(pB0, pB1, K_lds + SHM_K, qr, r32, hi);
    finishSM(pA0, pA1, alA, l_reg, pa0, pa1, pa2, pa3); SBAR();
    SLOAD((j + 1) * KVBLK); SBAR();
    pv_d0(o, vb0, pa0, pa1, pa2, pa3); partialSM(pB0, pB1, m_reg, mnB, alB);
    __syncthreads(); SWAIT(); SWRITE(0);
    RESC(alB); __syncthreads();
    SBAR(); qkt(pA0, pA1, K_lds, qr, r32, hi);
    finishSM(pB0, pB1, alB, l_reg, pa0, pa1, pa2, pa3); SBAR();
    SLOAD((j + 2) * KVBLK); SBAR();
    pv_d0(o, vb0 + (int)SHM_V, pa0, pa1, pa2, pa3); partialSM(pA0, pA1, m_reg, mnA, alA);
    __syncthreads(); SWAIT(); SWRITE(1);
    RESC(alA); __syncthreads();
  }
  SBAR(); qkt(pB0, pB1, K_lds + SHM_K, qr, r32, hi);
  finishSM(pA0, pA1, alA, l_reg, pa0, pa1, pa2, pa3); SBAR();
  pv_d0(o, vb0, pa0, pa1, pa2, pa3); partialSM(pB0, pB1, m_reg, mnB, alB);
  __syncthreads(); RESC(alB);
  finishSM(pB0, pB1, alB, l_reg, pa0, pa1, pa2, pa3); SBAR();
  pv_d0(o, vb0 + (int)SHM_V, pa0, pa1, pa2, pa3);
  if (hi == 0) li_l[r32] = l_reg; asm volatile("s_waitcnt lgkmcnt(0)" ::: "memory");
  { const int l_e = lane_id_asm(), r32e = l_e & 31, hie = l_e >> 5;
    bf16* Obe = Ob; asm volatile("" : "+s"(Obe)); Obe = (bf16*)(GAS bf16*)(unsigned long long)Obe;
    float rli[16];
#pragma unroll
    for (int r = 0; r < 16; ++r) rli[r] = __builtin_amdgcn_rcpf(li_l[crow(r, hie)]);
    bf16* Ow = Obe + (long)(wid * QBLK) * LDO;
    unsigned short* stg = (unsigned short*)(lds + SHM_ATTN + wid * OST_WAVE);
#pragma unroll
    for (int p = 0; p < 2; ++p) {
#pragma unroll
      for (int r = 0; r < 16; ++r) { const int orow = crow(r, hie);
#pragma unroll
        for (int d = 0; d < 2; ++d) stg[orow * OST_ROW + d * 32 + r32e] = f2bf(o[2 * p + d][r] * rli[r]); }
      asm volatile("s_waitcnt lgkmcnt(0)" ::: "memory");
#pragma unroll
      for (int i = 0; i < 4; ++i) { const int row = i * 8 + (l_e >> 3), ch = l_e & 7; const v4u v = *(const v4u*)(stg + row * OST_ROW + ch * 8); *(v4u*)(Ow + (long)row * LDO + p * 64 + ch * 8) = v; }
      asm volatile("s_waitcnt lgkmcnt(0)" ::: "memory");
    } }
  __builtin_amdgcn_s_setprio(0);
#undef SLOAD
#undef SWRITE
#undef SWAIT
#undef RESC
}
}
struct Ctx {
    LAS unsigned char* lds; int tid, lane, wave, G, gw, NGW;
    __device__ __forceinline__ void* p(int i) const { asm volatile("" : "+s"(i));
        volatile LAS unsigned* T = (volatile LAS unsigned*)(lds + MISC_OFF + MISC_PT);
        const unsigned lo = __builtin_amdgcn_readfirstlane(T[2 * i]), hi = __builtin_amdgcn_readfirstlane(T[2 * i + 1]); return (void*)(GAS void*)(((unsigned long long)hi << 32) | lo); }
};

template <class Map>
__device__ __forceinline__ void transpose_item(const float* W, int K, int N, bf16* WT, const float* kscale, LAS float* scr, int item, int lane, Map map) {
    const int nblk = N / 32, kb = item / nblk, nb = item % nblk, k0 = 64 * kb, n0 = 32 * nb;
#pragma unroll 8
    for (int i = 0; i < 32; ++i) { const int kk = 2 * i + (lane >> 5); float v = W[(size_t)(k0 + kk) * N + n0 + (lane & 31)]; if (kscale) v *= kscale[k0 + kk]; scr[kk * 33 + (lane & 31)] = v; }
    LDS_WAIT(); asm volatile("" ::: "memory");
    const int c = lane & 7;
#pragma unroll
    for (int j = 0; j < 4; ++j) { const int n = (lane >> 3) + 8 * j; const LAS float* s = scr + (8 * c) * 33 + n;
        v4u o; o.x = pk2(s[0 * 33], s[1 * 33]); o.y = pk2(s[2 * 33], s[3 * 33]); o.z = pk2(s[4 * 33], s[5 * 33]); o.w = pk2(s[6 * 33], s[7 * 33]);
        const int dr = map(n0 + n);
        *(v4u*)(WT + (size_t)dr * K + k0 + 8 * c) = o; }
    LDS_WAIT(); asm volatile("" ::: "memory");
}
__device__ __forceinline__ int map_win(int n) {
    if (n < 2048) { const int seg = n >> 10, r = n & 1023, h = r >> 8, j = r & 255;
        const int jp = 2 * (64 * (j >> 7) + (j & 63)) + ((j >> 6) & 1); return seg * 1024 + h * 256 + jp; }
    if (n < 4096) return WIN_V + (n - 2048);
    if (n < 6144) return WIN_GATE + (n - 4096);
    if (n < 6528) return WIN_MLA + (n - 6144);
    if (n < 6784) return WIN_MLA + 384 + (n - 6528);
    if (n < 6848) { const int j = n - 6784; const int jp = 2 * (16 * (j >> 5) + (j & 15)) + ((j >> 4) & 1); return WIN_MLA + 640 + jp; }
    if (n < 7872) return WIN_GRET + (n - 6848);
    return WIN_GMLA + (n - 7872);
}
__device__ __forceinline__ int map_wuq(int n) { const int h = n / 192, jj = n % 192; if (jj < 128) return n; const int j = jj - 128; return h * 192 + 128 + 2 * (16 * (j >> 5) + (j & 15)) + ((j >> 4) & 1); }
__device__ __forceinline__ int map_id(int n) { return n; }
__device__ __forceinline__ int map_wgu(int n) { const int up = n >> 10, j = n & 1023; return 256 * (j >> 7) + 128 * up + (j & 127); }

__device__ __forceinline__ void p0_weights(const Ctx& C) {
    LAS float* scr = (LAS float*)(C.lds + C.wave * 16384);
    unsigned char* ws = ((unsigned char*)C.p(26));
    const float* w_in = ((const float*)C.p(8)); const float* w_uq = ((const float*)C.p(12)); const float* w_ukv = ((const float*)C.p(14)); const float* w_br = ((const float*)C.p(15)); const float* w_bm = ((const float*)C.p(16)); const float* w_o = ((const float*)C.p(17));
    const float* w_gu = ((const float*)C.p(20)); const float* w_d = ((const float*)C.p(22)); const float* qg = ((const float*)C.p(11)); const float* kvg = ((const float*)C.p(13));
    constexpr int I_IN = 16 * (8896 / 32), I_UQ = 6 * 48, I_UKV = 4 * 64, I_BR = 32 * 32, I_BM = 16 * 32, I_O = 16 * 32, I_GU1 = 16 * 64, I_D1 = 16 * 32;
    constexpr int NIT = I_IN + I_UQ + I_UKV + I_BR + I_BM + I_O + 32 * I_GU1 + 32 * I_D1;
    for (int it = C.gw; it < NIT; it += C.NGW) {
        int r = it;
        if (r < I_IN) { transpose_item(w_in, 1024, 8896, (bf16*)(ws + WS_WIN), nullptr, scr, r, C.lane, map_win); continue; } r -= I_IN;
        if (r < I_UQ) { transpose_item(w_uq, 384, 1536, (bf16*)(ws + WS_WUQ), qg, scr, r, C.lane, map_wuq); continue; } r -= I_UQ;
        if (r < I_UKV) { transpose_item(w_ukv, 256, 2048, (bf16*)(ws + WS_WUKV), kvg, scr, r, C.lane, map_id); continue; } r -= I_UKV;
        if (r < I_BR) { transpose_item(w_br, 2048, 1024, (bf16*)(ws + WS_WBR), nullptr, scr, r, C.lane, map_id); continue; } r -= I_BR;
        if (r < I_BM) { transpose_item(w_bm, 1024, 1024, (bf16*)(ws + WS_WBM), nullptr, scr, r, C.lane, map_id); continue; } r -= I_BM;
        if (r < I_O) { transpose_item(w_o, 1024, 1024, (bf16*)(ws + WS_WO), nullptr, scr, r, C.lane, map_id); continue; } r -= I_O;
        if (r < 32 * I_GU1) { const int e = r / I_GU1; transpose_item(w_gu + (size_t)e * 1024 * 2048, 1024, 2048, (bf16*)(ws + WS_WGU) + (size_t)e * 2048 * 1024, nullptr, scr, r % I_GU1, C.lane, map_wgu); continue; } r -= 32 * I_GU1;
        { const int e = r / I_D1; transpose_item(w_d + (size_t)e * 1024 * 1024, 1024, 1024, (bf16*)(ws + WS_WD) + (size_t)e * 1024 * 1024, nullptr, scr, r % I_D1, C.lane, map_id); }
    }
    { bf16* padp = (bf16*)(ws + WS_WIN) + (size_t)(WIN_MLA + 704) * 1024; const int n16 = 64 * 1024 * 2 / 16;
      for (int i = blockIdx.x * 512 + C.tid; i < n16; i += C.G * 512) ((v4u*)padp)[i] = (v4u){0u, 0u, 0u, 0u}; }
    { float2* tabr = (float2*)(ws + WS_TABR); float2* tabm = (float2*)(ws + WS_TABM); float* lg = (float*)(ws + WS_LG);
      for (int i = blockIdx.x * 512 + C.tid; i < 64 * 64 + 64 * 16 + 8; i += C.G * 512) {
        if (i < 4096) { const int pos = i >> 6, f = i & 63; const float fr = exp2f(-(float)f * (13.287712379549449f / 64.0f)); const float a = (float)pos * fr; tabr[i] = make_float2(cosf(a), sinf(a)); }
        else if (i < 4096 + 1024) { const int k = i - 4096, pos = k >> 4, f = k & 15; const float fr = exp2f(-(float)f * (13.287712379549449f / 16.0f)); const float a = (float)pos * fr; tabm[k] = make_float2(cosf(a), sinf(a)); }
        else { const int k = i - 5120; const float d = (k < 4 ? ((const float*)C.p(9)) : ((const float*)C.p(10)))[k & 3];
               lg[k] = -log2f(1.0f + expf(-d)); }
      } }
}
__device__ __forceinline__ void p0_ada(const Ctx& C) {
    if ((int)blockIdx.x >= 96) return;
    LAS float* sl = (LAS float*)C.lds;
    LAS float* red = sl + 17 * 1024;
    const float* cv = ((const float*)C.p(1)); const float* cc = ((const float*)C.p(3)); const float* aw = ((const float*)C.p(6)); const float* ab = ((const float*)C.p(7));
#pragma unroll 8
    for (int i = C.tid; i < 17 * 1024; i += 512) { const float v = i < 16 * 1024 ? cv[i] : cc[i - 16 * 1024]; sl[i] = v / (1.0f + expf(-v)); }
    __syncthreads();
    const int n = blockIdx.x * 64 + C.lane; float acc[17];
#pragma unroll
    for (int b = 0; b < 17; ++b) acc[b] = 0.f;
#pragma unroll 8
    for (int k = C.wave * 128; k < C.wave * 128 + 128; ++k) { const float w = aw[(size_t)k * 6144 + n];
#pragma unroll
        for (int b = 0; b < 17; ++b) acc[b] += sl[b * 1024 + k] * w; }
#pragma unroll
    for (int b = 0; b < 17; ++b) red[(C.wave * 17 + b) * 64 + C.lane] = acc[b];
    __syncthreads();
    float* m = (float*)(((unsigned char*)C.p(26)) + WS_ADA);
    for (int i = C.tid; i < 17 * 64; i += 512) { const int b = i >> 6, l = i & 63; float s = ab[blockIdx.x * 64 + l];
#pragma unroll
        for (int w = 0; w < 8; ++w) s += red[(w * 17 + b) * 64 + l];
        m[(size_t)b * 6144 + blockIdx.x * 64 + l] = s; }
    __syncthreads();
}

__device__ __forceinline__ const float* p1_src(const float* x, const float* ctx, int grp, int r) {
    const int bl = r / LE, p = r % LE, b = grp * NBG + bl; return p < CTX ? ctx + ((size_t)b * CTX + p) * D : x + ((size_t)b * SEQ + (p - CTX)) * D; }
__device__ __forceinline__ void p1_finish(const f32x4 (&v)[4], const float* g1, const float* ada, bf16* h, int grp, int r, int lane) {
    const int bl = r / LE, p = r % LE, b = grp * NBG + bl; const float* mod = ada + (size_t)(p < CTX ? 16 : b) * 6144;
    f32x4 ga[4], sha[4], sca[4];
#pragma unroll
    for (int j = 0; j < 4; ++j) { const int c = 4 * lane + 256 * j; ga[j] = *(const f32x4*)(g1 + c); sha[j] = *(const f32x4*)(mod + c); sca[j] = *(const f32x4*)(mod + 1024 + c); }
    float s = 0.f;
#pragma unroll
    for (int j = 0; j < 4; ++j) s += (v[j].x * v[j].x + v[j].y * v[j].y) + (v[j].z * v[j].z + v[j].w * v[j].w);
    const float rstd = 1.0f / sqrtf(wave_sum(s) * (1.f / D) + EPS);
#pragma unroll
    for (int j = 0; j < 4; ++j) { const int c = 4 * lane + 256 * j;
        const f32x4 g = ga[j], sh = sha[j], sc = sca[j];
        const f32x4 o = (v[j] * rstd * g) * (sc + 1.0f) + sh;
        v2u w; w.x = pk2(o.x, o.y); w.y = pk2(o.z, o.w); *(v2u*)(h + (size_t)r * 1024 + c) = w; }
}
__device__ __forceinline__ void p1_hext(const Ctx& C, int grp) {
    const float* x = ((const float*)C.p(0)); const float* ctx = ((const float*)C.p(2)); const float* g1 = ((const float*)C.p(4)); const float* ada = (const float*)(((unsigned char*)C.p(26)) + WS_ADA);
    bf16* h = (bf16*)(((unsigned char*)C.p(26)) + WS_ARENA + AR_H);
    for (int rA = C.gw; rA < TE; rA += 2 * C.NGW) {
        const int rB = rA + C.NGW; const bool hasB = rB < TE;
        const float* sA = p1_src(x, ctx, grp, rA); const float* sB = p1_src(x, ctx, grp, hasB ? rB : rA);
        f32x4 vA[4], vB[4];
#pragma unroll
        for (int j = 0; j < 4; ++j) { vA[j] = *(const f32x4*)(sA + 4 * C.lane + 256 * j); vB[j] = *(const f32x4*)(sB + 4 * C.lane + 256 * j); }
        p1_finish(vA, g1, ada, h, grp, rA, C.lane);
        if (hasB) p1_finish(vB, g1, ada, h, grp, rB, C.lane);
    }
}

__device__ __forceinline__ void p_kt2(const Ctx& C) {
    const bf16* k = (const bf16*)(((unsigned char*)C.p(26)) + WS_ARENA + AR_K); bf16* kt = (bf16*)(((unsigned char*)C.p(26)) + WS_ARENA + AR_KT2); const float* lg = (const float*)(((unsigned char*)C.p(26)) + WS_LG);
    LAS unsigned short* tile = (LAS unsigned short*)C.lds;
    const int nitems = NBG * 4 * NCH * 4;
    v4u wn[4];
#define KT2_LOAD(itx) do { const int db_ = (itx) & 3, chh_ = (itx) >> 2, e_ = chh_ % NCH, h_ = (chh_ / NCH) & 3, bl_ = chh_ / (NCH * 4); const size_t r0_ = (size_t)bl_ * LE + e_ * 256; \
        _Pragma("unroll") for (int i = 0; i < 4; ++i) { const int pc = C.tid + 512 * i, j = pc >> 3, dc = (pc & 7) * 8; wn[i] = *(const v4u*)(k + (r0_ + j) * 1024 + h_ * 256 + db_ * 64 + dc); } } while (0)
    if ((int)blockIdx.x < nitems) KT2_LOAD((int)blockIdx.x);
    for (int it = blockIdx.x; it < nitems; it += C.G) {
        const int db = it & 3, chh = it >> 2, e = chh % NCH, h = (chh / NCH) & 3, bl = chh / (NCH * 4); (void)e; (void)bl;
#pragma unroll
        for (int i = 0; i < 4; ++i) { const int pc = C.tid + 512 * i, j = pc >> 3, dc = (pc & 7) * 8; const v4u w = wn[i];
            LAS unsigned* tp = (LAS unsigned*)(tile + j * 66 + dc); tp[0] = w.x; tp[1] = w.y; tp[2] = w.z; tp[3] = w.w; }
        if (it + C.G < nitems) KT2_LOAD(it + C.G);
        __syncthreads();
        const float lgf = lg[h], lgb = lg[4 + h];
        const LAS unsigned* tile32 = (const LAS unsigned*)tile;
#pragma unroll
        for (int i = 0; i < 2; ++i) { const int dp = 4 * C.wave + (C.lane & 3), j0 = (16 * i + (C.lane >> 2)) * 8;
            unsigned w[8];
#pragma unroll
            for (int x = 0; x < 8; ++x) w[x] = tile32[(j0 + x) * 33 + dp];
            float f0[8], f1[8], g0[8], g1[8];
#pragma unroll
            for (int x = 0; x < 8; ++x) { const float ef = __builtin_amdgcn_exp2f(lgf * (float)(255 - (j0 + x))), eb = __builtin_amdgcn_exp2f(lgb * (float)(j0 + x)); const float lo = bflo(w[x]), hi = bfhi(w[x]);
                f0[x] = lo * ef; f1[x] = hi * ef; g0[x] = lo * eb; g1[x] = hi * eb; }
            v4u wf0, wf1, wb0, wb1;
            wf0.x = pk2(f0[0], f0[1]); wf0.y = pk2(f0[2], f0[3]); wf0.z = pk2(f0[4], f0[5]); wf0.w = pk2(f0[6], f0[7]);
            wf1.x = pk2(f1[0], f1[1]); wf1.y = pk2(f1[2], f1[3]); wf1.z = pk2(f1[4], f1[5]); wf1.w = pk2(f1[6], f1[7]);
            wb0.x = pk2(g0[0], g0[1]); wb0.y = pk2(g0[2], g0[3]); wb0.z = pk2(g0[4], g0[5]); wb0.w = pk2(g0[6], g0[7]);
            wb1.x = pk2(g1[0], g1[1]); wb1.y = pk2(g1[2], g1[3]); wb1.z = pk2(g1[4], g1[5]); wb1.w = pk2(g1[6], g1[7]);
            const size_t off = ((size_t)chh * 256 + db * 64 + 2 * dp) * 256 + j0;
            *(v4u*)(kt + off) = wf0; *(v4u*)(kt + off + 256) = wf1; *(v4u*)(kt + KT2_DIR / 2 + off) = wb0; *(v4u*)(kt + KT2_DIR / 2 + off + 256) = wb1; }
        __syncthreads();
    }
#undef KT2_LOAD
}

__device__ __forceinline__ void p_scan(const Ctx& C) {
    bf16* bcat = (bf16*)(((unsigned char*)C.p(26)) + WS_ARENA + AR_BCAT); const float* lg = (const float*)(((unsigned char*)C.p(26)) + WS_LG);
    const int nitems = NBG * 4 * 2 * 512 * 32;
    for (int it = blockIdx.x * 512 + C.tid; it < nitems; it += C.G * 512) {
        const int c8 = it & 31, dv = (it >> 5) & 511, dir = (it >> 14) & 1, bh = it >> 15, h = bh & 3;
        const float gC = __builtin_amdgcn_exp2f(lg[dir * 4 + h] * 256.0f);
        bf16* base = bcat + (size_t)bh * NCH * 512 * 768 + (size_t)dv * 768 + 256 + dir * 256 + c8 * 8;
        v4u w[16];
#pragma unroll
        for (int st = 0; st < 16; ++st) { const int e = dir == 0 ? 1 + st : 16 - st; w[st] = *(const v4u*)(base + (size_t)e * 512 * 768); }
        float s[8] = {bflo(w[0].x), bfhi(w[0].x), bflo(w[0].y), bfhi(w[0].y), bflo(w[0].z), bfhi(w[0].z), bflo(w[0].w), bfhi(w[0].w)};
#pragma unroll
        for (int st = 1; st < 16; ++st) { const int e = dir == 0 ? 1 + st : 16 - st;
            s[0] = gC * s[0] + bflo(w[st].x); s[1] = gC * s[1] + bfhi(w[st].x); s[2] = gC * s[2] + bflo(w[st].y); s[3] = gC * s[3] + bfhi(w[st].y);
            s[4] = gC * s[4] + bflo(w[st].z); s[5] = gC * s[5] + bfhi(w[st].z); s[6] = gC * s[6] + bflo(w[st].w); s[7] = gC * s[7] + bfhi(w[st].w);
            v4u o; o.x = pk2(s[0], s[1]); o.y = pk2(s[2], s[3]); o.z = pk2(s[4], s[5]); o.w = pk2(s[6], s[7]); *(v4u*)(base + (size_t)e * 512 * 768) = o; }
    }
}

__device__ __forceinline__ void rt6_finish(const v4u (&w)[4], const v4u (&gw)[4], bf16* o, size_t r, int lane) {
#pragma unroll
    for (int c = 0; c < 4; ++c) { const size_t off = r * 2048 + (size_t)(c * 64 + lane) * 8;
        float v[8] = {bflo(w[c].x), bfhi(w[c].x), bflo(w[c].y), bfhi(w[c].y), bflo(w[c].z), bfhi(w[c].z), bflo(w[c].w), bfhi(w[c].w)};
        float g[8] = {bflo(gw[c].x), bfhi(gw[c].x), bflo(gw[c].y), bfhi(gw[c].y), bflo(gw[c].z), bfhi(gw[c].z), bflo(gw[c].w), bfhi(gw[c].w)};
        float s = 0.f;
#pragma unroll
        for (int x = 0; x < 8; ++x) s += v[x] * v[x];
        const float rstd = 1.0f / sqrtf(wave_sum(s) * (1.f / 512.f) + EPS);
#pragma unroll
        for (int x = 0; x < 8; ++x) v[x] = v[x] * rstd * g[x] * fast_sigmoid(g[x]);
        v4u ow; ow.x = pk2(v[0], v[1]); ow.y = pk2(v[2], v[3]); ow.z = pk2(v[4], v[5]); ow.w = pk2(v[6], v[7]); *(v4u*)(o + off) = ow; }
}
__device__ __forceinline__ void p_rt6(const Ctx& C) {
    bf16* o = (bf16*)(((unsigned char*)C.p(26)) + WS_ARENA + AR_O); const bf16* gate = (const bf16*)(((unsigned char*)C.p(26)) + WS_ARENA + AR_GATE);
    for (int rlA = C.gw; rlA < TL; rlA += 2 * C.NGW) { const int rlB = rlA + C.NGW; const bool hasB = rlB < TL;
        const size_t rA = (size_t)(rlA >> 12) * LE + CTX + (rlA & 4095); const int rlb = hasB ? rlB : rlA; const size_t rB = (size_t)(rlb >> 12) * LE + CTX + (rlb & 4095);
        v4u wA[4], gA[4], wB[4], gB[4];
#pragma unroll
        for (int c = 0; c < 4; ++c) { const size_t oa = rA * 2048 + (size_t)(c * 64 + C.lane) * 8, ob = rB * 2048 + (size_t)(c * 64 + C.lane) * 8;
            wA[c] = *(const v4u*)(o + oa); gA[c] = *(const v4u*)(gate + oa); wB[c] = *(const v4u*)(o + ob); gB[c] = *(const v4u*)(gate + ob); }
        rt6_finish(wA, gA, o, rA, C.lane);
        if (hasB) rt6_finish(wB, gB, o, rB, C.lane);
    }
}

__device__ __forceinline__ void p_m1(const Ctx& C) {
    const bf16* mi = (const bf16*)(((unsigned char*)C.p(26)) + WS_ARENA + AR_MLAIN); bf16* mn = (bf16*)(((unsigned char*)C.p(26)) + WS_ARENA + AR_MLAN);
    for (int r0 = C.gw; r0 < TE; r0 += 4 * C.NGW) {
        unsigned w[4][5];
#pragma unroll
        for (int q = 0; q < 4; ++q) { const int r = r0 + q * C.NGW; const unsigned* src = (const unsigned*)(mi + (size_t)(r < TE ? r : r0) * 768);
#pragma unroll
            for (int i = 0; i < 5; ++i) w[q][i] = src[C.lane + 64 * i]; }
#pragma unroll
        for (int q = 0; q < 4; ++q) { const int r = r0 + q * C.NGW; float sq = 0.f, sk = 0.f;
#pragma unroll
            for (int i = 0; i < 5; ++i) { const float a = bflo(w[q][i]), b = bfhi(w[q][i]); if (i < 3) sq += a * a + b * b; else sk += a * a + b * b; }
            const float rq = 1.0f / sqrtf(wave_sum(sq) * (1.f / 384.f) + EPS), rk = 1.0f / sqrtf(wave_sum(sk) * (1.f / 256.f) + EPS);
            if (r < TE) { unsigned* dst = (unsigned*)(mn + (size_t)r * 640);
#pragma unroll
                for (int i = 0; i < 5; ++i) { const float sc = i < 3 ? rq : rk; dst[C.lane + 64 * i] = pk2(bflo(w[q][i]) * sc, bfhi(w[q][i]) * sc); } } }
    }
}
__device__ __forceinline__ void build_ptab(const Ctx& C, const unsigned* cnt) {
    volatile LAS int* T = (volatile LAS int*)(C.lds + MISC_OFF);
    __syncthreads();
    if (C.tid < NEXP) { const int c = (int)__hip_atomic_load(cnt + C.tid, RLX_AGENT); T[672 + C.tid] = c; T[640 + C.tid] = (c + 255) >> 8; }
    __syncthreads();
    if (C.tid < NEXP) { int acc = 0; for (int e = 0; e < C.tid; ++e) acc += T[640 + e]; const int np = T[640 + C.tid];
        T[16 + C.tid] = acc; for (int p = 0; p < np; ++p) T[64 + acc + p] = C.tid; if (C.tid == NEXP - 1) T[16 + NEXP] = acc + np; }
    __syncthreads();
}
#define LX1(v) __builtin_bit_cast(float, __builtin_amdgcn_update_dpp(0, __builtin_bit_cast(int, (v)), 0xB1, 0xF, 0xF, true))
#define LX2(v) __builtin_bit_cast(float, __builtin_amdgcn_update_dpp(0, __builtin_bit_cast(int, (v)), 0x4E, 0xF, 0xF, true))
#define LX8(v) __builtin_bit_cast(float, __builtin_amdgcn_update_dpp(0, __builtin_bit_cast(int, (v)), 0x128, 0xF, 0xF, true))
#define LX4(v) SWZ_XOR((v), 4)
#define LX16(v) SWZ_XOR((v), 16)
__device__ __forceinline__ float reduce32_transposed(const float (&L)[32], int lane) {
    float M[16], N[8], P[4], Q[2];
#pragma unroll
    for (int e = 0; e < 16; ++e) { unsigned a_ = __builtin_bit_cast(unsigned, L[e]), b_ = __builtin_bit_cast(unsigned, L[e + 16]);
        auto rr = __builtin_amdgcn_permlane32_swap(a_, b_, false, false); unsigned r0_ = rr[0], r1_ = rr[1]; asm volatile("" : "+v"(r0_), "+v"(r1_));
        M[e] = __builtin_bit_cast(float, r0_) + __builtin_bit_cast(float, r1_); }
    const bool b3 = (lane & 8) != 0, b2 = (lane & 4) != 0, b1 = (lane & 2) != 0;
#pragma unroll
    for (int e = 0; e < 8; ++e) { unsigned a_ = __builtin_bit_cast(unsigned, M[e]), b_ = __builtin_bit_cast(unsigned, M[e + 8]);
        auto rr = __builtin_amdgcn_permlane16_swap(a_, b_, false, false); unsigned r0_ = rr[0], r1_ = rr[1]; asm volatile("" : "+v"(r0_), "+v"(r1_));
        N[e] = __builtin_bit_cast(float, r0_) + __builtin_bit_cast(float, r1_); }
#pragma unroll
    for (int e = 0; e < 4; ++e) { const float snd = b3 ? N[e] : N[e + 4]; P[e] = (b3 ? N[e + 4] : N[e]) + LX8(snd); }
#pragma unroll
    for (int e = 0; e < 2; ++e) { const float snd = b2 ? P[e] : P[e + 2]; Q[e] = (b2 ? P[e + 2] : P[e]) + LX4(snd); }
    const float snd = b1 ? Q[0] : Q[1]; float R = (b1 ? Q[1] : Q[0]) + LX2(snd);
    R += LX1(R);
    return R;
}
__device__ __forceinline__ void e1_route_t(float v, int ridx0, bool hasB, int lane, LAS unsigned* lcnt, LAS unsigned* rec) {
    int se[4]; float sv[4]; const unsigned myi = (unsigned)lane >> 1;
    const unsigned kb = __builtin_bit_cast(unsigned, v); unsigned key = kb ^ ((unsigned)((int)kb >> 31) | 0x80000000u);
#define UX2(x) ((unsigned)__builtin_amdgcn_update_dpp(0, (int)(x), 0x4E, 0xF, 0xF, true))
#define UX8(x) ((unsigned)__builtin_amdgcn_update_dpp(0, (int)(x), 0x128, 0xF, 0xF, true))
#define UX4(x) ((unsigned)__builtin_amdgcn_update_dpp(0, __builtin_amdgcn_update_dpp(0, (int)(x), 0x141, 0xF, 0xF, true), 0x1B, 0xF, 0xF, true))
#define USWAP(x, OP, BI) { unsigned a_ = (x), b_ = a_; asm volatile("" : "+v"(b_)); auto rr = BI(a_, b_, false, false); unsigned r0_ = rr[0], r1_ = rr[1]; asm volatile("" : "+v"(r0_), "+v"(r1_)); (x) = OP(r0_, r1_); }
#define UMAX(a, b) ((a) > (b) ? (a) : (b))
#define UMIN(a, b) ((a) < (b) ? (a) : (b))
#pragma unroll
    for (int k = 0; k < 4; ++k) { unsigned mk = key;
        { const unsigned o = UX2(mk); mk = UMAX(mk, o); } { const unsigned o = UX4(mk); mk = UMAX(mk, o); } { const unsigned o = UX8(mk); mk = UMAX(mk, o); }
        USWAP(mk, UMAX, __builtin_amdgcn_permlane16_swap) USWAP(mk, UMAX, __builtin_amdgcn_permlane32_swap)
        unsigned ci = key == mk ? myi : 64u;
        { const unsigned o = UX2(ci); ci = UMIN(ci, o); } { const unsigned o = UX4(ci); ci = UMIN(ci, o); } { const unsigned o = UX8(ci); ci = UMIN(ci, o); }
        USWAP(ci, UMIN, __builtin_amdgcn_permlane16_swap) USWAP(ci, UMIN, __builtin_amdgcn_permlane32_swap)
        se[k] = (int)ci; sv[k] = __builtin_bit_cast(float, mk ^ ((mk >> 31) ? 0x80000000u : 0xFFFFFFFFu)); if (myi == ci) key = 0u; }
#undef UX2
#undef UX8
#undef UX4
#undef USWAP
#undef UMAX
#undef UMIN
    const float L2E = 1.4426950408889634f; const float e1 = __builtin_amdgcn_exp2f((sv[1] - sv[0]) * L2E), e2 = __builtin_amdgcn_exp2f((sv[2] - sv[0]) * L2E), e3 = __builtin_amdgcn_exp2f((sv[3] - sv[0]) * L2E); const float inv = __builtin_amdgcn_rcpf(1.0f + e1 + e2 + e3);
    const float gt[4] = {inv, e1 * inv, e2 * inv, e3 * inv};
    if (lane < 8 && (hasB || (lane & 1) == 0)) { const int k = lane >> 1, ridx = ridx0 + (lane & 1); const int e = k == 0 ? se[0] : k == 1 ? se[1] : k == 2 ? se[2] : se[3]; const float gk = k == 0 ? gt[0] : k == 1 ? gt[1] : k == 2 ? gt[2] : gt[3];
        const unsigned pos = __hip_atomic_fetch_add(lcnt + e, 1u, __ATOMIC_RELAXED, __HIP_MEMORY_SCOPE_WORKGROUP);
        LAS unsigned* rp = rec + (ridx * 4 + k) * 3; rp[0] = (unsigned)e; rp[1] = pos; rp[2] = __builtin_bit_cast(unsigned, gk); }
}
__device__ __forceinline__ void e1_route(const float (&lgt)[32], int ridx, int lane, LAS unsigned* lcnt, LAS unsigned* rec) {
    int se[4]; float sv[4];
#pragma unroll
    for (int k = 0; k < 4; ++k) { float best = -3.0e38f; int bi = 0;
#pragma unroll
        for (int e = 0; e < 32; ++e) { const bool taken = (k > 0 && se[0] == e) || (k > 1 && se[1] == e) || (k > 2 && se[2] == e); if (!taken && lgt[e] > best) { best = lgt[e]; bi = e; } }
        se[k] = bi; sv[k] = best; }
    const float e1 = expf(sv[1] - sv[0]), e2 = expf(sv[2] - sv[0]), e3 = expf(sv[3] - sv[0]); const float inv = 1.0f / (1.0f + e1 + e2 + e3);
    const float gt[4] = {inv, e1 * inv, e2 * inv, e3 * inv};
    if (lane < 4) { const int k = lane; const int e = k == 0 ? se[0] : k == 1 ? se[1] : k == 2 ? se[2] : se[3]; const float gk = k == 0 ? gt[0] : k == 1 ? gt[1] : k == 2 ? gt[2] : gt[3];
        const unsigned pos = __hip_atomic_fetch_add(lcnt + e, 1u, __ATOMIC_RELAXED, __HIP_MEMORY_SCOPE_WORKGROUP);
        LAS unsigned* rp = rec + (ridx * 4 + k) * 3; rp[0] = (unsigned)e; rp[1] = pos; rp[2] = __builtin_bit_cast(unsigned, gk); }
}
__device__ __forceinline__ void e1_rawload(v2u (&raw)[4], const float* x1, int grp, int tl, int lane) {
    const int bl = tl >> 12, b = grp * NBM + bl; const size_t tok = (size_t)b * SEQ + (tl & 4095);
#pragma unroll
    for (int j = 0; j < 4; ++j) raw[j] = *(const v2u*)((const bf16*)(x1 + tok * 1024) + 4 * lane + 256 * j);
}
struct E1Par { f32x4 gs[4], sha[4]; };
__device__ __forceinline__ void e1_params(E1Par& P, const float* g2, const float* ada, int grp, int tl, int lane) {
    const int bl = tl >> 12, b = grp * NBM + bl;
    const float* mod = ada + (size_t)b * 6144 + 3072;
    f32x4 ga[4], sca[4];
#pragma unroll
    for (int j = 0; j < 4; ++j) { const int c = 4 * lane + 256 * j; ga[j] = *(const f32x4*)(g2 + c); sca[j] = *(const f32x4*)(mod + 1024 + c); P.sha[j] = *(const f32x4*)(mod + c); }
#pragma unroll
    for (int j = 0; j < 4; ++j) P.gs[j] = ga[j] * (sca[j] + 1.0f);
}
__device__ __forceinline__ void e1_row(f32x4 (&v)[4], const v2u (&raw)[4], const E1Par& P, bf16* h2, int tl, int lane) {
    float s = 0.f;
#pragma unroll
    for (int j = 0; j < 4; ++j) { const v2u w = raw[j]; v[j] = (f32x4){bflo(w.x), bfhi(w.x), bflo(w.y), bfhi(w.y)}; s += (v[j].x * v[j].x + v[j].y * v[j].y) + (v[j].z * v[j].z + v[j].w * v[j].w); }
    const float rstd = __builtin_amdgcn_rsqf(wave_sum(s) * (1.f / D) + EPS);
#pragma unroll
    for (int j = 0; j < 4; ++j) { const int c = 4 * lane + 256 * j;
        v[j] = (v[j] * rstd) * P.gs[j] + P.sha[j];
        v2u w; w.x = cvt_pk_bf16(v[j].x, v[j].y); w.y = cvt_pk_bf16(v[j].z, v[j].w); *(v2u*)(h2 + (size_t)tl * 1024 + c) = w; }
}
__device__ __forceinline__ void p_e1(const Ctx& C, int grp) {
    const float* x1 = ((float*)C.p(25)); const float* g2 = ((const float*)C.p(5)); const float* ada = (const float*)(((unsigned char*)C.p(26)) + WS_ADA); const float* rwg = ((const float*)C.p(18)); const float* rb = ((const float*)C.p(19));
    bf16* h2 = (bf16*)(((unsigned char*)C.p(26)) + WS_ARENA + AR_H2); int* sel = (int*)(((unsigned char*)C.p(26)) + WS_ARENA + AR_SEL);
    unsigned* cnt = (unsigned*)(((unsigned char*)C.p(26)) + WS_CTL) + CW_CNT + grp * 64;
    LAS float* rw = (LAS float*)C.lds;
    LAS unsigned* lcnt = (LAS unsigned*)(C.lds + MISC_OFF + MISC_LCNT);
    LAS unsigned* rec = (LAS unsigned*)(C.lds + MISC_OFF + 8192);
    if (C.tid < 32) lcnt[C.tid] = 0u;
    { f32x4 rv[16];
#pragma unroll
      for (int i = 0; i < 16; ++i) rv[i] = *(const f32x4*)(rwg + (size_t)(C.tid + 512 * i) * 4);
#pragma unroll
      for (int i = 0; i < 16; ++i) { const int q = C.tid + 512 * i, k = q >> 3, eg = q & 7; const int l = (k & 255) >> 2, j = k >> 8, c = k & 3; *(LAS f32x4*)(rw + (((j * 4 + c) * 8 + eg) * 64 + l) * 4) = rv[i]; } }
    __syncthreads();
    const int tl0 = C.gw * 16; const bool live = tl0 < TLM && 16 * 8 * C.G >= TLM;
    E1Par P; e1_params(P, g2, ada, grp, live ? tl0 : 0, C.lane);
    const float be = rb[C.lane >> 1];
    v2u rawA[4], rawB[4];
    e1_rawload(rawA, x1, grp, live ? tl0 : 0, C.lane); e1_rawload(rawB, x1, grp, live ? tl0 + 1 : 0, C.lane);
    for (int trip = 0; live && trip < 8; ++trip) {
        const int tlA = tl0 + 2 * trip, tlB = tlA + 1; const bool hasB = true;
        f32x4 vA[4], vB[4]; v2u nxA[4], nxB[4];
        { const int nA = trip < 7 ? tlA + 2 : tlA;
          e1_rawload(nxA, x1, grp, nA, C.lane); e1_rawload(nxB, x1, grp, nA + 1, C.lane); }
        e1_row(vA, rawA, P, h2, tlA, C.lane);
        e1_row(vB, rawB, P, h2, tlB, C.lane);
        float lgA[32], lgB[32];
        { f32x4 rb0[8], rb1[8];
#define E1_LD8(buf, eg, h) _Pragma("unroll") for (int k = 0; k < 8; ++k) buf[k] = *(const LAS f32x4*)(rw + ((((h) * 8 + k) * 8 + (eg)) * 64 + C.lane) * 4);
#define E1_FM8(buf, h) _Pragma("unroll") for (int k = 0; k < 8; ++k) { const int kk = (h) * 8 + k; const float a_ = vA[kk >> 2][kk & 3], b_ = vB[kk >> 2][kk & 3];                  \
            const f32x2 r01 = {buf[k].x, buf[k].y}, r23 = {buf[k].z, buf[k].w}, a2 = {a_, a_}, b2 = {b_, b_};                                                                   \
            if (kk == 0) { aA0 = a2 * r01; aA1 = a2 * r23; aB0 = b2 * r01; aB1 = b2 * r23; }                                                                                   \
            else { aA0 = __builtin_elementwise_fma(a2, r01, aA0); aA1 = __builtin_elementwise_fma(a2, r23, aA1); aB0 = __builtin_elementwise_fma(b2, r01, aB0); aB1 = __builtin_elementwise_fma(b2, r23, aB1); } }
          E1_LD8(rb0, 0, 0)
#pragma unroll
          for (int eg = 0; eg < 8; ++eg) { f32x2 aA0, aA1, aB0, aB1;
              E1_LD8(rb1, eg, 1) __builtin_amdgcn_sched_barrier(0);
              E1_FM8(rb0, 0) __builtin_amdgcn_sched_barrier(0);
              if (eg < 7) { E1_LD8(rb0, eg + 1, 0) } __builtin_amdgcn_sched_barrier(0);
              E1_FM8(rb1, 1) __builtin_amdgcn_sched_barrier(0);
              lgA[eg * 4 + 0] = aA0.x; lgA[eg * 4 + 1] = aA0.y; lgA[eg * 4 + 2] = aA1.x; lgA[eg * 4 + 3] = aA1.y;
              lgB[eg * 4 + 0] = aB0.x; lgB[eg * 4 + 1] = aB0.y; lgB[eg * 4 + 2] = aB1.x; lgB[eg * 4 + 3] = aB1.y; }
#undef E1_LD8
#undef E1_FM8
        }
        {
          const float vA1 = reduce32_transposed(lgA, C.lane) + be, vB1 = reduce32_transposed(lgB, C.lane) + be;
          e1_route_t((C.lane & 1) ? vB1 : vA1, C.wave * 16 + 2 * trip, hasB, C.lane, lcnt, rec); }
#pragma unroll
        for (int j = 0; j < 4; ++j) { rawA[j] = nxA[j]; rawB[j] = nxB[j]; }
    }
    __syncthreads();
    if (C.tid < 32) lcnt[32 + C.tid] = __hip_atomic_fetch_add(cnt + C.tid, lcnt[C.tid], RLX_AGENT);
    __syncthreads();
    { const int i = C.tid, w = i >> 6, t = (i >> 2) & 15, k = i & 3; const int tl = ((int)blockIdx.x * 8 + w) * 16 + t;
      if (tl < TLM && 16 * 8 * C.G >= TLM) {
          const unsigned e = rec[i * 3], lp = rec[i * 3 + 1]; const float gk = __builtin_bit_cast(float, rec[i * 3 + 2]);
          const unsigned posg = lcnt[32 + e] + lp, d = e * (unsigned)TLM + posg;
          float* rowg = (float*)(((unsigned char*)C.p(26)) + WS_ARENA + AR_ROWG); unsigned short* rowtok = (unsigned short*)(((unsigned char*)C.p(26)) + WS_ARENA + AR_ROWTOK);
          rowtok[(d & ~127u) + 2 * (d & 63u) + ((d >> 6) & 1u)] = (unsigned short)tl; rowg[d] = gk; sel[(size_t)TLM * 12 + (size_t)tl * 4 + k] = (int)(e | (posg << 8)); } }
    if (blockIdx.x == 0 && C.tid < 128) { unsigned zz = 0u; asm volatile("" : "+v"(zz)); ((v4u*)(h2 + (size_t)TLM * 1024))[C.tid] = (v4u){zz, zz, zz, zz}; }
    __syncthreads();
}
typedef int i32x4 __attribute__((ext_vector_type(4)));
__device__ __forceinline__ void e5_load(f32x4 (&v)[4], const float* out, const float* ada, const bf16* ys, const i32x4 rec4, const volatile LAS int* T, int grp, int tl, int lane) {
    const int bl = tl >> 12, b = grp * NBM + bl; const size_t tok = (size_t)b * SEQ + (tl & 4095);
    const float* g2v = ada + (size_t)b * 6144 + 5120;
    i32x4 d4;
#pragma unroll
    for (int k = 0; k < 4; ++k) d4[k] = T[16 + (rec4[k] & 255)] * 256 + (int)((unsigned)rec4[k] >> 8);
#pragma unroll
    for (int j = 0; j < 2; ++j) { const int c = 8 * lane + 512 * j; f32x4 m0 = (f32x4){0.f, 0.f, 0.f, 0.f}, m1 = m0;
#pragma unroll
        for (int k = 0; k < 4; ++k) { const v4u w = *(const v4u*)(ys + (size_t)d4[k] * 1024 + c);
            m0 += (f32x4){bflo(w.x), bfhi(w.x), bflo(w.y), bfhi(w.y)}; m1 += (f32x4){bflo(w.z), bfhi(w.z), bflo(w.w), bfhi(w.w)}; }
        const v4u xw = *(const v4u*)((const bf16*)(out + tok * 1024) + c);
        v[2 * j] = (f32x4){bflo(xw.x), bfhi(xw.x), bflo(xw.y), bfhi(xw.y)} + *(const f32x4*)(g2v + c) * m0;
        v[2 * j + 1] = (f32x4){bflo(xw.z), bfhi(xw.z), bflo(xw.w), bfhi(xw.w)} + *(const f32x4*)(g2v + c + 4) * m1; }
}
__device__ __forceinline__ void e5_store(const f32x4 (&v)[4], float* out, const f32x4 (&fga)[4], int grp, int tl, int lane) {
    const int bl = tl >> 12, b = grp * NBM + bl; const size_t tok = (size_t)b * SEQ + (tl & 4095);
    float s = 0.f;
#pragma unroll
    for (int j = 0; j < 4; ++j) s += (v[j].x * v[j].x + v[j].y * v[j].y) + (v[j].z * v[j].z + v[j].w * v[j].w);
    const float rstd = 1.0f / sqrtf(wave_sum(s) * (1.f / D) + EPS);
#pragma unroll
    for (int j = 0; j < 4; ++j) { const int c = 8 * lane + 512 * (j >> 1) + 4 * (j & 1); __builtin_nontemporal_store(v[j] * rstd * fga[j], (f32x4*)(out + tok * 1024 + c)); }
}
__device__ __forceinline__ void p_e5(const Ctx& C, int grp) {
    float* out = ((float*)C.p(25)); const float* ada = (const float*)(((unsigned char*)C.p(26)) + WS_ADA); const float* fg = ((const float*)C.p(24));
    const bf16* ys = (const bf16*)(((unsigned char*)C.p(26)) + WS_ARENA + AR_XS); const int* sel = (const int*)(((unsigned char*)C.p(26)) + WS_ARENA + AR_SEL);
    build_ptab(C, (const unsigned*)(((unsigned char*)C.p(26)) + WS_CTL) + CW_CNT + grp * 64);
    const volatile LAS int* T = (const volatile LAS int*)(C.lds + MISC_OFF);
    f32x4 fga[4];
#pragma unroll
    for (int j = 0; j < 4; ++j) fga[j] = *(const f32x4*)(fg + 8 * C.lane + 512 * (j >> 1) + 4 * (j & 1));
    const int* dsel = sel + (size_t)TLM * 12;
    i32x4 dA = {0, 0, 0, 0}, dB = {0, 0, 0, 0};
    if (C.gw < TLM) { dA = *(const i32x4*)(dsel + (size_t)C.gw * 4); const int tb = C.gw + C.NGW; dB = *(const i32x4*)(dsel + (size_t)(tb < TLM ? tb : C.gw) * 4); }
    for (int tlA = C.gw; tlA < TLM; tlA += 2 * C.NGW) {
        const int tlB = tlA + C.NGW; const bool hasB = tlB < TLM;
        f32x4 vA[4], vB[4];
        e5_load(vA, out, ada, ys, dA, T, grp, tlA, C.lane);
        if (hasB) e5_load(vB, out, ada, ys, dB, T, grp, tlB, C.lane);
        { const int nA = tlA + 2 * C.NGW, nB = nA + C.NGW; if (nA < TLM) { dA = *(const i32x4*)(dsel + (size_t)nA * 4); dB = *(const i32x4*)(dsel + (size_t)(nB < TLM ? nB : nA) * 4); } }
        e5_store(vA, out, fga, grp, tlA, C.lane);
        if (hasB) e5_store(vB, out, fga, grp, tlB, C.lane);
    }
}
#ifndef PH_MASK
#define PH_MASK 0xFFFFFFFFu
#endif
#define EN(k) ((PH_MASK >> (k)) & 1u)
constexpr int NM = 8, NE = 4, NSGS = 2 * NM + NE, NSTEPS = 1 + NSG * NSGS;
#ifndef MK_ONE_LAUNCH
#define MK_ONE_LAUNCH 1
#endif

__global__ void __launch_bounds__(512, 2) fwd_kernel(Params P) {
    extern __shared__ __attribute__((aligned(16))) unsigned char lds_raw[];
    Ctx C; C.lds = (LAS unsigned char*)lds_raw; C.tid = threadIdx.x; C.lane = C.tid & 63; C.wave = __builtin_amdgcn_readfirstlane(C.tid >> 6);
    C.G = gridDim.x; C.gw = blockIdx.x * 8 + C.wave; C.NGW = C.G * 8; int wave_s = C.wave;
    volatile LAS unsigned* MISC = (volatile LAS unsigned*)(C.lds + MISC_OFF);
    if (C.tid < 4) MISC[C.tid] = 0u;
    if (C.tid == 0) { volatile LAS unsigned long long* PT = (volatile LAS unsigned long long*)(C.lds + MISC_OFF + MISC_PT);
#pragma unroll
        for (int i = 0; i < 25; ++i) PT[i] = (unsigned long long)P.in[i];
        PT[25] = (unsigned long long)P.out; PT[26] = (unsigned long long)P.ws; }
    __syncthreads();
    const int lo = P.ph_lo, hi = P.ph_hi;
    if (hi - lo > 1) (void)xcd_barrier_post((unsigned*)((unsigned char*)C.p(26) + WS_CTL) + CW_BAR, MISC);
#define IN(k) (lo <= (k) && (k) < hi)
#define NOCONT pg8::Cont{nullptr, nullptr, 0, 0}
#define OPAQ() { int l_; asm volatile("v_mbcnt_lo_u32_b32 %0, -1, 0\n\tv_mbcnt_hi_u32_b32 %0, -1, %0" : "=v"(l_)); asm volatile("" : "+s"(wave_s)); \
      C.lane = l_; C.wave = wave_s; C.tid = wave_s * 64 + l_; C.gw = blockIdx.x * 8 + wave_s; } \
    unsigned char* ws = (unsigned char*)C.p(26); unsigned char* ar = ws + WS_ARENA; (void)ar; \
    const float2* tabr = (const float2*)(ws + WS_TABR); const float2* tabm = (const float2*)(ws + WS_TABM); const float* lg = (const float*)(ws + WS_LG); (void)tabr; (void)tabm; (void)lg
#define SEAM(k) do { if (IN((k) + 1)) { XcdBarrier b2_; b2_.bar = (unsigned*)((unsigned char*)C.p(26) + WS_CTL) + CW_BAR; b2_.x = xb_xcc_id(); b2_.st = MISC; xcd_barrier(b2_, wave_s * 64 + lane_id_asm()); } } while (0)
    LAS unsigned char* ring = C.lds;
    const int G = C.G, cb = (int)blockIdx.x;

    if (EN(0) && IN(0)) { OPAQ(); p0_weights(C); __syncthreads(); p0_ada(C); SEAM(0); }

    for (int sg = 0; sg < NSG; ++sg) {
      const int b0 = 1 + sg * NSGS;
      if (hi <= b0 || lo >= b0 + NSGS) continue;
      for (int gi = 0; gi < 2; ++gi) {
        const int grp = sg * 2 + gi, s0 = b0 + gi * NM;
        if (hi <= s0 || lo >= s0 + NM) continue;
        if (EN(1) && grp == 0 && IN(s0 + 0)) { OPAQ(); p1_hext(C, grp); SEAM(s0 + 0); }
        if (EN(2) && IN(s0 + 1)) { OPAQ();
            { SchedGAV S{(const char*)(ar + AR_H), (const char*)(ws + WS_WIN), G, cb};
              EpiGAV E{EpiGA{(bf16*)(ar + AR_Q), (bf16*)(ar + AR_K), (bf16*)(ar + AR_ACAT), (bf16*)(ar + AR_MLAIN), tabr, tabm, lg, (float*)(ar + AR_SSQ)}, EpiStore<LocGV>{LocGV{(bf16*)(ar + AR_BCAT)}}};
              pg8::gemm_phase<EpiGAV, SchedGAV, 1024, 1024, 16>(ring, S, E, wave_s); }
            SEAM(s0 + 1); }
        if (EN(3) && IN(s0 + 2)) { OPAQ();
            const int gemm_first = (cb >> 3) & 1;
#pragma unroll 1
            for (int half = 0; half < 2; ++half) {
                int do_gemm = (half ^ gemm_first) ^ 1; asm volatile("" : "+s"(do_gemm));
                if (!do_gemm) { int l_; asm volatile("v_mbcnt_lo_u32_b32 %0, -1, 0\n\tv_mbcnt_hi_u32_b32 %0, -1, %0" : "=v"(l_)); C.lane = l_; C.tid = wave_s * 64 + l_; p_kt2(C); }
                else {
                       Sched2D<true, false> S2{(const char*)(ar + AR_H), (const char*)(ws + WS_WIN + (size_t)WIN_GATE * 1024 * 2), (size_t)256 * 1024 * 2, (size_t)256 * 1024 * 2, TL / 256, 8, G, cb};
                       pg8::Unit nu; const bool hn = S2.next(0, nu); bool ps;
                       { SchedRT4 S{(const char*)(ar + AR_Q), (const char*)(ar + AR_K), G, cb}; EpiRT4 E{(bf16*)(ar + AR_ACAT), lg};
                         ps = pg8::gemm_phase<EpiRT4, SchedRT4, 1024, 1024, 4>(ring, S, E, wave_s, hn ? pg8::Cont{nu.a, nu.b, 1024, 1024} : NOCONT); }
                       { EpiStore<LocGB> E{LocGB{(bf16*)(ar + AR_GATE), (bf16*)(ar + AR_GRET), (bf16*)(ar + AR_GMLA)}};
                         pg8::gemm_phase<EpiStore<LocGB>, Sched2D<true, false>, 1024, 1024, 16>(ring, S2, E, wave_s, NOCONT, ps); } }
                __syncthreads();
            }
            SEAM(s0 + 2); }
        if (EN(4) && IN(s0 + 3)) { OPAQ();
            Sched2D<true, false> SM2{(const char*)(ar + AR_MLAIN), (const char*)(ws + WS_WUQ), (size_t)256 * 768 * 2, (size_t)256 * 384 * 2, TL / 256, 6, G, cb};
            Sched2D<false, false> SM3{(const char*)(ar + AR_MLAIN) + 384 * 2, (const char*)(ws + WS_WUKV), (size_t)256 * 768 * 2, (size_t)256 * 256 * 2, TE / 256, 8, G, G == 256 ? ((cb + 128) & 255) : cb};
            pg8::Unit nu2, nu3; const bool hn2 = SM2.next(0, nu2), hn3 = SM3.next(0, nu3); bool ps2, ps3;
            { SchedRT2 S{(const char*)(ar + AR_BCAT), (const char*)(ar + AR_KT2), G, cb}; EpiStore<LocRT2> E{LocRT2{(bf16*)(ar + AR_BCAT)}};
              ps2 = pg8::gemm_phase<EpiStore<LocRT2>, SchedRT2, 768, 256, 4>(ring, S, E, wave_s, hn2 ? pg8::Cont{nu2.a, nu2.b, 768, 384} : NOCONT); }
            { EpiM2 E{(bf16*)(ar + AR_QMLA), tabm, (const float*)(ar + AR_SSQ)};
              ps3 = pg8::gemm_phase<EpiM2, Sched2D<true, false>, 768, 384, 6>(ring, SM2, E, wave_s, hn3 ? pg8::Cont{nu3.a, nu3.b, 768, 256} : NOCONT, ps2); }
            { const Sched2D<false, false>& S = SM3;
              EpiM3 E{(bf16*)(ar + AR_KVMLA), (const float*)(ar + AR_SSQ)};
              pg8::gemm_phase<EpiM3, Sched2D<false, false>, 768, 256, 4>(ring, S, E, wave_s, NOCONT, ps3); }
            SEAM(s0 + 3); }
        if (EN(5) && IN(s0 + 4)) { OPAQ();
            const int att_first = (cb >> 3) & 1;
#pragma unroll 1
            for (int half = 0; half < 2; ++half) {
                int do_att = (half ^ att_first) ^ 1; asm volatile("" : "+s"(do_att));
                if (!do_att) { int l_; asm volatile("v_mbcnt_lo_u32_b32 %0, -1, 0\n\tv_mbcnt_hi_u32_b32 %0, -1, %0" : "=v"(l_)); C.lane = l_; C.tid = wave_s * 64 + l_; p_scan(C); }
                else {
                    const bf16* qm = (const bf16*)(ar + AR_QMLA); const bf16* kv = (const bf16*)(ar + AR_KVMLA); const bf16* mi = (const bf16*)(ar + AR_MLAIN); bf16* ao = (bf16*)(ar + AR_ATTO);
                    for (int it0 = cb; it0 < NBG * 8 * 16; it0 += G) {
                        int it = it0; if (G == 256) { const int xcd = cb & 7, slot = cb >> 3, hp = (it0 >> 8) * 16 + xcd * 2 + (slot >> 4); it = hp * 16 + (slot & 15); }
                        const int qb = it & 15, h = (it >> 4) & 7, bl = it >> 7; const size_t rb = (size_t)bl * LE, rq = rb + CTX + qb * 256;
                        att::attn_body(qm + rq * 1536 + h * 192, kv + rb * 2048 + h * 256, mi + rb * 768 + 640, kv + rb * 2048 + h * 256 + 128, ao + rq * 1024 + h * 128, LE, (char*)lds_raw, wave_s);
                        __syncthreads(); }
                }
                __syncthreads();
            }
            SEAM(s0 + 4); }
        if (EN(6) && IN(s0 + 5)) { OPAQ();
            Sched2D<true, false> SG{(const char*)(ar + AR_H), (const char*)(ws + WS_WIN + (size_t)WIN_GATE * 1024 * 2), (size_t)256 * 1024 * 2, (size_t)256 * 1024 * 2, TL / 256, 8, G, cb, 8};
            pg8::Unit nu; const bool hn = SG.next(0, nu); bool ps;
            { SchedRT5 S{(const char*)(ar + AR_ACAT), (const char*)(ar + AR_BCAT), G, cb}; EpiRT5F E{(bf16*)(ar + AR_O), (const bf16*)(ar + AR_GATE), (float*)(ar + AR_SSQ)};
              ps = pg8::gemm_phase<EpiRT5F, SchedRT5, 3072, 768, 12>(ring, S, E, wave_s, hn ? pg8::Cont{nu.a, nu.b, 1024, 1024} : NOCONT); }
            { EpiStore<LocGB> E{LocGB{(bf16*)(ar + AR_GATE), (bf16*)(ar + AR_GRET), (bf16*)(ar + AR_GMLA)}};
              pg8::gemm_phase<EpiStore<LocGB>, Sched2D<true, false>, 1024, 1024, 16>(ring, SG, E, wave_s, NOCONT, ps); }
            SEAM(s0 + 5); }
        if (EN(8) && IN(s0 + 6)) { OPAQ();
            Sched2D<true, false> S2{(const char*)(ar + AR_ATTO), (const char*)(ws + WS_WBM), (size_t)256 * 1024 * 2, (size_t)256 * 1024 * 2, TL / 256, 4, G, cb};
            pg8::Unit nu; const bool hn = S2.next(0, nu); bool ps;
            { Sched2D<true, false> S{(const char*)(ar + AR_O), (const char*)(ws + WS_WBR), (size_t)256 * 2048 * 2, (size_t)256 * 2048 * 2, TL / 256, 4, G, cb};
              EpiG1 E{(const bf16*)(ar + AR_GRET), (bf16*)(ar + AR_T1), (const float*)(ar + AR_SSQ)};
              ps = pg8::gemm_phase<EpiG1, Sched2D<true, false>, 2048, 2048, 32>(ring, S, E, wave_s, hn ? pg8::Cont{nu.a, nu.b, 1024, 1024} : NOCONT); }
            asm volatile("s_waitcnt vmcnt(0)" ::: "memory");
            { EpiGate<true> E{(const bf16*)(ar + AR_GMLA), (const bf16*)(ar + AR_T1), (bf16*)(ar + AR_MERGED)};
              pg8::gemm_phase<EpiGate<true>, Sched2D<true, false>, 1024, 1024, 16>(ring, S2, E, wave_s, NOCONT, ps); }
            SEAM(s0 + 6); }
        if (EN(9) && IN(s0 + 7)) { OPAQ();
            const int gemm_first = (cb >> 3) & 1;
#pragma unroll 1
            for (int half = 0; half < 2; ++half) {
                int do_gemm = (half ^ gemm_first) ^ 1; asm volatile("" : "+s"(do_gemm));
                if (do_gemm) {
                    Sched2D<true, false> S{(const char*)(ar + AR_MERGED), (const char*)(ws + WS_WO), (size_t)256 * 1024 * 2, (size_t)256 * 1024 * 2, TL / 256, 4, G, cb};
                    EpiG3 E{((const float*)C.p(0)), (const float*)(ws + WS_ADA), ((float*)C.p(25)), grp * NBG};
                    pg8::gemm_phase<EpiG3, Sched2D<true, false>, 1024, 1024, 16>(ring, S, E, wave_s); }
                else if (gi == 0) { int l_; asm volatile("v_mbcnt_lo_u32_b32 %0, -1, 0\n\tv_mbcnt_hi_u32_b32 %0, -1, %0" : "=v"(l_)); C.lane = l_; C.tid = wave_s * 64 + l_; p1_hext(C, grp + 1); }
                __syncthreads();
            }
            SEAM(s0 + 7); }
      }
      const int e0 = b0 + 2 * NM;
      if (EN(12) && IN(e0 + 0)) { OPAQ(); p_e1(C, sg); SEAM(e0 + 0); }
      if (EN(14) && IN(e0 + 1)) { OPAQ();
          const unsigned* cnt = (const unsigned*)(ws + WS_CTL) + CW_CNT + sg * 64; build_ptab(C, cnt);
          volatile LAS int* T = (volatile LAS int*)(C.lds + MISC_OFF);
          SchedMoEG S{(const char*)(ar + AR_H2), (const unsigned short*)(ar + AR_ROWTOK), (const char*)(ws + WS_WGU), (size_t)2048 * 1024 * 2, T + 64, T[16 + NEXP], G, cb, TLM};
          EpiE3 E{(bf16*)(ar + AR_ACT), ((const float*)C.p(21))};
          pg8::gemm_phase<EpiE3, SchedMoEG, 1024, 1024, 16, true, true>(ring, S, E, wave_s);
          SEAM(e0 + 1); }
      if (EN(15) && IN(e0 + 2)) { OPAQ();
          const unsigned* cnt = (const unsigned*)(ws + WS_CTL) + CW_CNT + sg * 64; build_ptab(C, cnt);
          volatile LAS int* T = (volatile LAS int*)(C.lds + MISC_OFF);
          SchedMoE<4> S{(const char*)(ar + AR_ACT), (const char*)(ws + WS_WD), (size_t)1024 * 1024 * 2, T + 64, T[16 + NEXP], G, cb};
          EpiE4 E{(bf16*)(ar + AR_XS), ((const float*)C.p(23)), (const float*)(ar + AR_ROWG)};
          pg8::gemm_phase<EpiE4, SchedMoE<4>, 1024, 1024, 16, false, true>(ring, S, E, wave_s);
          SEAM(e0 + 2); }
      if (EN(16) && IN(e0 + 3)) { OPAQ(); p_e5(C, sg); if (sg + 1 < NSG) p1_hext(C, 2 * (sg + 1)); SEAM(e0 + 3); }
    }
#undef IN
#undef NOCONT
#undef SEAM
}

extern "C" void kernel_launch(void* const* d_in, const int* in_sizes, int n_in, void* d_out, int out_size, void* d_ws, size_t ws_size, hipStream_t stream) {
    static int grid = 0;
    if (grid == 0) {
        if (n_in != 25 || in_sizes[0] != BATCH * SEQ * D || out_size != BATCH * SEQ * D || ws_size < WS_END) {
            fprintf(stderr, "kernel_launch: shape mismatch: n_in %d in0 %d out %d ws %zu (need %zu)\n", n_in, n_in > 0 ? in_sizes[0] : -1, out_size, ws_size, (size_t)WS_END); grid = -1; return; }
        int dev = 0, cus = 0, per_cu = 0;
        if (hipGetDevice(&dev) != hipSuccess || hipDeviceGetAttribute(&cus, hipDeviceAttributeMultiprocessorCount, dev) != hipSuccess) { grid = -1; return; }
        if (hipFuncSetAttribute((const void*)fwd_kernel, hipFuncAttributeMaxDynamicSharedMemorySize, LDS_BYTES) != hipSuccess) { fprintf(stderr, "kernel_launch: hipFuncSetAttribute failed\n"); grid = -1; return; }
        if (hipOccupancyMaxActiveBlocksPerMultiprocessor(&per_cu, (const void*)fwd_kernel, 512, LDS_BYTES) != hipSuccess || per_cu < 1) fprintf(stderr, "kernel_launch: occupancy query reports %d\n", per_cu);
        (void)hipGetLastError();
        grid = cus < 256 ? cus : 256;
    }
    if (grid < 0) return;
    if (hipMemsetAsync((char*)d_ws + WS_CTL, 0, CTL_ZERO_BYTES, stream) != hipSuccess) return;
    Params p{};
    for (int i = 0; i < 25; ++i) p.in[i] = (const float*)d_in[i];
    p.out = (float*)d_out; p.ws = (unsigned char*)d_ws;
#if MK_ONE_LAUNCH
    p.ph_lo = 0; p.ph_hi = NSTEPS;
    hipLaunchKernelGGL(fwd_kernel, dim3(grid), dim3(512), LDS_BYTES, stream, p);
#else
    for (int s = 0; s < NSTEPS; ++s) { p.ph_lo = s; p.ph_hi = s + 1; hipLaunchKernelGGL(fwd_kernel, dim3(grid), dim3(512), LDS_BYTES, stream, p); }
#endif
}
```

```cpp
#include <hip/hip_runtime.h>
#include <cstdio>
#include <cstdint>

#define GAS __attribute__((address_space(1)))
#define LAS __attribute__((address_space(3)))
typedef unsigned short bf16;
typedef unsigned v4u __attribute__((ext_vector_type(4)));
typedef unsigned v2u __attribute__((ext_vector_type(2)));
typedef float f32x4 __attribute__((ext_vector_type(4)));
typedef float f32x2 __attribute__((ext_vector_type(2)));
typedef float f32x16 __attribute__((ext_vector_type(16)));
typedef short bf16x8 __attribute__((ext_vector_type(8)));
typedef short s16x4 __attribute__((ext_vector_type(4)));
typedef GAS unsigned gu32;
#define RLX_AGENT __ATOMIC_RELAXED, __HIP_MEMORY_SCOPE_AGENT
#define LDS_WAIT() asm volatile("s_waitcnt lgkmcnt(0)" ::: "memory")
#define VM_WAIT() asm volatile("s_waitcnt vmcnt(0)" ::: "memory")

constexpr int D = 1024, BATCH = 16, SEQ = 4096, CTX = 256, LE = SEQ + CTX;
constexpr int NBG = 4, NGROUPS = BATCH / NBG;
constexpr int TE = NBG * LE, TL = NBG * SEQ;
constexpr int NCH = LE / 256;
constexpr int NEXP = 32, TOPK = 4;
constexpr float EPS = 1e-6f;
constexpr int NBM = 8, NSG = BATCH / NBM, TLM = NBM * SEQ;
constexpr int MOE_ROWS = TLM * TOPK + NEXP * 256;
constexpr int MAXPANELS = MOE_ROWS / 256;

__device__ __forceinline__ unsigned f2bf(float f) { unsigned u = __builtin_bit_cast(unsigned, f); return (u + 0x7fffu + ((u >> 16) & 1u)) >> 16; }
__device__ __forceinline__ unsigned cvt_pk_bf16(float lo, float hi) { unsigned r; asm volatile("v_cvt_pk_bf16_f32 %0, %1, %2" : "=v"(r) : "v"(lo), "v"(hi)); return r; }
__device__ __forceinline__ unsigned pk2(float lo, float hi) { return cvt_pk_bf16(lo, hi); }
__device__ __forceinline__ float bf2f(unsigned short b) { return __builtin_bit_cast(float, ((unsigned)b) << 16); }
__device__ __forceinline__ float bflo(unsigned w) { return __builtin_bit_cast(float, w << 16); }
__device__ __forceinline__ float bfhi(unsigned w) { return __builtin_bit_cast(float, w & 0xffff0000u); }
#define SWZ_XOR(v, k) __builtin_bit_cast(float, __builtin_amdgcn_ds_swizzle(__builtin_bit_cast(int, (v)), 0x1f | ((k) << 10)))
#define DPP_ADD(v, ctrl) (v) += __builtin_bit_cast(float, __builtin_amdgcn_update_dpp(0, __builtin_bit_cast(int, (v)), (ctrl), 0xF, 0xF, true))
__device__ __forceinline__ float wave_sum(float v) {
    DPP_ADD(v, 0xB1); DPP_ADD(v, 0x4E); DPP_ADD(v, 0x141); DPP_ADD(v, 0x140);
    v += SWZ_XOR(v, 16);
    { unsigned a_ = __builtin_bit_cast(unsigned, v), b_ = a_; asm volatile("" : "+v"(b_));
      auto rr = __builtin_amdgcn_permlane32_swap(a_, b_, false, false);
      unsigned r0_ = rr[0], r1_ = rr[1]; asm volatile("" : "+v"(r0_), "+v"(r1_));
      v = __builtin_bit_cast(float, r0_) + __builtin_bit_cast(float, r1_); }
    return v;
}
__device__ __forceinline__ float fast_sigmoid(float x) { return __builtin_amdgcn_rcpf(1.0f + __builtin_amdgcn_exp2f(-1.4426950408889634f * x)); }
__device__ __forceinline__ f32x2 sig2(f32x2 x) { const f32x2 z = x * (f32x2){-1.4426950408889634f, -1.4426950408889634f}; const f32x2 d = (f32x2){__builtin_amdgcn_exp2f(z.x), __builtin_amdgcn_exp2f(z.y)} + (f32x2){1.f, 1.f}; return (f32x2){__builtin_amdgcn_rcpf(d.x), __builtin_amdgcn_rcpf(d.y)}; }
__device__ __forceinline__ f32x2 bf2x2(unsigned u) { return (f32x2){bflo(u), bfhi(u)}; }

__device__ __forceinline__ int lane_id_asm() { int l; asm volatile("v_mbcnt_lo_u32_b32 %0, -1, 0\n\tv_mbcnt_hi_u32_b32 %0, -1, %0" : "=v"(l)); return l; }

#define XB_TMO      128
#define XB_XCNT(j)  (256  + 64 * (j))
#define XB_XSUB(j)  (1280 + 64 * (j))
#define XB_XGEN(j)  (2304 + 64 * (j))
#define XB_TOP      3328
#define XB_TOPGEN   3392
#define XCD_BAR_WORDS 3456
#define XB_SPIN_CAP (1u << 22)

__device__ __forceinline__ unsigned xb_ld(unsigned* p)              { return __hip_atomic_load(p, __ATOMIC_RELAXED, __HIP_MEMORY_SCOPE_AGENT); }
__device__ __forceinline__ unsigned xb_add(unsigned* p, unsigned v) { return __hip_atomic_fetch_add(p, v, __ATOMIC_RELAXED, __HIP_MEMORY_SCOPE_AGENT); }
__device__ __forceinline__ unsigned xb_xcc_id() { return (unsigned)__builtin_amdgcn_s_getreg((3 << 11) | 20) & 0xFu; }
#define XB_SPIN(cond, bar) do { unsigned _sp = 0; while (cond) { __builtin_amdgcn_s_sleep(1); \
    if ((++_sp & 255u) == 0u) { if (xb_ld(&(bar)[XB_TMO])) break; if (_sp > XB_SPIN_CAP) { atomicAdd(&(bar)[XB_TMO], 1u); break; } } } } while (0)

struct XcdBarrier { unsigned* bar; unsigned x; volatile LAS unsigned* st; };

__device__ __forceinline__ XcdBarrier xcd_barrier_post(unsigned* bar, volatile LAS unsigned* st) {
    XcdBarrier b; b.bar = bar; b.x = xb_xcc_id(); b.st = st;
    if (threadIdx.x == 0) (void)xb_add(&bar[XB_XCNT(b.x)], 1u);
    return b;
}
__device__ __forceinline__ void xcd_barrier_complete(unsigned* bar, unsigned x, unsigned& nloc, unsigned& nx) {
    const unsigned G = gridDim.x * gridDim.y * gridDim.z;
    unsigned sum, cnt, mine, sp = 0u;
    for (;;) {
        sum = 0u; cnt = 0u; mine = 0u;
#pragma unroll
        for (unsigned j = 0; j < 16; ++j) { const unsigned c = xb_ld(&bar[XB_XCNT(j)]); sum += c; cnt += (c > 0u) ? 1u : 0u; mine = (j == x) ? c : mine; }
        if (sum == G) break;
        __builtin_amdgcn_s_sleep(1);
        if ((++sp & 255u) == 0u) { if (xb_ld(&bar[XB_TMO])) break; if (sp > XB_SPIN_CAP) { atomicAdd(&bar[XB_TMO], 1u); break; } }
    }
    nloc = mine > 0u ? mine : 1u; nx = cnt > 0u ? cnt : 1u;
}
__device__ __forceinline__ void xcd_barrier(const XcdBarrier& b, int tid_b) {
    asm volatile("s_waitcnt vmcnt(0)" ::: "memory");
    __syncthreads();
    if (tid_b == 0) {
        unsigned* bar = b.bar;
        __builtin_amdgcn_s_waitcnt(0);
        unsigned nloc = b.st[0], nx = b.st[1];
        if (nloc == 0u) { xcd_barrier_complete(bar, b.x, nloc, nx); b.st[0] = nloc; b.st[1] = nx; }
        const unsigned old = xb_add(&bar[XB_XSUB(b.x)], 1u);
        const unsigned gen = old / nloc;
        if (old + 1u == (gen + 1u) * nloc) {
            __builtin_amdgcn_fence(__ATOMIC_RELEASE, "agent");
            asm volatile("s_waitcnt vmcnt(0)" ::: "memory");
            const unsigned og = xb_add(&bar[XB_TOP], 1u);
            const unsigned tg = og / nx;
            if (og + 1u == (tg + 1u) * nx) xb_add(&bar[XB_TOPGEN], 1u);
            else XB_SPIN(xb_ld(&bar[XB_TOPGEN]) == tg, bar);
            __builtin_amdgcn_fence(__ATOMIC_ACQUIRE, "agent");
            xb_add(&bar[XB_XGEN(b.x)], 1u);
            asm volatile("s_waitcnt vmcnt(0)" ::: "memory");
        } else {
            XB_SPIN(xb_ld(&bar[XB_XGEN(b.x)]) == gen, bar);
            __builtin_amdgcn_fence(__ATOMIC_ACQUIRE, "agent");
            asm volatile("s_waitcnt vmcnt(0)" ::: "memory");
        }
    }
    __syncthreads();
}

namespace pg8 {
constexpr int BM = 256, BK = 64, HALF = 128, HTB = HALF * BK * 2, STAGE_BYTES = 8 * HTB, NXCD = 8, WGM = 8;
constexpr int EPI_SLOT_OFF = STAGE_BYTES + 8192, EPI_SLOT_BYTES = 4096;
__host__ __device__ __forceinline__ int lds_byte(int r, int c) { const int pos = ((c >> 3) & 3) ^ (((r >> 2) & 1) << 1); return (r >> 3) * 1024 + ((c >> 5) & 1) * 512 + (r & 7) * 64 + pos * 16 + (c & 7) * 2; }
__host__ __device__ __forceinline__ void stage_rc(int b, int& R, int& C) { const int p = b / 1024, sb = b % 1024, pos = (sb >> 4) & 3; R = p * 8 + ((sb >> 6) & 7); C = (sb >> 9) * 32 + ((pos ^ (((R >> 2) & 1) << 1)) * 8) + (sb & 15) / 2; }
__host__ __device__ __forceinline__ int perm32(int rho) { const int n = rho >> 4, i = rho & 15; return 8 * (i >> 2) + 4 * n + (i & 3); }

struct Unit { const char* a; const char* b; int u0, u1, u2, u3, u4; };

__device__ __forceinline__ void tile2d(int L, int nM, int nN, int& pm, int& pn) {
    const int nwg = nM * nN; int wgid = L;
    { const int q = nwg / NXCD, r = nwg % NXCD, xcd = wgid % NXCD, off = wgid / NXCD; wgid = (xcd < r ? xcd * (q + 1) : r * (q + 1) + (xcd - r) * q) + off; }
    const int nig = WGM * nN, gid = wgid / nig, fm = gid * WGM, gsz = (nM - fm) < WGM ? (nM - fm) : WGM;
    pm = fm + ((wgid % nig) % gsz); pn = (wgid % nig) / gsz;
}

struct Cont { const char* a; const char* b; int lda, ldb; };
template <class Epi, class Sched, int LDA, int LDB, int KT, bool GATHER = false, bool STAGGER = false>
__device__ __forceinline__ bool gemm_phase(LAS unsigned char* lds, const Sched& S, const Epi& E, int tid_in, const Cont cont = Cont{nullptr, nullptr, 0, 0}, const bool prestaged = false) {
    static_assert(KT >= 4 && (KT % 2) == 0, "K multiple of 128, >= 256");
    const int tid_o = tid_in * 64 + lane_id_asm();
    const int tid = tid_o, wid = __builtin_amdgcn_readfirstlane(tid >> 6), lane = tid & 63, wr = wid >> 2, wc = wid & 3, fr = lane & 15, fq = lane >> 4;
    constexpr int nt = KT;
    unsigned voffA[2], voffB[2];
#pragma unroll
    for (int i = 0; i < 2; ++i) { int R, C; stage_rc(tid * 16 + i * 8192, R, C); const int Rb = Epi::PERM ? ((R & ~31) + perm32(R & 31)) : R;
        voffA[i] = (unsigned)(R * LDA + C) * 2u; voffB[i] = (unsigned)(Rb * LDB + C) * 2u; }
    constexpr size_t kstep = (size_t)(BK * 2);
    size_t hstepA = (size_t)HALF * LDA * 2, hstepB = (size_t)HALF * LDB * 2;
    const unsigned ldsw = (unsigned)wid * 1024u;
    const int aoff = lds_byte(wr * 64 + fr, fq * 8), boff = lds_byte(wc * 32 + fr, fq * 8);
#define PG8_SA(b, h) (((b) * 2 + (h)) * HTB)
#define PG8_SB(b, h) ((4 + (b) * 2 + (h)) * HTB)
#define PG8_STAGE(bufoff, gbase, voff) do { const char* _b = (const char*)(gbase); asm volatile("" : "+s"(_b)); _Pragma("unroll") for (int _i = 0; _i < 2; ++_i) { unsigned _v = (voff)[_i]; asm volatile("" : "+v"(_v)); \
        __builtin_amdgcn_global_load_lds((const unsigned*)(_b + _v), (LAS unsigned*)(lds + (bufoff) + ldsw + _i * 8192), 16, 0, 0); } } while (0)
    unsigned ogc[2] = {0u, 0u}, ogn[2] = {0u, 0u}; const unsigned gpk = (voffA[0] / (unsigned)(LDA * 2)) | ((voffA[0] % (unsigned)(LDA * 2)) << 8);
#define PG8_LOAD_OG(og, un) do { if constexpr (GATHER) { unsigned _g = gpk; asm volatile("" : "+v"(_g)); const int rA0 = (int)(_g & 255u); _Pragma("unroll") for (int _h = 0; _h < 2; ++_h) { const unsigned* _q = (const unsigned*)S.rowtok + ((((un).u4 + 128 * _h) >> 1) + rA0); unsigned _x; \
        asm volatile("global_load_dword %0, %1, off" : "=v"(_x) : "v"(_q) : "memory"); og[_h] = _x; } } } while (0)
#define PG8_MASK_OG(p, rem, h) ([&](unsigned _pp, int _rem, int _hh) { unsigned _gg = gpk; asm volatile("" : "+v"(_gg)); const int _r = (int)(_gg & 255u) + 128 * _hh; return ((_r < _rem) ? (_pp & 0xffffu) : (unsigned)S.zrow) | (((_r + 64 < _rem) ? (_pp >> 16) : (unsigned)S.zrow) << 16); }((p), (rem), (h)))
#define PG8_STAGE_A(bufoff, base, h, nx) do { if constexpr (GATHER) { const char* _bg = (const char*)(base); asm volatile("" : "+s"(_bg)); unsigned _pn = ogn[h], _g = gpk; asm volatile("" : "+v"(_pn), "+v"(_g)); const unsigned _p = (nx) ? PG8_MASK_OG(_pn, nxt.u3, h) : ogc[h], cbA = _g >> 8; \
        __builtin_amdgcn_global_load_lds((const unsigned*)(_bg + (size_t)((_p & 0xffffu) * (unsigned)(LDA * 2) + cbA)), (LAS unsigned*)(lds + (bufoff) + ldsw), 16, 0, 0); \
        __builtin_amdgcn_global_load_lds((const unsigned*)(_bg + (size_t)((_p >> 16) * (unsigned)(LDA * 2) + cbA)), (LAS unsigned*)(lds + (bufoff) + ldsw + 8192), 16, 0, 0); } \
        else { PG8_STAGE(bufoff, (base) + (h) * hstepA, voffA); } } while (0)
#define PG8_LDA(dst, b, h) do { _Pragma("unroll") for (int m = 0; m < 4; ++m) _Pragma("unroll") for (int k = 0; k < 2; ++k) dst[m][k] = *(const LAS bf16x8*)(lds + PG8_SA(b, h) + aoff + m * 2048 + k * 512); } while (0)
#define PG8_LDB(dst, b, h) do { _Pragma("unroll") for (int n = 0; n < 2; ++n) _Pragma("unroll") for (int k = 0; k < 2; ++k) dst[n][k] = *(const LAS bf16x8*)(lds + PG8_SB(b, h) + boff + n * 2048 + k * 512); } while (0)
#define PG8_MMA(ai, bj, At, Bt) do { __builtin_amdgcn_s_setprio(1); _Pragma("unroll") for (int m = 0; m < 4; ++m) _Pragma("unroll") for (int n = 0; n < 2; ++n) _Pragma("unroll") for (int k = 0; k < 2; ++k) \
        acc[ai][bj][m][n] = __builtin_amdgcn_mfma_f32_16x16x32_bf16(Bt[n][k], At[m][k], acc[ai][bj][m][n], 0, 0, 0); __builtin_amdgcn_s_setprio(0); } while (0)
#define PG8_WAIT_V(n) asm volatile("s_waitcnt vmcnt(" #n ")" ::: "memory")
#define PG8_WAIT_L(n) asm volatile("s_waitcnt lgkmcnt(" #n ")" ::: "memory")
#define PG8_BAR __builtin_amdgcn_s_barrier()
#define PG8_SCHED __builtin_amdgcn_sched_barrier(0)
    Unit cur, nxt; int ui = 0;
    if (!S.next(0, cur)) return false;
    bool cont_done = false;
    f32x4 acc[2][2][4][2];
#pragma unroll
    for (int a = 0; a < 2; ++a)
#pragma unroll
        for (int b = 0; b < 2; ++b)
#pragma unroll
            for (int m = 0; m < 4; ++m)
#pragma unroll
                for (int n = 0; n < 2; ++n) acc[a][b][m][n] = (f32x4){0.f, 0.f, 0.f, 0.f};
    bf16x8 At[4][2], B0[2][2], B1[2][2];
    const char* cA; if constexpr (GATHER) cA = S.gbase; else cA = cur.a;
    const char* cB = cur.b;
    PG8_LOAD_OG(ogc, cur);
    if constexpr (GATHER) { asm volatile("s_waitcnt vmcnt(0)" : "+v"(ogc[0]), "+v"(ogc[1]) :: "memory"); ogc[0] = PG8_MASK_OG(ogc[0], cur.u3, 0); ogc[1] = PG8_MASK_OG(ogc[1], cur.u3, 1); }
    if constexpr (STAGGER) { const int stag = ((int)blockIdx.x >> 3) & 3; for (int i = 0; i < stag; ++i) __builtin_amdgcn_s_sleep(45); }
    if (!prestaged) {
    PG8_STAGE(PG8_SB(0, 0), cB, voffB); PG8_STAGE(PG8_SB(0, 1), cB + hstepB, voffB); PG8_STAGE_A(PG8_SA(0, 0), cA, 0, false); PG8_STAGE_A(PG8_SA(0, 1), cA, 1, false);
    PG8_STAGE(PG8_SB(1, 0), cB + kstep, voffB); PG8_STAGE_A(PG8_SA(1, 0), cA + kstep, 0, false); PG8_STAGE(PG8_SB(1, 1), cB + hstepB + kstep, voffB); }
    if (wr == 1) PG8_BAR;
    PG8_WAIT_V(8); PG8_BAR;
    PG8_WAIT_V(6); PG8_BAR;
    for (;;) {
        if constexpr (Epi::PRE) { cur.u3 = ui & 1; E.pre(cur, lds + EPI_SLOT_OFF + (ui & 1) * EPI_SLOT_BYTES, wid); }
        const bool has_next = S.next(ui + 1, nxt);
        const char* nA; if constexpr (GATHER) nA = cA; else nA = has_next ? nxt.a : cA;
        const char* nB = has_next ? nxt.b : cB;
        const bool use_cont = !GATHER && !has_next && cont.a != nullptr;
        if constexpr (GATHER) { if (has_next) { PG8_LOAD_OG(ogn, nxt); } else { ogn[0] = ogc[0]; ogn[1] = ogc[1]; } }
#pragma unroll 1
        for (int t = 0; t < nt; t += 2) {
            const bool last = (t == nt - 2);
            if constexpr (Epi::KSCALE) { if (t != 0 && (t & 7) == 0) E.kscale(acc, wr, (t >> 3) - 1, lds + EPI_SLOT_OFF + cur.u3 * EPI_SLOT_BYTES); }
            const char* a1 = cA + (size_t)(t + 1) * kstep;
            PG8_LDB(B0, 0, 0); PG8_LDB(B1, 0, 1); PG8_SCHED; PG8_LDA(At, 0, 0); PG8_STAGE_A(PG8_SA(1, 1), a1, 1, false);
            if (last && use_cont) {
                const int tid2 = wid * 64 + lane_id_asm();
#pragma unroll
                for (int i = 0; i < 2; ++i) { int R, C; stage_rc(tid2 * 16 + i * 8192, R, C); const int Rb = Epi::PERM ? ((R & ~31) + perm32(R & 31)) : R;
                    voffA[i] = (unsigned)(R * cont.lda + C) * 2u; voffB[i] = (unsigned)(Rb * cont.ldb + C) * 2u; }
                hstepA = (size_t)HALF * cont.lda * 2; hstepB = (size_t)HALF * cont.ldb * 2; nA = cont.a; nB = cont.b; cont_done = true; }
            const char* a2 = last ? nA : cA + (size_t)(t + 2) * kstep; const char* b2 = last ? nB : cB + (size_t)(t + 2) * kstep;
            const char* a3 = a2 + kstep; const char* b3 = b2 + kstep;
            PG8_WAIT_V(8); PG8_WAIT_L(0); PG8_BAR; PG8_MMA(0, 0, At, B0); PG8_MMA(0, 1, At, B1); PG8_BAR; PG8_SCHED;
            PG8_LDA(At, 0, 1); PG8_STAGE(PG8_SB(0, 0), b2, voffB); PG8_STAGE(PG8_SB(0, 1), b2 + hstepB, voffB); PG8_STAGE_A(PG8_SA(0, 0), a2, 0, last);
            PG8_WAIT_V(8); PG8_WAIT_L(0); PG8_BAR; PG8_MMA(1, 0, At, B0); PG8_MMA(1, 1, At, B1); PG8_BAR; PG8_SCHED;
            PG8_LDB(B0, 1, 0); PG8_LDB(B1, 1, 1); PG8_SCHED; PG8_LDA(At, 1, 0); PG8_STAGE_A(PG8_SA(0, 1), a2, 1, last);
            PG8_WAIT_V(8); PG8_WAIT_L(0); PG8_BAR; PG8_MMA(0, 0, At, B0); PG8_MMA(0, 1, At, B1); PG8_BAR; PG8_SCHED;
            PG8_LDA(At, 1, 1); PG8_STAGE(PG8_SB(1, 0), b3, voffB); PG8_STAGE(PG8_SB(1, 1), b3 + hstepB, voffB); PG8_STAGE_A(PG8_SA(1, 0), a3, 0, last);
            PG8_WAIT_V(8); PG8_WAIT_L(0); PG8_BAR; PG8_MMA(1, 0, At, B0); PG8_MMA(1, 1, At, B1); PG8_BAR; PG8_SCHED;
        }
        if (wr == 0) PG8_BAR;
        { const int l_e = lane_id_asm(); int wr_e = wr, wc_e = wc, fr_e = l_e & 15, fq_e = l_e >> 4; asm volatile("" : "+s"(wr_e), "+s"(wc_e));
          if constexpr (Epi::PRE) E(acc, cur, wr_e, wc_e, fr_e, fq_e, lds + EPI_SLOT_OFF + cur.u3 * EPI_SLOT_BYTES); else E(acc, cur, wr_e, wc_e, fr_e, fq_e); }
        if (!has_next) break;
#pragma unroll
        for (int a = 0; a < 2; ++a)
#pragma unroll
            for (int b = 0; b < 2; ++b)
#pragma unroll
                for (int m = 0; m < 4; ++m)
#pragma unroll
                    for (int n = 0; n < 2; ++n) acc[a][b][m][n] = (f32x4){0.f, 0.f, 0.f, 0.f};
        cur = nxt; cA = nA; cB = nB; ++ui;
        if constexpr (GATHER) { ogc[0] = PG8_MASK_OG(ogn[0], cur.u3, 0); ogc[1] = PG8_MASK_OG(ogn[1], cur.u3, 1); }
        if (wr == 1) PG8_BAR;
    }
    PG8_WAIT_V(0);
    PG8_BAR;
    return cont_done;
#undef PG8_SA
#undef PG8_SB
#undef PG8_STAGE
#undef PG8_STAGE_A
#undef PG8_LOAD_OG
#undef PG8_MASK_OG
#undef PG8_LDA
#undef PG8_LDB
#undef PG8_MMA
#undef PG8_WAIT_V
#undef PG8_WAIT_L
#undef PG8_BAR
#undef PG8_SCHED
}
}
constexpr size_t MiB = 1u << 20;
constexpr size_t WS_CTL = 0, CTL_ZERO_BYTES = 1 * MiB;
constexpr size_t WS_ADA = 1 * MiB;
constexpr size_t WS_TABR = WS_ADA + 512 * 1024;
constexpr size_t WS_TABM = WS_TABR + 64 * 64 * 8;
constexpr size_t WS_LG = WS_TABM + 64 * 16 * 8;
constexpr size_t WS_WIN = 2 * MiB;
constexpr int    WIN_ROWS = 8960, WIN_Q = 0, WIN_K = 1024, WIN_MLA = 2048, WIN_V = 2816, WIN_GATE = 4864, WIN_GRET = 6912, WIN_GMLA = 7936;
constexpr size_t WS_WUQ = WS_WIN + (size_t)WIN_ROWS * 1024 * 2;
constexpr size_t WS_WUKV = WS_WUQ + (size_t)1536 * 384 * 2;
constexpr size_t WS_WBR = WS_WUKV + (size_t)2048 * 256 * 2;
constexpr size_t WS_WBM = WS_WBR + (size_t)1024 * 2048 * 2;
constexpr size_t WS_WO = WS_WBM + (size_t)1024 * 1024 * 2;
constexpr size_t WS_WGU = WS_WO + (size_t)1024 * 1024 * 2;
constexpr size_t WS_WD = WS_WGU + (size_t)32 * 2048 * 1024 * 2;
constexpr size_t WS_WEND = WS_WD + (size_t)32 * 1024 * 1024 * 2;
constexpr size_t WS_ARENA = (WS_WEND + MiB - 1) / MiB * MiB;
constexpr size_t AR_H = 0;
constexpr size_t AR_MLAIN = AR_H + (size_t)TE * 1024 * 2;
constexpr size_t AR_O = AR_MLAIN + (size_t)TE * 768 * 2;
constexpr size_t AR_Q = AR_O + (size_t)TE * 2048 * 2;
constexpr size_t AR_K = AR_Q + (size_t)TE * 1024 * 2;
constexpr size_t AR_ACAT = AR_K + (size_t)TE * 1024 * 2;
constexpr size_t AR_KT2 = AR_ACAT + (size_t)TE * 3072 * 2;
constexpr size_t KT2_DIR = (size_t)NBG * 4 * NCH * 256 * 256 * 2;
constexpr size_t AR_BCAT = AR_KT2 + 2 * KT2_DIR;
constexpr size_t BCAT_CH = (size_t)512 * 768 * 2;
constexpr size_t AR_MLAN = AR_BCAT + (size_t)NBG * 4 * NCH * BCAT_CH;
constexpr size_t AR_ATTO = AR_MLAN + (size_t)TE * 640 * 2;
constexpr size_t AR_GATE = AR_ATTO + (size_t)TE * 1024 * 2;
constexpr size_t AR_SSQ = AR_GATE + (size_t)TE * 2048 * 2;
constexpr size_t AR_END1 = AR_SSQ + (size_t)TE * 32 * 4;
constexpr size_t AR_QMLA = AR_O;
constexpr size_t AR_KVMLA = AR_Q;
constexpr size_t AR_GRET = AR_KT2;
constexpr size_t AR_GMLA = AR_GRET + (size_t)TE * 1024 * 2;
constexpr size_t AR_T1 = AR_ACAT;
constexpr size_t AR_MERGED = AR_T1 + (size_t)TE * 1024 * 2;
static_assert(AR_QMLA + (size_t)TE * 1536 * 2 <= AR_Q, "q_mla over o");
static_assert(AR_KVMLA + (size_t)TE * 2048 * 2 <= AR_ACAT, "kv_mla / gate over q,k");
static_assert(AR_GMLA + (size_t)TE * 1024 * 2 <= AR_BCAT, "g over kt2");
static_assert(AR_MERGED + (size_t)TE * 1024 * 2 <= AR_KT2, "t1/merged over acat");
constexpr size_t AR_H2 = 0;
constexpr size_t AR_XS = AR_H2 + (size_t)(TLM + 8) * 1024 * 2;
constexpr size_t AR_ACT = AR_XS + (size_t)MOE_ROWS * 1024 * 2;
constexpr size_t AR_SEL = AR_ACT + (size_t)MOE_ROWS * 1024 * 2;
constexpr size_t AR_ROWG = AR_SEL + (size_t)TLM * 4 * 4 * 4;
constexpr size_t AR_ROWTOK = AR_ROWG + (size_t)NEXP * TLM * 4;
constexpr size_t AR_END2 = AR_ROWTOK + (size_t)NEXP * TLM * 2;
constexpr size_t AR_SIZE = (AR_END1 > AR_END2 ? AR_END1 : AR_END2);
constexpr size_t WS_END = WS_ARENA + AR_SIZE;
constexpr int CW_BAR = 4096;
constexpr int CW_CNT = 16384;
constexpr int CW_BBASE = 32768;

constexpr int RING_BYTES = 131072;
constexpr int MISC_OFF = RING_BYTES; static_assert(pg8::EPI_SLOT_OFF == RING_BYTES + 8192 && pg8::STAGE_BYTES == RING_BYTES && RING_BYTES + 8192 + 2 * pg8::EPI_SLOT_BYTES <= 147456, "epilogue operand slots");
constexpr int MISC_LCNT = 3072, MISC_PT = 4096;
constexpr int LDS_BYTES = 147456;

struct Params {
    const float* in[25];
    float* out;
    unsigned char* ws;
    int ph_lo, ph_hi;
};
using pg8::Unit;
__device__ __forceinline__ int lat_panel_to_ext(int pml) { return (pml >> 4) * NCH + (pml & 15) + 1; }

template <bool LAT_A, bool LAT_B>
struct Sched2D {
    const char* A; const char* B; size_t sa, sb; int nM, nN, G, c, n0 = 0;
    __device__ __forceinline__ bool next(int i, Unit& u) const {
        const int L = i * G + c; if (L >= nM * nN) return false;
        int pm, pn; pg8::tile2d(L, nM, nN, pm, pn); pn += n0;
        const int am = LAT_A ? lat_panel_to_ext(pm) : pm, bn = LAT_B ? lat_panel_to_ext(pn) : pn;
        u.a = A + (size_t)am * sa; u.b = B + (size_t)bn * sb; u.u0 = am; u.u1 = bn; u.u2 = 0; u.u3 = 0; return true;
    }
};

struct EpiGA {
    static constexpr bool PERM = true; static constexpr bool PRE = false, KSCALE = false;
    bf16 *q, *k, *acat, *mlain; const float2* tabr; const float2* tabm; const float* lg; float* ssqm;
    __device__ __forceinline__ void operator()(const f32x4 (&acc)[2][2][4][2], const Unit& u, int wr, int wc, int fr, int fq) const {
        const int pm = u.u0, pn = u.u1;
        if (pn < 8) {
            const int h = pn & 3; const bool isq = pn < 4;
            const float lgf = lg[h], lgb = lg[4 + h];
#pragma unroll
            for (int ai = 0; ai < 2; ++ai) { f32x4 csa[4][2][2];
#pragma unroll
                for (int m = 0; m < 4; ++m) { const int r = pm * 256 + ai * 128 + wr * 64 + m * 16 + fr; const int p = r % LE; const int t = p >= CTX ? p - CTX : 0;
#pragma unroll
                    for (int bj = 0; bj < 2; ++bj) { const int pos = bj == 0 ? (t >> 6) : (t & 63); const f32x4* tp = (const f32x4*)(tabr + pos * 64 + 16 * wc + 4 * fq); csa[m][bj][0] = tp[0]; csa[m][bj][1] = tp[1]; } }
#pragma unroll
                for (int m = 0; m < 4; ++m) {
                    const int r = pm * 256 + ai * 128 + wr * 64 + m * 16 + fr;
                    const int p = r % LE; const bool lat = p >= CTX;
                    const int iloc = p & 255;
                    const float sf = isq ? __builtin_amdgcn_exp2f(lgf * (float)(iloc + 1)) : 0.0625f;
                    const float sb = __builtin_amdgcn_exp2f(lgb * (float)(256 - iloc));
#pragma unroll
                    for (int bj = 0; bj < 2; ++bj) {
                        f32x4 cs0 = csa[m][bj][0], cs1 = csa[m][bj][1];
                        if (!lat) { cs0 = (f32x4){1.f, 0.f, 1.f, 0.f}; cs1 = cs0; }
                        const f32x4 v0 = acc[ai][bj][m][0], v1 = acc[ai][bj][m][1];
                        float o[8];
                        o[0] = v0[0] * cs0[0] - v0[1] * cs0[1]; o[1] = v0[0] * cs0[1] + v0[1] * cs0[0];
                        o[2] = v0[2] * cs0[2] - v0[3] * cs0[3]; o[3] = v0[2] * cs0[3] + v0[3] * cs0[2];
                        o[4] = v1[0] * cs1[0] - v1[1] * cs1[1]; o[5] = v1[0] * cs1[1] + v1[1] * cs1[0];
                        o[6] = v1[2] * cs1[2] - v1[3] * cs1[3]; o[7] = v1[2] * cs1[3] + v1[3] * cs1[2];
                        const int col = bj * 128 + wc * 32 + 8 * fq;
                        if (isq) {
                            v4u w; w.x = cvt_pk_bf16(o[0], o[1]); w.y = cvt_pk_bf16(o[2], o[3]); w.z = cvt_pk_bf16(o[4], o[5]); w.w = cvt_pk_bf16(o[6], o[7]);
                            *(v4u*)(q + (size_t)r * 1024 + h * 256 + col) = w;
                            v4u wf; wf.x = cvt_pk_bf16(o[0] * sf, o[1] * sf); wf.y = cvt_pk_bf16(o[2] * sf, o[3] * sf); wf.z = cvt_pk_bf16(o[4] * sf, o[5] * sf); wf.w = cvt_pk_bf16(o[6] * sf, o[7] * sf);
                            *(v4u*)(acat + (size_t)r * 3072 + h * 768 + 256 + col) = wf;
                            v4u wb; wb.x = cvt_pk_bf16(o[0] * sb, o[1] * sb); wb.y = cvt_pk_bf16(o[2] * sb, o[3] * sb); wb.z = cvt_pk_bf16(o[4] * sb, o[5] * sb); wb.w = cvt_pk_bf16(o[6] * sb, o[7] * sb);
                            *(v4u*)(acat + (size_t)r * 3072 + h * 768 + 512 + col) = wb;
                        } else {
                            v4u w; w.x = cvt_pk_bf16(o[0] * sf, o[1] * sf); w.y = cvt_pk_bf16(o[2] * sf, o[3] * sf); w.z = cvt_pk_bf16(o[4] * sf, o[5] * sf); w.w = cvt_pk_bf16(o[6] * sf, o[7] * sf);
                            *(v4u*)(k + (size_t)r * 1024 + h * 256 + col) = w;
                        }
                    }
                } }
        } else {
            const int c0 = (pn - 8) * 256;
#pragma unroll
            for (int ai = 0; ai < 2; ++ai)
#pragma unroll
                for (int m = 0; m < 4; ++m) {
                    const int r = pm * 256 + ai * 128 + wr * 64 + m * 16 + fr;
                    const int p = r % LE; const bool lat = p >= CTX; const int t = lat ? p - CTX : 0;
#pragma unroll
                    for (int bj = 0; bj < 2; ++bj) {
                        const int col = c0 + bj * 128 + wc * 32 + 8 * fq;
                        const f32x4 v0 = acc[ai][bj][m][0], v1 = acc[ai][bj][m][1];
                        float o[8] = {v0[0], v0[1], v0[2], v0[3], v1[0], v1[1], v1[2], v1[3]};
                        if (col >= 640 && col < 704 && lat) {
                            const int pp0 = (col - 640) >> 1; const int pos = pp0 < 16 ? (t >> 6) : (t & 63);
                            const f32x4* tp = (const f32x4*)(tabm + pos * 16 + (pp0 & 15));
                            const f32x4 cs0 = tp[0], cs1 = tp[1];
                            o[0] = v0[0] * cs0[0] - v0[1] * cs0[1]; o[1] = v0[0] * cs0[1] + v0[1] * cs0[0];
                            o[2] = v0[2] * cs0[2] - v0[3] * cs0[3]; o[3] = v0[2] * cs0[3] + v0[3] * cs0[2];
                            o[4] = v1[0] * cs1[0] - v1[1] * cs1[1]; o[5] = v1[0] * cs1[1] + v1[1] * cs1[0];
                            o[6] = v1[2] * cs1[2] - v1[3] * cs1[3]; o[7] = v1[2] * cs1[3] + v1[3] * cs1[2];
                        }
                        v4u w; w.x = cvt_pk_bf16(o[0], o[1]); w.y = cvt_pk_bf16(o[2], o[3]); w.z = cvt_pk_bf16(o[4], o[5]); w.w = cvt_pk_bf16(o[6], o[7]);
                        *(v4u*)(mlain + (size_t)r * 768 + col) = w;
                        const int blk = (c0 >> 7) + bj;
                        if (blk < 5) { float sq = 0.f;
#pragma unroll
                            for (int x = 0; x < 8; ++x) sq += o[x] * o[x];
                            sq += SWZ_XOR(sq, 16);
                            { unsigned a_ = __builtin_bit_cast(unsigned, sq), b_ = a_; asm volatile("" : "+v"(b_));
                              auto rr = __builtin_amdgcn_permlane32_swap(a_, b_, false, false);
                              unsigned r0_ = rr[0], r1_ = rr[1]; asm volatile("" : "+v"(r0_), "+v"(r1_));
                              sq = __builtin_bit_cast(float, r0_) + __builtin_bit_cast(float, r1_); }
                            if (fq == 0) ssqm[(size_t)r * 32 + blk * 4 + wc] = sq; }
                    }
                }
        }
    }
};

struct SchedGAV { const char* H; const char* W; int G, c;
    __device__ __forceinline__ bool next(int i, Unit& u) const {
        const int L = i * G + c; int pm, pn;
        if (L < 476) { pg8::tile2d(L, TE / 256, 7, pm, pn); pn += 4; u.u2 = 0; }
        else if (L < 732) { pg8::tile2d(L - 476, TL / 256, 4, pm, pn); pm = lat_panel_to_ext(pm); u.u2 = 0; }
        else if (L < 1276) { pg8::tile2d(L - 732, 8, TE / 256, pm, pn); u.u2 = 1; }
        else return false;
        if (u.u2 == 0) { u.a = H + (size_t)pm * 256 * 1024 * 2; u.b = W + (size_t)pn * 256 * 1024 * 2; }
        else { u.a = W + (size_t)(WIN_V + pm * 256) * 1024 * 2; u.b = H + (size_t)pn * 256 * 1024 * 2; }
        u.u0 = pm; u.u1 = pn; u.u3 = 0; return true; } };

template <class Loc>
struct EpiStore {
    static constexpr bool PERM = true; static constexpr bool PRE = false, KSCALE = false;
    Loc loc;
    __device__ __forceinline__ void operator()(const f32x4 (&acc)[2][2][4][2], const Unit& u, int wr, int wc, int fr, int fq) const {
        bf16* base; int ldc; loc(u, base, ldc);
#pragma unroll
        for (int ai = 0; ai < 2; ++ai)
#pragma unroll
            for (int m = 0; m < 4; ++m) { bf16* rowp = base + (size_t)(ai * 128 + wr * 64 + m * 16 + fr) * ldc + wc * 32 + 8 * fq;
#pragma unroll
                for (int bj = 0; bj < 2; ++bj) { const f32x4 v0 = acc[ai][bj][m][0], v1 = acc[ai][bj][m][1];
                    v4u w; w.x = cvt_pk_bf16(v0[0], v0[1]); w.y = cvt_pk_bf16(v0[2], v0[3]); w.z = cvt_pk_bf16(v1[0], v1[1]); w.w = cvt_pk_bf16(v1[2], v1[3]);
                    *(v4u*)(rowp + bj * 128) = w; } }
    }
};

struct LocGV { bf16* bcat;
    __device__ __forceinline__ void operator()(const Unit& u, bf16*& base, int& ldc) const {
        const int vt = u.u0, tt = u.u1, bl = tt / NCH, e = tt % NCH, h = vt >> 1;
        base = bcat + ((size_t)((bl * 4 + h) * NCH + e) * 512 + (vt & 1) * 256) * 768; ldc = 768; } };
struct EpiGAV {
    static constexpr bool PERM = true; static constexpr bool PRE = false, KSCALE = false;
    EpiGA ga; EpiStore<LocGV> gv;
    __device__ __forceinline__ void operator()(const f32x4 (&acc)[2][2][4][2], const Unit& u, int wr, int wc, int fr, int fq) const {
        if (u.u2 == 0) ga(acc, u, wr, wc, fr, fq); else gv(acc, u, wr, wc, fr, fq); }
};
struct LocGB { bf16 *gate, *gret, *gmla;
    __device__ __forceinline__ void operator()(const Unit& u, bf16*& base, int& ldc) const {
        const int pn = u.u1; const size_t r0 = (size_t)u.u0 * 256;
        if (pn < 8) { base = gate + r0 * 2048 + pn * 256; ldc = 2048; }
        else if (pn < 12) { base = gret + r0 * 1024 + (pn - 8) * 256; ldc = 1024; }
        else { base = gmla + r0 * 1024 + (pn - 12) * 256; ldc = 1024; } } };
struct LocM3 { bf16* kv;
    __device__ __forceinline__ void operator()(const Unit& u, bf16*& base, int& ldc) const { base = kv + (size_t)u.u0 * 256 * 2048 + u.u1 * 256; ldc = 2048; } };

struct EpiM2 {
    static constexpr bool PERM = true; static constexpr bool PRE = true, KSCALE = false;
    bf16* qm; const float2* tabm; const float* ssqm;
    __device__ __forceinline__ void pre(const Unit& u, LAS unsigned char* slot, int wid) const {
        if (wid < 4) { const int rl = wid * 64 + lane_id_asm(); const float* p = ssqm + ((size_t)u.u0 * 256 + rl) * 32;
            const f32x4 a = *(const f32x4*)p, b = *(const f32x4*)(p + 4), c = *(const f32x4*)(p + 8);
            ((LAS float*)slot)[rl] = 1.0f / sqrtf(((((a.x + a.y) + (a.z + a.w)) + ((b.x + b.y) + (b.z + b.w))) + ((c.x + c.y) + (c.z + c.w))) * (1.f / 384.f) + EPS); } }
    __device__ __forceinline__ void operator()(const f32x4 (&acc)[2][2][4][2], const Unit& u, int wr, int wc, int fr, int fq, const LAS unsigned char* slot) const {
        const int pm = u.u0, pn = u.u1;
#pragma unroll
        for (int ai = 0; ai < 2; ++ai) { f32x4 csa[4][2][2];
#pragma unroll
            for (int m = 0; m < 4; ++m) { const int r = pm * 256 + ai * 128 + wr * 64 + m * 16 + fr; const int p = r % LE; const int t = p >= CTX ? p - CTX : 0;
#pragma unroll
                for (int bj = 0; bj < 2; ++bj) { const int jj = (pn * 256 + bj * 128 + wc * 32 + 8 * fq) % 192; const int pp0 = (jj >= 128 ? jj - 128 : 0) >> 1; const int pos = pp0 < 16 ? (t >> 6) : (t & 63);
                    const f32x4* tp = (const f32x4*)(tabm + pos * 16 + (pp0 & 15)); csa[m][bj][0] = tp[0]; csa[m][bj][1] = tp[1]; } }
#pragma unroll
            for (int m = 0; m < 4; ++m) {
                const int r = pm * 256 + ai * 128 + wr * 64 + m * 16 + fr;
                const int p = r % LE; const bool lat = p >= CTX;
#pragma unroll
                for (int bj = 0; bj < 2; ++bj) {
                    const int col = pn * 256 + bj * 128 + wc * 32 + 8 * fq; const int jj = col % 192;
                    const float rs = ((const LAS float*)slot)[ai * 128 + wr * 64 + m * 16 + fr];
                    const f32x4 v0 = acc[ai][bj][m][0] * rs, v1 = acc[ai][bj][m][1] * rs;
                    float o[8] = {v0[0], v0[1], v0[2], v0[3], v1[0], v1[1], v1[2], v1[3]};
                    if (jj >= 128 && lat) {
                        const f32x4 cs0 = csa[m][bj][0], cs1 = csa[m][bj][1];
                        o[0] = v0[0] * cs0[0] - v0[1] * cs0[1]; o[1] = v0[0] * cs0[1] + v0[1] * cs0[0];
                        o[2] = v0[2] * cs0[2] - v0[3] * cs0[3]; o[3] = v0[2] * cs0[3] + v0[3] * cs0[2];
                        o[4] = v1[0] * cs1[0] - v1[1] * cs1[1]; o[5] = v1[0] * cs1[1] + v1[1] * cs1[0];
                        o[6] = v1[2] * cs1[2] - v1[3] * cs1[3]; o[7] = v1[2] * cs1[3] + v1[3] * cs1[2];
                    }
                    v4u w; w.x = cvt_pk_bf16(o[0], o[1]); w.y = cvt_pk_bf16(o[2], o[3]); w.z = cvt_pk_bf16(o[4], o[5]); w.w = cvt_pk_bf16(o[6], o[7]);
                    *(v4u*)(qm + (size_t)r * 1536 + col) = w;
                }
            } }
    }
};

struct EpiM3 {
    static constexpr bool PERM = true; static constexpr bool PRE = true, KSCALE = false;
    bf16* kv; const float* ssqm;
    __device__ __forceinline__ void pre(const Unit& u, LAS unsigned char* slot, int wid) const {
        if (wid < 4) { const int rl = wid * 64 + lane_id_asm(); const float* p = ssqm + ((size_t)u.u0 * 256 + rl) * 32 + 12;
            const f32x4 a = *(const f32x4*)p, b = *(const f32x4*)(p + 4);
            ((LAS float*)slot)[rl] = 1.0f / sqrtf((((a.x + a.y) + (a.z + a.w)) + ((b.x + b.y) + (b.z + b.w))) * (1.f / 256.f) + EPS); } }
    __device__ __forceinline__ void operator()(const f32x4 (&acc)[2][2][4][2], const Unit& u, int wr, int wc, int fr, int fq, const LAS unsigned char* slot) const {
        bf16* base = kv + (size_t)u.u0 * 256 * 2048 + u.u1 * 256;
#pragma unroll
        for (int ai = 0; ai < 2; ++ai)
#pragma unroll
            for (int m = 0; m < 4; ++m) { const int rl = ai * 128 + wr * 64 + m * 16 + fr; const float rs = ((const LAS float*)slot)[rl]; bf16* rowp = base + (size_t)rl * 2048 + wc * 32 + 8 * fq;
#pragma unroll
                for (int bj = 0; bj < 2; ++bj) { const f32x4 v0 = acc[ai][bj][m][0] * rs, v1 = acc[ai][bj][m][1] * rs;
                    v4u w; w.x = cvt_pk_bf16(v0[0], v0[1]); w.y = cvt_pk_bf16(v0[2], v0[3]); w.z = cvt_pk_bf16(v1[0], v1[1]); w.w = cvt_pk_bf16(v1[2], v1[3]);
                    *(v4u*)(rowp + bj * 128) = w; } }
    }
};

struct SchedRT4 { const char* q; const char* k; int G, c;
    __device__ __forceinline__ bool next(int i, Unit& u) const {
        const int L = i * G + c; if (L >= NBG * 4 * 16) return false;
        const int e = (L & 15) + 1, h = (L >> 4) & 3, bl = L >> 6; const size_t r0 = (size_t)bl * LE + e * 256;
        u.a = q + (r0 * 1024 + h * 256) * 2; u.b = k + (r0 * 1024 + h * 256) * 2; u.u0 = (int)r0; u.u1 = h; u.u2 = 0; u.u3 = 0; return true; } };
struct EpiRT4 {
    static constexpr bool PERM = true; static constexpr bool PRE = false, KSCALE = false;
    bf16* acat; const float* lg;
    __device__ __forceinline__ void operator()(const f32x4 (&acc)[2][2][4][2], const Unit& u, int wr, int wc, int fr, int fq) const {
        const int r0 = u.u0, h = u.u1; const float lgf = lg[h], lgb = lg[4 + h];
#pragma unroll
        for (int ai = 0; ai < 2; ++ai)
#pragma unroll
            for (int m = 0; m < 4; ++m) { const int i = ai * 128 + wr * 64 + m * 16 + fr;
#pragma unroll
                for (int bj = 0; bj < 2; ++bj) { const int j0 = bj * 128 + wc * 32 + 8 * fq;
                    const f32x4 v0 = acc[ai][bj][m][0], v1 = acc[ai][bj][m][1];
                    float o[8] = {v0[0], v0[1], v0[2], v0[3], v1[0], v1[1], v1[2], v1[3]};
#pragma unroll
                    for (int x = 0; x < 8; ++x) { const int d = i - (j0 + x); const float e2 = d >= 0 ? lgf * (float)d : lgb * (float)(-d); o[x] *= __builtin_amdgcn_exp2f(e2); }
                    v4u w; w.x = cvt_pk_bf16(o[0], o[1]); w.y = cvt_pk_bf16(o[2], o[3]); w.z = cvt_pk_bf16(o[4], o[5]); w.w = cvt_pk_bf16(o[6], o[7]);
                    *(v4u*)(acat + (size_t)(r0 + i) * 3072 + h * 768 + j0) = w; } }
    }
};
struct SchedRT2 { const char* bcat; const char* kt2; int G, c;
    __device__ __forceinline__ bool next(int i, Unit& u) const {
        int L = i * G + c; if (L >= NBG * 4 * 2 * 16 * 2) return false;
        if (G == 256) L = i * 256 + (c & 7) * 32 + (c >> 3);
        const int s6 = L & 63, bh = L >> 6, h = bh & 3, bl = bh >> 2; int es, dir, pm = s6 & 1;
        if (s6 < 4) { es = 0; dir = s6 >> 1; } else if (s6 < 6) { es = 1; dir = 0; } else if (s6 < 62) { const int t = s6 - 6; es = 2 + (t >> 2); dir = (t >> 1) & 1; } else { es = 16; dir = 1; }
        const int ed = dir == 0 ? es + 1 : (es == 0 ? 16 : es - 1);
        const int ch = (bl * 4 + h) * NCH;
        u.a = bcat + (size_t)(ch + es) * BCAT_CH + (size_t)pm * 256 * 768 * 2;
        u.b = kt2 + (size_t)dir * KT2_DIR + (size_t)(ch + es) * 131072;
        u.u0 = ch + ed; u.u1 = pm; u.u2 = dir; u.u3 = 0; return true; } };
struct LocRT2 { bf16* bcat;
    __device__ __forceinline__ void operator()(const Unit& u, bf16*& base, int& ldc) const {
        base = bcat + ((size_t)u.u0 * 512 + u.u1 * 256) * 768 + 256 + u.u2 * 256; ldc = 768; } };
struct SchedRT5 { const char* acat; const char* bcat; int G, c;
    __device__ __forceinline__ bool next(int i, Unit& u) const {
        int L = i * G + c; if (L >= NBG * 4 * 16 * 2) return false;
        if (G == 256) { const int xcd = c & 7, slot = c >> 3; L = ((i * 128 + xcd * 16 + (slot >> 1)) << 1) | (slot & 1); }
        const int pn = L & 1, idx = L >> 1, e = (idx & 15) + 1, h = (idx >> 4) & 3, bl = idx >> 6; const size_t r0 = (size_t)bl * LE + e * 256;
        u.a = acat + (r0 * 3072 + h * 768) * 2; u.b = bcat + (size_t)((bl * 4 + h) * NCH + e) * BCAT_CH + (size_t)pn * 256 * 768 * 2;
        u.u0 = (int)r0; u.u1 = h * 512 + pn * 256; u.u2 = 0; u.u3 = 0; return true; } };
struct LocRT5 { bf16* o;
    __device__ __forceinline__ void operator()(const Unit& u, bf16*& base, int& ldc) const { base = o + (size_t)u.u0 * 2048 + u.u1; ldc = 2048; } };

struct EpiRT5F {
    static constexpr bool PERM = true; static constexpr bool PRE = false, KSCALE = false;
    bf16* o; const bf16* gate; float* ssq;
    __device__ __forceinline__ void operator()(const f32x4 (&acc)[2][2][4][2], const Unit& u, int wr, int wc, int fr, int fq) const {
        const int pidx = (u.u1 >> 8) * 4 + wc;
        v4u gwa[2][4][2];
#pragma unroll
        for (int ai = 0; ai < 2; ++ai)
#pragma unroll
            for (int m = 0; m < 4; ++m) { const size_t off = ((size_t)u.u0 + ai * 128 + wr * 64 + m * 16 + fr) * 2048 + u.u1 + wc * 32 + 8 * fq;
#pragma unroll
                for (int bj = 0; bj < 2; ++bj) gwa[ai][m][bj] = *(const v4u*)(gate + off + bj * 128); }
#pragma unroll
        for (int ai = 0; ai < 2; ++ai)
#pragma unroll
            for (int m = 0; m < 4; ++m) { const size_t row = (size_t)u.u0 + ai * 128 + wr * 64 + m * 16 + fr; const size_t off = row * 2048 + u.u1 + wc * 32 + 8 * fq;
                f32x2 s2 = {0.f, 0.f};
#pragma unroll
                for (int bj = 0; bj < 2; ++bj) { const f32x4 v0 = acc[ai][bj][m][0], v1 = acc[ai][bj][m][1];
                    const v4u gw = gwa[ai][m][bj];
                    const f32x2 vv[4] = {(f32x2){v0[0], v0[1]}, (f32x2){v0[2], v0[3]}, (f32x2){v1[0], v1[1]}, (f32x2){v1[2], v1[3]}}; const unsigned gd[4] = {gw.x, gw.y, gw.z, gw.w};
                    unsigned wv[4];
#pragma unroll
                    for (int q = 0; q < 4; ++q) { const f32x2 g2 = bf2x2(gd[q]); s2 += vv[q] * vv[q]; const f32x2 og = vv[q] * (g2 * sig2(g2)); wv[q] = cvt_pk_bf16(og.x, og.y); }
                    v4u w; w.x = wv[0]; w.y = wv[1]; w.z = wv[2]; w.w = wv[3];
                    *(v4u*)(o + off + bj * 128) = w; }
                float s = s2.x + s2.y;
                s += SWZ_XOR(s, 16);
                { unsigned a_ = __builtin_bit_cast(unsigned, s), b_ = a_; asm volatile("" : "+v"(b_));
                  auto rr = __builtin_amdgcn_permlane32_swap(a_, b_, false, false);
                  unsigned r0_ = rr[0], r1_ = rr[1]; asm volatile("" : "+v"(r0_), "+v"(r1_));
                  s = __builtin_bit_cast(float, r0_) + __builtin_bit_cast(float, r1_); }
                if (fq == 0) ssq[row * 32 + pidx] = s; }
    }
};
struct EpiG1 {
    static constexpr bool PERM = true; static constexpr bool PRE = true, KSCALE = true;
    const bf16* g; bf16* out; const float* ssq;
    __device__ __forceinline__ void pre(const Unit& u, LAS unsigned char* slot, int wid) const {
        if (wid < 4) { const int rl = wid * 64 + lane_id_asm(); const float* p = ssq + ((size_t)u.u0 * 256 + rl) * 32; float rs[4];
#pragma unroll
            for (int h = 0; h < 4; ++h) { const f32x4 a = *(const f32x4*)(p + h * 8), b = *(const f32x4*)(p + h * 8 + 4);
                rs[h] = 1.0f / sqrtf((((a.x + a.y) + (a.z + a.w)) + ((b.x + b.y) + (b.z + b.w))) * (1.f / 512.f) + EPS); }
            *(LAS f32x4*)(slot + rl * 16) = (f32x4){rs[0] / rs[1], rs[1] / rs[2], rs[2] / rs[3], rs[3]}; } }
    __device__ __forceinline__ void kscale(f32x4 (&acc)[2][2][4][2], int wr, int hidx, const LAS unsigned char* slot) const {
        const int fr = lane_id_asm() & 15; const LAS float* f = (const LAS float*)slot + hidx;
#pragma unroll
        for (int ai = 0; ai < 2; ++ai)
#pragma unroll
            for (int m = 0; m < 4; ++m) { const float sc = f[(ai * 128 + wr * 64 + m * 16 + fr) * 4];
#pragma unroll
                for (int bj = 0; bj < 2; ++bj)
#pragma unroll
                    for (int n = 0; n < 2; ++n) acc[ai][bj][m][n] *= sc; } }
    __device__ __forceinline__ void operator()(const f32x4 (&acc)[2][2][4][2], const Unit& u, int wr, int wc, int fr, int fq, const LAS unsigned char* slot) const {
        const LAS float* f = (const LAS float*)slot + 3;
        v4u gwa[2][4][2];
#pragma unroll
        for (int ai = 0; ai < 2; ++ai)
#pragma unroll
            for (int m = 0; m < 4; ++m) { const size_t off = (size_t)(u.u0 * 256 + ai * 128 + wr * 64 + m * 16 + fr) * 1024 + u.u1 * 256 + wc * 32 + 8 * fq;
#pragma unroll
                for (int bj = 0; bj < 2; ++bj) gwa[ai][m][bj] = *(const v4u*)(g + off + bj * 128); }
#pragma unroll
        for (int ai = 0; ai < 2; ++ai)
#pragma unroll
            for (int m = 0; m < 4; ++m) { const int rl = ai * 128 + wr * 64 + m * 16 + fr; const float sc = f[rl * 4];
                const size_t off = (size_t)(u.u0 * 256 + rl) * 1024 + u.u1 * 256 + wc * 32 + 8 * fq;
#pragma unroll
                for (int bj = 0; bj < 2; ++bj) { const f32x4 v0 = acc[ai][bj][m][0] * sc, v1 = acc[ai][bj][m][1] * sc;
                    const v4u gw = gwa[ai][m][bj];
                    const f32x2 o0 = (f32x2){v0[0], v0[1]} * sig2(bf2x2(gw.x)), o1 = (f32x2){v0[2], v0[3]} * sig2(bf2x2(gw.y)), o2 = (f32x2){v1[0], v1[1]} * sig2(bf2x2(gw.z)), o3 = (f32x2){v1[2], v1[3]} * sig2(bf2x2(gw.w));
                    v4u w; w.x = cvt_pk_bf16(o0.x, o0.y); w.y = cvt_pk_bf16(o1.x, o1.y); w.z = cvt_pk_bf16(o2.x, o2.y); w.w = cvt_pk_bf16(o3.x, o3.y);
                    *(v4u*)(out + off + bj * 128) = w; } }
    }
};

template <bool ADD>
struct EpiGate {
    static constexpr bool PERM = true; static constexpr bool PRE = false, KSCALE = false;
    const bf16* g; const bf16* prev; bf16* out;
    __device__ __forceinline__ void operator()(const f32x4 (&acc)[2][2][4][2], const Unit& u, int wr, int wc, int fr, int fq) const {
#pragma unroll
        for (int ai = 0; ai < 2; ++ai) { v4u gwa[4][2], pwa[4][2];
#pragma unroll
            for (int m = 0; m < 4; ++m) { const size_t off = (size_t)(u.u0 * 256 + ai * 128 + wr * 64 + m * 16 + fr) * 1024 + u.u1 * 256 + wc * 32 + 8 * fq;
#pragma unroll
                for (int bj = 0; bj < 2; ++bj) { gwa[m][bj] = *(const v4u*)(g + off + bj * 128); if (ADD) pwa[m][bj] = *(const v4u*)(prev + off + bj * 128); } }
#pragma unroll
            for (int m = 0; m < 4; ++m) { const size_t off = (size_t)(u.u0 * 256 + ai * 128 + wr * 64 + m * 16 + fr) * 1024 + u.u1 * 256 + wc * 32 + 8 * fq;
#pragma unroll
                for (int bj = 0; bj < 2; ++bj) { const f32x4 v0 = acc[ai][bj][m][0], v1 = acc[ai][bj][m][1];
                    const v4u gw = gwa[m][bj];
                    f32x2 o0 = (f32x2){v0[0], v0[1]} * sig2(bf2x2(gw.x)), o1 = (f32x2){v0[2], v0[3]} * sig2(bf2x2(gw.y)), o2 = (f32x2){v1[0], v1[1]} * sig2(bf2x2(gw.z)), o3 = (f32x2){v1[2], v1[3]} * sig2(bf2x2(gw.w));
                    if (ADD) { const v4u pw = pwa[m][bj]; o0 += bf2x2(pw.x); o1 += bf2x2(pw.y); o2 += bf2x2(pw.z); o3 += bf2x2(pw.w); }
                    v4u w; w.x = cvt_pk_bf16(o0.x, o0.y); w.y = cvt_pk_bf16(o1.x, o1.y); w.z = cvt_pk_bf16(o2.x, o2.y); w.w = cvt_pk_bf16(o3.x, o3.y);
                    *(v4u*)(out + off + bj * 128) = w; } } }
    }
};
struct EpiG3 {
    static constexpr bool PERM = true; static constexpr bool PRE = false, KSCALE = false;
    const float* x; const float* ada; float* out; int g0;
    __device__ __forceinline__ void operator()(const f32x4 (&acc)[2][2][4][2], const Unit& u, int wr, int wc, int fr, int fq) const {
        const int pe = u.u0, bl = pe / NCH, e = pe % NCH, b = g0 + bl;
        const float* gv = ada + (size_t)b * 6144 + 2048 + u.u1 * 256 + wc * 32 + 8 * fq;
        f32x4 gt[2][2];
#pragma unroll
        for (int bj = 0; bj < 2; ++bj)
#pragma unroll
            for (int n = 0; n < 2; ++n) gt[bj][n] = *(const f32x4*)(gv + bj * 128 + n * 4);
#pragma unroll
        for (int ai = 0; ai < 2; ++ai) { f32x4 xa[4][2][2];
#pragma unroll
            for (int m = 0; m < 4; ++m) { const size_t tok = (size_t)b * SEQ + (e - 1) * 256 + ai * 128 + wr * 64 + m * 16 + fr; const int col = u.u1 * 256 + wc * 32 + 8 * fq;
#pragma unroll
                for (int bj = 0; bj < 2; ++bj) { const float* xp = x + tok * 1024 + col + bj * 128; xa[m][bj][0] = *(const f32x4*)xp; xa[m][bj][1] = *(const f32x4*)(xp + 4); } }
#pragma unroll
            for (int m = 0; m < 4; ++m) { const size_t tok = (size_t)b * SEQ + (e - 1) * 256 + ai * 128 + wr * 64 + m * 16 + fr;
                const int col = u.u1 * 256 + wc * 32 + 8 * fq;
#pragma unroll
                for (int bj = 0; bj < 2; ++bj) {
                    const f32x4 v0 = xa[m][bj][0] + gt[bj][0] * acc[ai][bj][m][0], v1 = xa[m][bj][1] + gt[bj][1] * acc[ai][bj][m][1];
                    v4u w; w.x = cvt_pk_bf16(v0[0], v0[1]); w.y = cvt_pk_bf16(v0[2], v0[3]); w.z = cvt_pk_bf16(v1[0], v1[1]); w.w = cvt_pk_bf16(v1[2], v1[3]);
                    *(v4u*)((bf16*)(out + tok * 1024) + col + bj * 128) = w; } } }
    }
};

template <int NT>
struct SchedMoE { const char* A; const char* W; size_t wexp; const volatile LAS int* ptab; int npan, G, c;
    __device__ __forceinline__ bool next(int i, Unit& u) const {
        const int L = i * G + c; if (L >= npan * NT) return false;
        int pm, pn; pg8::tile2d(L, npan, NT, pm, pn);
        const int e = ptab[pm]; const int pl = pm - ptab[e - 48];
        u.a = A + (size_t)pm * 256 * 1024 * 2; u.b = W + (size_t)e * wexp + (size_t)pn * 256 * 1024 * 2; u.u0 = pm; u.u1 = pn; u.u2 = e; u.u3 = ptab[608 + e] - pl * 256; u.u4 = e * TLM + pl * 256; return true; } };
struct SchedMoEG { const char* gbase; const unsigned short* rowtok; const char* W; size_t wexp; const volatile LAS int* ptab; int npan, G, c, zrow;
    __device__ __forceinline__ bool next(int i, Unit& u) const {
        const int L = i * G + c; if (L >= npan * 8) return false;
        int pm, pn; pg8::tile2d(L, npan, 8, pm, pn);
        const int e = ptab[pm]; const int pl = pm - ptab[e - 48];
        u.a = gbase; u.b = W + (size_t)e * wexp + (size_t)pn * 256 * 1024 * 2; u.u0 = pm; u.u1 = pn; u.u2 = e; u.u3 = ptab[608 + e] - pl * 256; u.u4 = e * TLM + pl * 256; return true; } };
struct EpiE3 {
    static constexpr bool PERM = true; static constexpr bool PRE = false, KSCALE = false;
    bf16* act; const float* bgu;
    __device__ __forceinline__ void operator()(const f32x4 (&acc)[2][2][4][2], const Unit& u, int wr, int wc, int fr, int fq) const {
        const int jj = u.u1 * 128 + wc * 32 + 8 * fq; const float* bp = bgu + (size_t)u.u2 * 2048 + jj;
        const f32x4 bg0 = *(const f32x4*)bp, bg1 = *(const f32x4*)(bp + 4), bu0 = *(const f32x4*)(bp + 1024), bu1 = *(const f32x4*)(bp + 1028);
#pragma unroll
        for (int ai = 0; ai < 2; ++ai)
#pragma unroll
            for (int m = 0; m < 4; ++m) { const size_t row = (size_t)u.u0 * 256 + ai * 128 + wr * 64 + m * 16 + fr;
                const f32x4 gs[2] = {acc[ai][0][m][0], acc[ai][0][m][1]}, us[2] = {acc[ai][1][m][0], acc[ai][1][m][1]}, bgs[2] = {bg0, bg1}, bus[2] = {bu0, bu1};
                unsigned wv[4];
#pragma unroll
                for (int q = 0; q < 4; ++q) { const int hx = q >> 1, x0 = (q & 1) * 2;
                    const f32x2 g2 = (f32x2){gs[hx][x0], gs[hx][x0 + 1]} + (f32x2){bgs[hx][x0], bgs[hx][x0 + 1]}, u2 = (f32x2){us[hx][x0], us[hx][x0 + 1]} + (f32x2){bus[hx][x0], bus[hx][x0 + 1]};
                    const f32x2 ga = (f32x2){fminf(g2.x, 7.f), fminf(g2.y, 7.f)}, up = (f32x2){fminf(fmaxf(u2.x, -7.f), 7.f), fminf(fmaxf(u2.y, -7.f), 7.f)};
                    const f32x2 z = ga * (f32x2){-1.702f * 1.4426950408889634f, -1.702f * 1.4426950408889634f};
                    const f32x2 den = (f32x2){__builtin_amdgcn_exp2f(z.x), __builtin_amdgcn_exp2f(z.y)} + (f32x2){1.f, 1.f};
                    const f32x2 sg = (f32x2){__builtin_amdgcn_rcpf(den.x), __builtin_amdgcn_rcpf(den.y)};
                    const f32x2 o2 = (up + (f32x2){1.f, 1.f}) * (ga * sg);
                    wv[q] = cvt_pk_bf16(o2.x, o2.y); }
                v4u w; w.x = wv[0]; w.y = wv[1]; w.z = wv[2]; w.w = wv[3];
                *(v4u*)(act + row * 1024 + jj) = w; }
    }
};
struct EpiE4 {
    static constexpr bool PERM = true; static constexpr bool PRE = false, KSCALE = false;
    bf16* ys; const float* bd; const float* rowg;
    __device__ __forceinline__ void operator()(const f32x4 (&acc)[2][2][4][2], const Unit& u, int wr, int wc, int fr, int fq) const {
        const int c0 = u.u1 * 256 + wc * 32 + 8 * fq; const float* bp = bd + (size_t)u.u2 * 1024 + c0;
        f32x4 b[2][2];
#pragma unroll
        for (int bj = 0; bj < 2; ++bj) { b[bj][0] = *(const f32x4*)(bp + bj * 128); b[bj][1] = *(const f32x4*)(bp + bj * 128 + 4); }
        float rga[2][4];
#pragma unroll
        for (int ai = 0; ai < 2; ++ai)
#pragma unroll
            for (int m = 0; m < 4; ++m) rga[ai][m] = rowg[(size_t)u.u4 + ai * 128 + wr * 64 + m * 16 + fr];
#pragma unroll
        for (int ai = 0; ai < 2; ++ai)
#pragma unroll
            for (int m = 0; m < 4; ++m) { const size_t row = (size_t)u.u0 * 256 + ai * 128 + wr * 64 + m * 16 + fr; const float rg = rga[ai][m];
#pragma unroll
                for (int bj = 0; bj < 2; ++bj) { const f32x4 v0 = (acc[ai][bj][m][0] + b[bj][0]) * rg, v1 = (acc[ai][bj][m][1] + b[bj][1]) * rg;
                    v4u w; w.x = cvt_pk_bf16(v0[0], v0[1]); w.y = cvt_pk_bf16(v0[2], v0[3]); w.z = cvt_pk_bf16(v1[0], v1[1]); w.w = cvt_pk_bf16(v1[2], v1[3]);
                    *(v4u*)(ys + row * 1024 + c0 + bj * 128) = w; } }
    }
};
namespace att {
constexpr int NW = 8, QBLK = 32, KVBLK = 64;
constexpr float SCALE = 0.072168783648703220f;
constexpr float THR = 8.f;
constexpr int KROWB = 384;
constexpr size_t SHM_V = KVBLK * 128 * 2, SHM_K = KVBLK * KROWB, SHM_ATTN = 2 * SHM_V + 2 * SHM_K + NW * 64 * 4;
constexpr int OST_ROW = 72, OST_WAVE = 32 * OST_ROW * 2;
static_assert(SHM_ATTN + NW * OST_WAVE <= RING_BYTES, "attention LDS");
#define KSWZ(row, colB) ((row) * att::KROWB + ((colB) ^ (((row) & 7) << 4)))
#define SBAR() __builtin_amdgcn_sched_barrier(0)
__device__ __forceinline__ int crow(int r, int hi) { return (r & 3) + 8 * (r >> 2) + 4 * hi; }

__device__ __forceinline__ void partialSM(f32x16& p0, f32x16& p1, float& m_reg, float& mn, float& alpha) {
  constexpr float C = SCALE * 1.4426950408889634f;
  float pmax = p0[0];
#pragma unroll
  for (int r = 1; r < 16; ++r) pmax = fmaxf(pmax, p0[r]);
#pragma unroll
  for (int r = 0; r < 16; ++r) pmax = fmaxf(pmax, p1[r]);
  { unsigned a_ = __float_as_uint(pmax), b_ = a_; asm volatile("" : "+v"(b_));
    auto rr = __builtin_amdgcn_permlane32_swap(a_, b_, false, false);
    unsigned r0_ = rr[0], r1_ = rr[1]; asm volatile("" : "+v"(r0_), "+v"(r1_));
    pmax = fmaxf(__uint_as_float(r0_), __uint_as_float(r1_)); }
  if (__builtin_expect(__all(pmax - m_reg <= THR / SCALE), 1)) { mn = m_reg; alpha = 1.f; }
  else { mn = fmaxf(m_reg, pmax); alpha = __builtin_amdgcn_exp2f((m_reg - mn) * C); m_reg = mn; }
  float mnC = -mn * C;
#pragma unroll
  for (int r = 0; r < 16; ++r) p0[r] = fmaf(p0[r], C, mnC);
#pragma unroll
  for (int r = 0; r < 16; ++r) p1[r] = fmaf(p1[r], C, mnC);
#pragma unroll
  for (int r = 0; r < 16; ++r) p0[r] = __builtin_amdgcn_exp2f(p0[r]);
}
__device__ __forceinline__ void finishSM(f32x16& p0, f32x16& p1, float alpha, float& l_reg, bf16x8& pa0, bf16x8& pa1, bf16x8& pa2, bf16x8& pa3) {
#pragma unroll
  for (int r = 0; r < 16; ++r) p1[r] = __builtin_amdgcn_exp2f(p1[r]);
  float ps = 0;
#pragma unroll
  for (int r = 0; r < 16; ++r) ps += p0[r];
#pragma unroll
  for (int r = 0; r < 16; ++r) ps += p1[r];
  { unsigned a_ = __float_as_uint(ps), b_ = a_; asm volatile("" : "+v"(b_));
    auto rr = __builtin_amdgcn_permlane32_swap(a_, b_, false, false);
    unsigned r0_ = rr[0], r1_ = rr[1]; asm volatile("" : "+v"(r0_), "+v"(r1_));
    ps = __uint_as_float(r0_) + __uint_as_float(r1_); }
  l_reg = l_reg * alpha + ps;
#define PK4(P, BASE, OUT) do { unsigned a0 = cvt_pk_bf16(P[BASE + 0], P[BASE + 1]), a1 = cvt_pk_bf16(P[BASE + 2], P[BASE + 3]);   \
    unsigned b0 = cvt_pk_bf16(P[BASE + 4], P[BASE + 5]), b1 = cvt_pk_bf16(P[BASE + 6], P[BASE + 7]);                              \
    auto r0 = __builtin_amdgcn_permlane32_swap(a0, b0, false, false); auto r1 = __builtin_amdgcn_permlane32_swap(a1, b1, false, false); \
    v4u w = {r0[0], r1[0], r0[1], r1[1]}; OUT = *reinterpret_cast<bf16x8*>(&w); } while (0)
  PK4(p0, 0, pa0); PK4(p0, 8, pa1); PK4(p1, 0, pa2); PK4(p1, 8, pa3);
#undef PK4
}
__device__ __forceinline__ void qkt(f32x16& p0, f32x16& p1, const char* Ks, const bf16x8 (&qr)[12], int r32, int hi) {
  p0 = f32x16{}; p1 = f32x16{};
#pragma unroll
  for (int d0 = 0; d0 < 12; ++d0) { int cb = (d0 * 16 + hi * 8) * 2;
    bf16x8 b0 = *reinterpret_cast<const bf16x8*>(Ks + KSWZ(r32, cb));
    bf16x8 b1 = *reinterpret_cast<const bf16x8*>(Ks + KSWZ(32 + r32, cb));
    p0 = __builtin_amdgcn_mfma_f32_32x32x16_bf16(b0, qr[d0], p0, 0, 0, 0);
    p1 = __builtin_amdgcn_mfma_f32_32x32x16_bf16(b1, qr[d0], p1, 0, 0, 0); }
}
__device__ __forceinline__ int v_st(int k, int c) { const int kk = (k & ~0xC) | ((k & 4) << 1) | ((k & 8) >> 1); return ((kk >> 3) * 4 + (c >> 5)) * 512 + ((kk & 7) * 32 + (c & 31)) * 2; }
__device__ __forceinline__ int v_rd_base(int lane) { return ((lane & 3) << 3) | (((lane >> 2) & 3) << 6) | (((lane >> 4) & 1) << 5) | (((lane >> 5) & 1) << 8); }
constexpr int v_rd_off(int d0, int ks, int half) { return d0 * 512 + ks * 4096 + half * 2048; }
template <int OFF> __device__ __forceinline__ s16x4 tr_read(int vb) {
  s16x4 r; asm volatile("ds_read_b64_tr_b16 %0, %1 offset:%2" : "=&v"(r) : "v"(vb), "i"(OFF) : "memory"); return r;
}
template <int D0> __device__ __forceinline__ void pv_one(f32x16& od, int vb, bf16x8 pa0, bf16x8 pa1, bf16x8 pa2, bf16x8 pa3) {
  const s16x4 l0 = tr_read<v_rd_off(D0, 0, 0)>(vb), h0 = tr_read<v_rd_off(D0, 0, 1)>(vb), l1 = tr_read<v_rd_off(D0, 1, 0)>(vb), h1 = tr_read<v_rd_off(D0, 1, 1)>(vb);
  const s16x4 l2 = tr_read<v_rd_off(D0, 2, 0)>(vb), h2 = tr_read<v_rd_off(D0, 2, 1)>(vb), l3 = tr_read<v_rd_off(D0, 3, 0)>(vb), h3 = tr_read<v_rd_off(D0, 3, 1)>(vb);
  asm volatile("s_waitcnt lgkmcnt(0)" ::: "memory"); SBAR();
#define PK(L, H) (bf16x8){L[0], L[1], L[2], L[3], H[0], H[1], H[2], H[3]}
  od = __builtin_amdgcn_mfma_f32_32x32x16_bf16(pa0, PK(l0, h0), od, 0, 0, 0);
  od = __builtin_amdgcn_mfma_f32_32x32x16_bf16(pa1, PK(l1, h1), od, 0, 0, 0);
  od = __builtin_amdgcn_mfma_f32_32x32x16_bf16(pa2, PK(l2, h2), od, 0, 0, 0);
  od = __builtin_amdgcn_mfma_f32_32x32x16_bf16(pa3, PK(l3, h3), od, 0, 0, 0);
#undef PK
}
__device__ __forceinline__ void pv_d0(f32x16 (&o)[4], int vb, bf16x8 pa0, bf16x8 pa1, bf16x8 pa2, bf16x8 pa3) {
  pv_one<0>(o[0], vb, pa0, pa1, pa2, pa3); pv_one<1>(o[1], vb, pa0, pa1, pa2, pa3); pv_one<2>(o[2], vb, pa0, pa1, pa2, pa3); pv_one<3>(o[3], vb, pa0, pa1, pa2, pa3);
}

__device__ __forceinline__ void attn_body(const bf16* __restrict__ Qb, const bf16* __restrict__ Kn, const bf16* __restrict__ Kr, const bf16* __restrict__ Vh,
                                          bf16* __restrict__ Ob, int seq, char* lds, int tid_in) {
  constexpr int LDQ = 1536, LDKV = 2048, LDKR = 768, LDO = 1024;
  const int tid_o = tid_in * 64 + lane_id_asm();
  const int tid = tid_o, wid = tid >> 6, lane = tid & 63, r32 = lane & 31, hi = lane >> 5;
  if (tid_in >= 4) __builtin_amdgcn_s_setprio(1);
  char* V_lds = lds; char* K_lds = lds + 2 * SHM_V;
  float* ws = (float*)(lds + 2 * SHM_V + 2 * SHM_K) + wid * 64; float* li_l = ws; float* al_l = ws + 32;
  float m_reg = -1e30f, l_reg = 0; f32x16 o[4] = {}; bf16x8 qr[12];
  const bf16* Qw = Qb + (long)(wid * QBLK + r32) * LDQ + hi * 8;
#pragma unroll
  for (int d0 = 0; d0 < 12; ++d0) qr[d0] = *reinterpret_cast<const bf16x8*>(Qw + d0 * 16);
  const int sr = tid >> 4, sc = (tid & 15) * 8, vst0 = v_st(sr, sc), vst1 = v_st(32 + sr, sc);
  const int rr = tid >> 3, rc = (tid & 7) * 8;
  const int vb0 = (int)(uintptr_t)V_lds + v_rd_base(lane);
  bf16x8 vs0, vs1, ks0, ks1, kr0;
#define SLOAD(k0) do { vs0 = *(const bf16x8*)(&Vh[(long)((k0) + sr) * LDKV + sc]); vs1 = *(const bf16x8*)(&Vh[(long)((k0) + 32 + sr) * LDKV + sc]); \
    ks0 = *(const bf16x8*)(&Kn[(long)((k0) + sr) * LDKV + sc]); ks1 = *(const bf16x8*)(&Kn[(long)((k0) + 32 + sr) * LDKV + sc]); \
    kr0 = *(const bf16x8*)(&Kr[(long)((k0) + rr) * LDKR + rc]); } while (0)
#define SWRITE(b) do { *(bf16x8*)(V_lds + (b) * SHM_V + vst0) = vs0; *(bf16x8*)(V_lds + (b) * SHM_V + vst1) = vs1; int kc = sc * 2;               \
    *(bf16x8*)(K_lds + (b) * SHM_K + KSWZ(sr, kc)) = ks0; *(bf16x8*)(K_lds + (b) * SHM_K + KSWZ(32 + sr, kc)) = ks1;                              \
    *(bf16x8*)(K_lds + (b) * SHM_K + KSWZ(rr, 256 + rc * 2)) = kr0; } while (0)
#define SWAIT() asm volatile("s_waitcnt vmcnt(0)" ::: "memory")
#define RESC(a) do { if (__any((a) < 1.f)) { if (hi == 0) al_l[r32] = (a); asm volatile("s_waitcnt lgkmcnt(0)" ::: "memory"); \
    _Pragma("unroll") for (int d = 0; d < 4; ++d) _Pragma("unroll") for (int r = 0; r < 16; ++r) o[d][r] *= al_l[crow(r, hi)]; } } while (0)
  f32x16 pA0, pA1, pB0, pB1; float mnA, mnB, alA, alB; bf16x8 pa0, pa1, pa2, pa3; const int NT = seq / KVBLK;
  SLOAD(0); asm volatile("s_waitcnt vmcnt(0)" ::: "memory"); SWRITE(0); SLOAD(KVBLK); __syncthreads();
  qkt(pA0, pA1, K_lds, qr, r32, hi); partialSM(pA0, pA1, m_reg, mnA, alA);
  SWAIT(); SWRITE(1); __syncthreads();
  for (int j = 1; j + 1 < NT; j += 2) {
    SBAR(); qkt(pB0, pB1, K_lds + SHM_K, qr, r32, hi);
    finishSM(pA0, pA1, alA, l_reg, pa0, pa1, pa2, pa3); SBAR();
    SLOAD((j + 1) * KVBLK); SBAR();
    pv_d0(o, vb0, pa0, pa1, pa2, pa3); partialSM(pB0, pB1, m_reg, mnB, alB);
    __syncthreads(); SWAIT(); SWRITE(0);
    RESC(alB); __syncthreads();
    SBAR(); qkt(pA0, pA1, K_lds, qr, r32, hi);
    finishSM(pB0, pB1, alB, l_reg, pa0, pa1, pa2, pa3); SBAR();
    SLOAD((j + 2) * KVBLK); SBAR();
    pv_d0(o, vb0 + (int)SHM_V, pa0, pa1, pa2, pa3); partialSM(pA0, pA1, m_reg, mnA, alA);
    __syncthreads(); SWAIT(); SWRITE(1);
    RESC(alA); __syncthreads();
  }
  SBAR(); qkt(pB0, pB1, K_lds + SHM_K, qr, r32, hi);
  finishSM(pA0, pA1, alA, l_reg, pa0, pa1, pa2, pa3); SBAR();
  pv_d0(o, vb0, pa0, pa1, pa2, pa3); partialSM(pB0, pB1, m_reg, mnB, alB);
  __syncthreads(); RESC(alB);
  finishSM(pB0, pB1, alB, l_reg, pa0, pa1, pa2, pa3); SBAR();
  pv_d0(o, vb0 + (int)SHM_V, pa0, pa1, pa2, pa3);
  if (hi == 0) li_l[r32] = l_reg; asm volatile("s_waitcnt lgkmcnt(0)" ::: "memory");
  { const int l_e = lane_id_asm(), r32e = l_e & 31, hie = l_e >> 5;
    bf16* Obe = Ob; asm volatile("" : "+s"(Obe)); Obe = (bf16*)(GAS bf16*)(unsigned long long)Obe;
    float rli[16];
#pragma unroll
    for (int r = 0; r < 16; ++r) rli[r] = __builtin_amdgcn_rcpf(li_l[crow(r, hie)]);
    bf16* Ow = Obe + (long)(wid * QBLK) * LDO;
    unsigned short* stg = (unsigned short*)(lds + SHM_ATTN + wid * OST_WAVE);
#pragma unroll
    for (int p = 0; p < 2; ++p) {
#pragma unroll
      for (int r = 0; r < 16; ++r) { const int orow = crow(r, hie);
#pragma unroll
        for (int d = 0; d < 2; ++d) stg[orow * OST_ROW + d * 32 + r32e] = f2bf(o[2 * p + d][r] * rli[r]); }
      asm volatile("s_waitcnt lgkmcnt(0)" ::: "memory");
#pragma unroll
      for (int i = 0; i < 4; ++i) { const int row = i * 8 + (l_e >> 3), ch = l_e & 7; const v4u v = *(const v4u*)(stg + row * OST_ROW + ch * 8); *(v4u*)(Ow + (long)row * LDO + p * 64 + ch * 8) = v; }
      asm volatile("s_waitcnt lgkmcnt(0)" ::: "memory");
    } }
  __builtin_amdgcn_s_setprio(0);
#undef SLOAD
#undef SWRITE
#undef SWAIT
#undef RESC
}
}
struct Ctx {
    LAS unsigned char* lds; int tid, lane, wave, G, gw, NGW;
    __device__ __forceinline__ void* p(int i) const { asm volatile("" : "+s"(i));
        volatile LAS unsigned* T = (volatile LAS unsigned*)(lds + MISC_OFF + MISC_PT);
        const unsigned lo = __builtin_amdgcn_readfirstlane(T[2 * i]), hi = __builtin_amdgcn_readfirstlane(T[2 * i + 1]); return (void*)(GAS void*)(((unsigned long long)hi << 32) | lo); }
};

template <class Map>
__device__ __forceinline__ void transpose_item(const float* W, int K, int N, bf16* WT, const float* kscale, LAS float* scr, int item, int lane, Map map) {
    const int nblk = N / 32, kb = item / nblk, nb = item % nblk, k0 = 64 * kb, n0 = 32 * nb;
#pragma unroll 8
    for (int i = 0; i < 32; ++i) { const int kk = 2 * i + (lane >> 5); float v = W[(size_t)(k0 + kk) * N + n0 + (lane & 31)]; if (kscale) v *= kscale[k0 + kk]; scr[kk * 33 + (lane & 31)] = v; }
    LDS_WAIT(); asm volatile("" ::: "memory");
    const int c = lane & 7;
#pragma unroll
    for (int j = 0; j < 4; ++j) { const int n = (lane >> 3) + 8 * j; const LAS float* s = scr + (8 * c) * 33 + n;
        v4u o; o.x = pk2(s[0 * 33], s[1 * 33]); o.y = pk2(s[2 * 33], s[3 * 33]); o.z = pk2(s[4 * 33], s[5 * 33]); o.w = pk2(s[6 * 33], s[7 * 33]);
        const int dr = map(n0 + n);
        *(v4u*)(WT + (size_t)dr * K + k0 + 8 * c) = o; }
    LDS_WAIT(); asm volatile("" ::: "memory");
}
__device__ __forceinline__ int map_win(int n) {
    if (n < 2048) { const int seg = n >> 10, r = n & 1023, h = r >> 8, j = r & 255;
        const int jp = 2 * (64 * (j >> 7) + (j & 63)) + ((j >> 6) & 1); return seg * 1024 + h * 256 + jp; }
    if (n < 4096) return WIN_V + (n - 2048);
    if (n < 6144) return WIN_GATE + (n - 4096);
    if (n < 6528) return WIN_MLA + (n - 6144);
    if (n < 6784) return WIN_MLA + 384 + (n - 6528);
    if (n < 6848) { const int j = n - 6784; const int jp = 2 * (16 * (j >> 5) + (j & 15)) + ((j >> 4) & 1); return WIN_MLA + 640 + jp; }
    if (n < 7872) return WIN_GRET + (n - 6848);
    return WIN_GMLA + (n - 7872);
}
__device__ __forceinline__ int map_wuq(int n) { const int h = n / 192, jj = n % 192; if (jj < 128) return n; const int j = jj - 128; return h * 192 + 128 + 2 * (16 * (j >> 5) + (j & 15)) + ((j >> 4) & 1); }
__device__ __forceinline__ int map_id(int n) { return n; }
__device__ __forceinline__ int map_wgu(int n) { const int up = n >> 10, j = n & 1023; return 256 * (j >> 7) + 128 * up + (j & 127); }

__device__ __forceinline__ void p0_weights(const Ctx& C) {
    LAS float* scr = (LAS float*)(C.lds + C.wave * 16384);
    unsigned char* ws = ((unsigned char*)C.p(26));
    const float* w_in = ((const float*)C.p(8)); const float* w_uq = ((const float*)C.p(12)); const float* w_ukv = ((const float*)C.p(14)); const float* w_br = ((const float*)C.p(15)); const float* w_bm = ((const float*)C.p(16)); const float* w_o = ((const float*)C.p(17));
    const float* w_gu = ((const float*)C.p(20)); const float* w_d = ((const float*)C.p(22)); const float* qg = ((const float*)C.p(11)); const float* kvg = ((const float*)C.p(13));
    constexpr int I_IN = 16 * (8896 / 32), I_UQ = 6 * 48, I_UKV = 4 * 64, I_BR = 32 * 32, I_BM = 16 * 32, I_O = 16 * 32, I_GU1 = 16 * 64, I_D1 = 16 * 32;
    constexpr int NIT = I_IN + I_UQ + I_UKV + I_BR + I_BM + I_O + 32 * I_GU1 + 32 * I_D1;
    for (int it = C.gw; it < NIT; it += C.NGW) {
        int r = it;
        if (r < I_IN) { transpose_item(w_in, 1024, 8896, (bf16*)(ws + WS_WIN), nullptr, scr, r, C.lane, map_win); continue; } r -= I_IN;
        if (r < I_UQ) { transpose_item(w_uq, 384, 1536, (bf16*)(ws + WS_WUQ), qg, scr, r, C.lane, map_wuq); continue; } r -= I_UQ;
        if (r < I_UKV) { transpose_item(w_ukv, 256, 2048, (bf16*)(ws + WS_WUKV), kvg, scr, r, C.lane, map_id); continue; } r -= I_UKV;
        if (r < I_BR) { transpose_item(w_br, 2048, 1024, (bf16*)(ws + WS_WBR), nullptr, scr, r, C.lane, map_id); continue; } r -= I_BR;
        if (r < I_BM) { transpose_item(w_bm, 1024, 1024, (bf16*)(ws + WS_WBM), nullptr, scr, r, C.lane, map_id); continue; } r -= I_BM;
        if (r < I_O) { transpose_item(w_o, 1024, 1024, (bf16*)(ws + WS_WO), nullptr, scr, r, C.lane, map_id); continue; } r -= I_O;
        if (r < 32 * I_GU1) { const int e = r / I_GU1; transpose_item(w_gu + (size_t)e * 1024 * 2048, 1024, 2048, (bf16*)(ws + WS_WGU) + (size_t)e * 2048 * 1024, nullptr, scr, r % I_GU1, C.lane, map_wgu); continue; } r -= 32 * I_GU1;
        { const int e = r / I_D1; transpose_item(w_d + (size_t)e * 1024 * 1024, 1024, 1024, (bf16*)(ws + WS_WD) + (size_t)e * 1024 * 1024, nullptr, scr, r % I_D1, C.lane, map_id); }
    }
    { bf16* padp = (bf16*)(ws + WS_WIN) + (size_t)(WIN_MLA + 704) * 1024; const int n16 = 64 * 1024 * 2 / 16;
      for (int i = blockIdx.x * 512 + C.tid; i < n16; i += C.G * 512) ((v4u*)padp)[i] = (v4u){0u, 0u, 0u, 0u}; }
    { float2* tabr = (float2*)(ws + WS_TABR); float2* tabm = (float2*)(ws + WS_TABM); float* lg = (float*)(ws + WS_LG);
      for (int i = blockIdx.x * 512 + C.tid; i < 64 * 64 + 64 * 16 + 8; i += C.G * 512) {
        if (i < 4096) { const int pos = i >> 6, f = i & 63; const float fr = exp2f(-(float)f * (13.287712379549449f / 64.0f)); const float a = (float)pos * fr; tabr[i] = make_float2(cosf(a), sinf(a)); }
        else if (i < 4096 + 1024) { const int k = i - 4096, pos = k >> 4, f = k & 15; const float fr = exp2f(-(float)f * (13.287712379549449f / 16.0f)); const float a = (float)pos * fr; tabm[k] = make_float2(cosf(a), sinf(a)); }
        else { const int k = i - 5120; const float d = (k < 4 ? ((const float*)C.p(9)) : ((const float*)C.p(10)))[k & 3];
               lg[k] = -log2f(1.0f + expf(-d)); }
      } }
}
__device__ __forceinline__ void p0_ada(const Ctx& C) {
    if ((int)blockIdx.x >= 96) return;
    LAS float* sl = (LAS float*)C.lds;
    LAS float* red = sl + 17 * 1024;
    const float* cv = ((const float*)C.p(1)); const float* cc = ((const float*)C.p(3)); const float* aw = ((const float*)C.p(6)); const float* ab = ((const float*)C.p(7));
#pragma unroll 8
    for (int i = C.tid; i < 17 * 1024; i += 512) { const float v = i < 16 * 1024 ? cv[i] : cc[i - 16 * 1024]; sl[i] = v / (1.0f + expf(-v)); }
    __syncthreads();
    const int n = blockIdx.x * 64 + C.lane; float acc[17];
#pragma unroll
    for (int b = 0; b < 17; ++b) acc[b] = 0.f;
#pragma unroll 8
    for (int k = C.wave * 128; k < C.wave * 128 + 128; ++k) { const float w = aw[(size_t)k * 6144 + n];
#pragma unroll
        for (int b = 0; b < 17; ++b) acc[b] += sl[b * 1024 + k] * w; }
#pragma unroll
    for (int b = 0; b < 17; ++b) red[(C.wave * 17 + b) * 64 + C.lane] = acc[b];
    __syncthreads();
    float* m = (float*)(((unsigned char*)C.p(26)) + WS_ADA);
    for (int i = C.tid; i < 17 * 64; i += 512) { const int b = i >> 6, l = i & 63; float s = ab[blockIdx.x * 64 + l];
#pragma unroll
        for (int w = 0; w < 8; ++w) s += red[(w * 17 + b) * 64 + l];
        m[(size_t)b * 6144 + blockIdx.x * 64 + l] = s; }
    __syncthreads();
}

__device__ __forceinline__ const float* p1_src(const float* x, const float* ctx, int grp, int r) {
    const int bl = r / LE, p = r % LE, b = grp * NBG + bl; return p < CTX ? ctx + ((size_t)b * CTX + p) * D : x + ((size_t)b * SEQ + (p - CTX)) * D; }
__device__ __forceinline__ void p1_finish(const f32x4 (&v)[4], const float* g1, const float* ada, bf16* h, int grp, int r, int lane) {
    const int bl = r / LE, p = r % LE, b = grp * NBG + bl; const float* mod = ada + (size_t)(p < CTX ? 16 : b) * 6144;
    f32x4 ga[4], sha[4], sca[4];
#pragma unroll
    for (int j = 0; j < 4; ++j) { const int c = 4 * lane + 256 * j; ga[j] = *(const f32x4*)(g1 + c); sha[j] = *(const f32x4*)(mod + c); sca[j] = *(const f32x4*)(mod + 1024 + c); }
    float s = 0.f;
#pragma unroll
    for (int j = 0; j < 4; ++j) s += (v[j].x * v[j].x + v[j].y * v[j].y) + (v[j].z * v[j].z + v[j].w * v[j].w);
    const float rstd = 1.0f / sqrtf(wave_sum(s) * (1.f / D) + EPS);
#pragma unroll
    for (int j = 0; j < 4; ++j) { const int c = 4 * lane + 256 * j;
        const f32x4 g = ga[j], sh = sha[j], sc = sca[j];
        const f32x4 o = (v[j] * rstd * g) * (sc + 1.0f) + sh;
        v2u w; w.x = pk2(o.x, o.y); w.y = pk2(o.z, o.w); *(v2u*)(h + (size_t)r * 1024 + c) = w; }
}
__device__ __forceinline__ void p1_hext(const Ctx& C, int grp) {
    const float* x = ((const float*)C.p(0)); const float* ctx = ((const float*)C.p(2)); const float* g1 = ((const float*)C.p(4)); const float* ada = (const float*)(((unsigned char*)C.p(26)) + WS_ADA);
    bf16* h = (bf16*)(((unsigned char*)C.p(26)) + WS_ARENA + AR_H);
    for (int rA = C.gw; rA < TE; rA += 2 * C.NGW) {
        const int rB = rA + C.NGW; const bool hasB = rB < TE;
        const float* sA = p1_src(x, ctx, grp, rA); const float* sB = p1_src(x, ctx, grp, hasB ? rB : rA);
        f32x4 vA[4], vB[4];
#pragma unroll
        for (int j = 0; j < 4; ++j) { vA[j] = *(const f32x4*)(sA + 4 * C.lane + 256 * j); vB[j] = *(const f32x4*)(sB + 4 * C.lane + 256 * j); }
        p1_finish(vA, g1, ada, h, grp, rA, C.lane);
        if (hasB) p1_finish(vB, g1, ada, h, grp, rB, C.lane);
    }
}

__device__ __forceinline__ void p_kt2(const Ctx& C) {
    const bf16* k = (const bf16*)(((unsigned char*)C.p(26)) + WS_ARENA + AR_K); bf16* kt = (bf16*)(((unsigned char*)C.p(26)) + WS_ARENA + AR_KT2); const float* lg = (const float*)(((unsigned char*)C.p(26)) + WS_LG);
    LAS unsigned short* tile = (LAS unsigned short*)C.lds;
    const int nitems = NBG * 4 * NCH * 4;
    v4u wn[4];
#define KT2_LOAD(itx) do { const int db_ = (itx) & 3, chh_ = (itx) >> 2, e_ = chh_ % NCH, h_ = (chh_ / NCH) & 3, bl_ = chh_ / (NCH * 4); const size_t r0_ = (size_t)bl_ * LE + e_ * 256; \
        _Pragma("unroll") for (int i = 0; i < 4; ++i) { const int pc = C.tid + 512 * i, j = pc >> 3, dc = (pc & 7) * 8; wn[i] = *(const v4u*)(k + (r0_ + j) * 1024 + h_ * 256 + db_ * 64 + dc); } } while (0)
    if ((int)blockIdx.x < nitems) KT2_LOAD((int)blockIdx.x);
    for (int it = blockIdx.x; it < nitems; it += C.G) {
        const int db = it & 3, chh = it >> 2, e = chh % NCH, h = (chh / NCH) & 3, bl = chh / (NCH * 4); (void)e; (void)bl;
#pragma unroll
        for (int i = 0; i < 4; ++i) { const int pc = C.tid + 512 * i, j = pc >> 3, dc = (pc & 7) * 8; const v4u w = wn[i];
            LAS unsigned* tp = (LAS unsigned*)(tile + j * 66 + dc); tp[0] = w.x; tp[1] = w.y; tp[2] = w.z; tp[3] = w.w; }
        if (it + C.G < nitems) KT2_LOAD(it + C.G);
        __syncthreads();
        const float lgf = lg[h], lgb = lg[4 + h];
        const LAS unsigned* tile32 = (const LAS unsigned*)tile;
#pragma unroll
        for (int i = 0; i < 2; ++i) { const int dp = 4 * C.wave + (C.lane & 3), j0 = (16 * i + (C.lane >> 2)) * 8;
            unsigned w[8];
#pragma unroll
            for (int x = 0; x < 8; ++x) w[x] = tile32[(j0 + x) * 33 + dp];
            float f0[8], f1[8], g0[8], g1[8];
#pragma unroll
            for (int x = 0; x < 8; ++x) { const float ef = __builtin_amdgcn_exp2f(lgf * (float)(255 - (j0 + x))), eb = __builtin_amdgcn_exp2f(lgb * (float)(j0 + x)); const float lo = bflo(w[x]), hi = bfhi(w[x]);
                f0[x] = lo * ef; f1[x] = hi * ef; g0[x] = lo * eb; g1[x] = hi * eb; }
            v4u wf0, wf1, wb0, wb1;
            wf0.x = pk2(f0[0], f0[1]); wf0.y = pk2(f0[2], f0[3]); wf0.z = pk2(f0[4], f0[5]); wf0.w = pk2(f0[6], f0[7]);
            wf1.x = pk2(f1[0], f1[1]); wf1.y = pk2(f1[2], f1[3]); wf1.z = pk2(f1[4], f1[5]); wf1.w = pk2(f1[6], f1[7]);
            wb0.x = pk2(g0[0], g0[1]); wb0.y = pk2(g0[2], g0[3]); wb0.z = pk2(g0[4], g0[5]); wb0.w = pk2(g0[6], g0[7]);
            wb1.x = pk2(g1[0], g1[1]); wb1.y = pk2(g1[2], g1[3]); wb1.z = pk2(g1[4], g1[5]); wb1.w = pk2(g1[6], g1[7]);
            const size_t off = ((size_t)chh * 256 + db * 64 + 2 * dp) * 256 + j0;
            *(v4u*)(kt + off) = wf0; *(v4u*)(kt + off + 256) = wf1; *(v4u*)(kt + KT2_DIR / 2 + off) = wb0; *(v4u*)(kt + KT2_DIR / 2 + off + 256) = wb1; }
        __syncthreads();
    }
#undef KT2_LOAD
}

__device__ __forceinline__ void p_scan(const Ctx& C) {
    bf16* bcat = (bf16*)(((unsigned char*)C.p(26)) + WS_ARENA + AR_BCAT); const float* lg = (const float*)(((unsigned char*)C.p(26)) + WS_LG);
    const int nitems = NBG * 4 * 2 * 512 * 32;
    for (int it = blockIdx.x * 512 + C.tid; it < nitems; it += C.G * 512) {
        const int c8 = it & 31, dv = (it >> 5) & 511, dir = (it >> 14) & 1, bh = it >> 15, h = bh & 3;
        const float gC = __builtin_amdgcn_exp2f(lg[dir * 4 + h] * 256.0f);
        bf16* base = bcat + (size_t)bh * NCH * 512 * 768 + (size_t)dv * 768 + 256 + dir * 256 + c8 * 8;
        v4u w[16];
#pragma unroll
        for (int st = 0; st < 16; ++st) { const int e = dir == 0 ? 1 + st : 16 - st; w[st] = *(const v4u*)(base + (size_t)e * 512 * 768); }
        float s[8] = {bflo(w[0].x), bfhi(w[0].x), bflo(w[0].y), bfhi(w[0].y), bflo(w[0].z), bfhi(w[0].z), bflo(w[0].w), bfhi(w[0].w)};
#pragma unroll
        for (int st = 1; st < 16; ++st) { const int e = dir == 0 ? 1 + st : 16 - st;
            s[0] = gC * s[0] + bflo(w[st].x); s[1] = gC * s[1] + bfhi(w[st].x); s[2] = gC * s[2] + bflo(w[st].y); s[3] = gC * s[3] + bfhi(w[st].y);
            s[4] = gC * s[4] + bflo(w[st].z); s[5] = gC * s[5] + bfhi(w[st].z); s[6] = gC * s[6] + bflo(w[st].w); s[7] = gC * s[7] + bfhi(w[st].w);
            v4u o; o.x = pk2(s[0], s[1]); o.y = pk2(s[2], s[3]); o.z = pk2(s[4], s[5]); o.w = pk2(s[6], s[7]); *(v4u*)(base + (size_t)e * 512 * 768) = o; }
    }
}

__device__ __forceinline__ void rt6_finish(const v4u (&w)[4], const v4u (&gw)[4], bf16* o, size_t r, int lane) {
#pragma unroll
    for (int c = 0; c < 4; ++c) { const size_t off = r * 2048 + (size_t)(c * 64 + lane) * 8;
        float v[8] = {bflo(w[c].x), bfhi(w[c].x), bflo(w[c].y), bfhi(w[c].y), bflo(w[c].z), bfhi(w[c].z), bflo(w[c].w), bfhi(w[c].w)};
        float g[8] = {bflo(gw[c].x), bfhi(gw[c].x), bflo(gw[c].y), bfhi(gw[c].y), bflo(gw[c].z), bfhi(gw[c].z), bflo(gw[c].w), bfhi(gw[c].w)};
        float s = 0.f;
#pragma unroll
        for (int x = 0; x < 8; ++x) s += v[x] * v[x];
        const float rstd = 1.0f / sqrtf(wave_sum(s) * (1.f / 512.f) + EPS);
#pragma unroll
        for (int x = 0; x < 8; ++x) v[x] = v[x] * rstd * g[x] * fast_sigmoid(g[x]);
        v4u ow; ow.x = pk2(v[0], v[1]); ow.y = pk2(v[2], v[3]); ow.z = pk2(v[4], v[5]); ow.w = pk2(v[6], v[7]); *(v4u*)(o + off) = ow; }
}
__device__ __forceinline__ void p_rt6(const Ctx& C) {
    bf16* o = (bf16*)(((unsigned char*)C.p(26)) + WS_ARENA + AR_O); const bf16* gate = (const bf16*)(((unsigned char*)C.p(26)) + WS_ARENA + AR_GATE);
    for (int rlA = C.gw; rlA < TL; rlA += 2 * C.NGW) { const int rlB = rlA + C.NGW; const bool hasB = rlB < TL;
        const size_t rA = (size_t)(rlA >> 12) * LE + CTX + (rlA & 4095); const int rlb = hasB ? rlB : rlA; const size_t rB = (size_t)(rlb >> 12) * LE + CTX + (rlb & 4095);
        v4u wA[4], gA[4], wB[4], gB[4];
#pragma unroll
        for (int c = 0; c < 4; ++c) { const size_t oa = rA * 2048 + (size_t)(c * 64 + C.lane) * 8, ob = rB * 2048 + (size_t)(c * 64 + C.lane) * 8;
            wA[c] = *(const v4u*)(o + oa); gA[c] = *(const v4u*)(gate + oa); wB[c] = *(const v4u*)(o + ob); gB[c] = *(const v4u*)(gate + ob); }
        rt6_finish(wA, gA, o, rA, C.lane);
        if (hasB) rt6_finish(wB, gB, o, rB, C.lane);
    }
}

__device__ __forceinline__ void p_m1(const Ctx& C) {
    const bf16* mi = (const bf16*)(((unsigned char*)C.p(26)) + WS_ARENA + AR_MLAIN); bf16* mn = (bf16*)(((unsigned char*)C.p(26)) + WS_ARENA + AR_MLAN);
    for (int r0 = C.gw; r0 < TE; r0 += 4 * C.NGW) {
        unsigned w[4][5];
#pragma unroll
        for (int q = 0; q < 4; ++q) { const int r = r0 + q * C.NGW; const unsigned* src = (const unsigned*)(mi + (size_t)(r < TE ? r : r0) * 768);
#pragma unroll
            for (int i = 0; i < 5; ++i) w[q][i] = src[C.lane + 64 * i]; }
#pragma unroll
        for (int q = 0; q < 4; ++q) { const int r = r0 + q * C.NGW; float sq = 0.f, sk = 0.f;
#pragma unroll
            for (int i = 0; i < 5; ++i) { const float a = bflo(w[q][i]), b = bfhi(w[q][i]); if (i < 3) sq += a * a + b * b; else sk += a * a + b * b; }
            const float rq = 1.0f / sqrtf(wave_sum(sq) * (1.f / 384.f) + EPS), rk = 1.0f / sqrtf(wave_sum(sk) * (1.f / 256.f) + EPS);
            if (r < TE) { unsigned* dst = (unsigned*)(mn + (size_t)r * 640);
#pragma unroll
                for (int i = 0; i < 5; ++i) { const float sc = i < 3 ? rq : rk; dst[C.lane + 64 * i] = pk2(bflo(w[q][i]) * sc, bfhi(w[q][i]) * sc); } } }
    }
}
__device__ __forceinline__ void build_ptab(const Ctx& C, const unsigned* cnt) {
    volatile LAS int* T = (volatile LAS int*)(C.lds + MISC_OFF);
    __syncthreads();
    if (C.tid < NEXP) { const int c = (int)__hip_atomic_load(cnt + C.tid, RLX_AGENT); T[672 + C.tid] = c; T[640 + C.tid] = (c + 255) >> 8; }
    __syncthreads();
    if (C.tid < NEXP) { int acc = 0; for (int e = 0; e < C.tid; ++e) acc += T[640 + e]; const int np = T[640 + C.tid];
        T[16 + C.tid] = acc; for (int p = 0; p < np; ++p) T[64 + acc + p] = C.tid; if (C.tid == NEXP - 1) T[16 + NEXP] = acc + np; }
    __syncthreads();
}
#define LX1(v) __builtin_bit_cast(float, __builtin_amdgcn_update_dpp(0, __builtin_bit_cast(int, (v)), 0xB1, 0xF, 0xF, true))
#define LX2(v) __builtin_bit_cast(float, __builtin_amdgcn_update_dpp(0, __builtin_bit_cast(int, (v)), 0x4E, 0xF, 0xF, true))
#define LX8(v) __builtin_bit_cast(float, __builtin_amdgcn_update_dpp(0, __builtin_bit_cast(int, (v)), 0x128, 0xF, 0xF, true))
#define LX4(v) SWZ_XOR((v), 4)
#define LX16(v) SWZ_XOR((v), 16)
__device__ __forceinline__ float reduce32_transposed(const float (&L)[32], int lane) {
    float M[16], N[8], P[4], Q[2];
#pragma unroll
    for (int e = 0; e < 16; ++e) { unsigned a_ = __builtin_bit_cast(unsigned, L[e]), b_ = __builtin_bit_cast(unsigned, L[e + 16]);
        auto rr = __builtin_amdgcn_permlane32_swap(a_, b_, false, false); unsigned r0_ = rr[0], r1_ = rr[1]; asm volatile("" : "+v"(r0_), "+v"(r1_));
        M[e] = __builtin_bit_cast(float, r0_) + __builtin_bit_cast(float, r1_); }
    const bool b3 = (lane & 8) != 0, b2 = (lane & 4) != 0, b1 = (lane & 2) != 0;
#pragma unroll
    for (int e = 0; e < 8; ++e) { unsigned a_ = __builtin_bit_cast(unsigned, M[e]), b_ = __builtin_bit_cast(unsigned, M[e + 8]);
        auto rr = __builtin_amdgcn_permlane16_swap(a_, b_, false, false); unsigned r0_ = rr[0], r1_ = rr[1]; asm volatile("" : "+v"(r0_), "+v"(r1_));
        N[e] = __builtin_bit_cast(float, r0_) + __builtin_bit_cast(float, r1_); }
#pragma unroll
    for (int e = 0; e < 4; ++e) { const float snd = b3 ? N[e] : N[e + 4]; P[e] = (b3 ? N[e + 4] : N[e]) + LX8(snd); }
#pragma unroll
    for (int e = 0; e < 2; ++e) { const float snd = b2 ? P[e] : P[e + 2]; Q[e] = (b2 ? P[e + 2] : P[e]) + LX4(snd); }
    const float snd = b1 ? Q[0] : Q[1]; float R = (b1 ? Q[1] : Q[0]) + LX2(snd);
    R += LX1(R);
    return R;
}
__device__ __forceinline__ void e1_route_t(float v, int ridx0, bool hasB, int lane, LAS unsigned* lcnt, LAS unsigned* rec) {
    int se[4]; float sv[4]; const unsigned myi = (unsigned)lane >> 1;
    const unsigned kb = __builtin_bit_cast(unsigned, v); unsigned key = kb ^ ((unsigned)((int)kb >> 31) | 0x80000000u);
#define UX2(x) ((unsigned)__builtin_amdgcn_update_dpp(0, (int)(x), 0x4E, 0xF, 0xF, true))
#define UX8(x) ((unsigned)__builtin_amdgcn_update_dpp(0, (int)(x), 0x128, 0xF, 0xF, true))
#define UX4(x) ((unsigned)__builtin_amdgcn_update_dpp(0, __builtin_amdgcn_update_dpp(0, (int)(x), 0x141, 0xF, 0xF, true), 0x1B, 0xF, 0xF, true))
#define USWAP(x, OP, BI) { unsigned a_ = (x), b_ = a_; asm volatile("" : "+v"(b_)); auto rr = BI(a_, b_, false, false); unsigned r0_ = rr[0], r1_ = rr[1]; asm volatile("" : "+v"(r0_), "+v"(r1_)); (x) = OP(r0_, r1_); }
#define UMAX(a, b) ((a) > (b) ? (a) : (b))
#define UMIN(a, b) ((a) < (b) ? (a) : (b))
#pragma unroll
    for (int k = 0; k < 4; ++k) { unsigned mk = key;
        { const unsigned o = UX2(mk); mk = UMAX(mk, o); } { const unsigned o = UX4(mk); mk = UMAX(mk, o); } { const unsigned o = UX8(mk); mk = UMAX(mk, o); }
        USWAP(mk, UMAX, __builtin_amdgcn_permlane16_swap) USWAP(mk, UMAX, __builtin_amdgcn_permlane32_swap)
        unsigned ci = key == mk ? myi : 64u;
        { const unsigned o = UX2(ci); ci = UMIN(ci, o); } { const unsigned o = UX4(ci); ci = UMIN(ci, o); } { const unsigned o = UX8(ci); ci = UMIN(ci, o); }
        USWAP(ci, UMIN, __builtin_amdgcn_permlane16_swap) USWAP(ci, UMIN, __builtin_amdgcn_permlane32_swap)
        se[k] = (int)ci; sv[k] = __builtin_bit_cast(float, mk ^ ((mk >> 31) ? 0x80000000u : 0xFFFFFFFFu)); if (myi == ci) key = 0u; }
#undef UX2
#undef UX8
#undef UX4
#undef USWAP
#undef UMAX
#undef UMIN
    const float L2E = 1.4426950408889634f; const float e1 = __builtin_amdgcn_exp2f((sv[1] - sv[0]) * L2E), e2 = __builtin_amdgcn_exp2f((sv[2] - sv[0]) * L2E), e3 = __builtin_amdgcn_exp2f((sv[3] - sv[0]) * L2E); const float inv = __builtin_amdgcn_rcpf(1.0f + e1 + e2 + e3);
    const float gt[4] = {inv, e1 * inv, e2 * inv, e3 * inv};
    if (lane < 8 && (hasB || (lane & 1) == 0)) { const int k = lane >> 1, ridx = ridx0 + (lane & 1); const int e = k == 0 ? se[0] : k == 1 ? se[1] : k == 2 ? se[2] : se[3]; const float gk = k == 0 ? gt[0] : k == 1 ? gt[1] : k == 2 ? gt[2] : gt[3];
        const unsigned pos = __hip_atomic_fetch_add(lcnt + e, 1u, __ATOMIC_RELAXED, __HIP_MEMORY_SCOPE_WORKGROUP);
        LAS unsigned* rp = rec + (ridx * 4 + k) * 3; rp[0] = (unsigned)e; rp[1] = pos; rp[2] = __builtin_bit_cast(unsigned, gk); }
}
__device__ __forceinline__ void e1_route(const float (&lgt)[32], int ridx, int lane, LAS unsigned* lcnt, LAS unsigned* rec) {
    int se[4]; float sv[4];
#pragma unroll
    for (int k = 0; k < 4; ++k) { float best = -3.0e38f; int bi = 0;
#pragma unroll
        for (int e = 0; e < 32; ++e) { const bool taken = (k > 0 && se[0] == e) || (k > 1 && se[1] == e) || (k > 2 && se[2] == e); if (!taken && lgt[e] > best) { best = lgt[e]; bi = e; } }
        se[k] = bi; sv[k] = best; }
    const float e1 = expf(sv[1] - sv[0]), e2 = expf(sv[2] - sv[0]), e3 = expf(sv[3] - sv[0]); const float inv = 1.0f / (1.0f + e1 + e2 + e3);
    const float gt[4] = {inv, e1 * inv, e2 * inv, e3 * inv};
    if (lane < 4) { const int k = lane; const int e = k == 0 ? se[0] : k == 1 ? se[1] : k == 2 ? se[2] : se[3]; const float gk = k == 0 ? gt[0] : k == 1 ? gt[1] : k == 2 ? gt[2] : gt[3];
        const unsigned pos = __hip_atomic_fetch_add(lcnt + e, 1u, __ATOMIC_RELAXED, __HIP_MEMORY_SCOPE_WORKGROUP);
        LAS unsigned* rp = rec + (ridx * 4 + k) * 3; rp[0] = (unsigned)e; rp[1] = pos; rp[2] = __builtin_bit_cast(unsigned, gk); }
}
__device__ __forceinline__ void e1_rawload(v2u (&raw)[4], const float* x1, int grp, int tl, int lane) {
    const int bl = tl >> 12, b = grp * NBM + bl; const size_t tok = (size_t)b * SEQ + (tl & 4095);
#pragma unroll
    for (int j = 0; j < 4; ++j) raw[j] = *(const v2u*)((const bf16*)(x1 + tok * 1024) + 4 * lane + 256 * j);
}
struct E1Par { f32x4 gs[4], sha[4]; };
__device__ __forceinline__ void e1_params(E1Par& P, const float* g2, const float* ada, int grp, int tl, int lane) {
    const int bl = tl >> 12, b = grp * NBM + bl;
    const float* mod = ada + (size_t)b * 6144 + 3072;
    f32x4 ga[4], sca[4];
#pragma unroll
    for (int j = 0; j < 4; ++j) { const int c = 4 * lane + 256 * j; ga[j] = *(const f32x4*)(g2 + c); sca[j] = *(const f32x4*)(mod + 1024 + c); P.sha[j] = *(const f32x4*)(mod + c); }
#pragma unroll
    for (int j = 0; j < 4; ++j) P.gs[j] = ga[j] * (sca[j] + 1.0f);
}
__device__ __forceinline__ void e1_row(f32x4 (&v)[4], const v2u (&raw)[4], const E1Par& P, bf16* h2, int tl, int lane) {
    float s = 0.f;
#pragma unroll
    for (int j = 0; j < 4; ++j) { const v2u w = raw[j]; v[j] = (f32x4){bflo(w.x), bfhi(w.x), bflo(w.y), bfhi(w.y)}; s += (v[j].x * v[j].x + v[j].y * v[j].y) + (v[j].z * v[j].z + v[j].w * v[j].w); }
    const float rstd = __builtin_amdgcn_rsqf(wave_sum(s) * (1.f / D) + EPS);
#pragma unroll
    for (int j = 0; j < 4; ++j) { const int c = 4 * lane + 256 * j;
        v[j] = (v[j] * rstd) * P.gs[j] + P.sha[j];
        v2u w; w.x = cvt_pk_bf16(v[j].x, v[j].y); w.y = cvt_pk_bf16(v[j].z, v[j].w); *(v2u*)(h2 + (size_t)tl * 1024 + c) = w; }
}
__device__ __forceinline__ void p_e1(const Ctx& C, int grp) {
    const float* x1 = ((float*)C.p(25)); const float* g2 = ((const float*)C.p(5)); const float* ada = (const float*)(((unsigned char*)C.p(26)) + WS_ADA); const float* rwg = ((const float*)C.p(18)); const float* rb = ((const float*)C.p(19));
    bf16* h2 = (bf16*)(((unsigned char*)C.p(26)) + WS_ARENA + AR_H2); int* sel = (int*)(((unsigned char*)C.p(26)) + WS_ARENA + AR_SEL);
    unsigned* cnt = (unsigned*)(((unsigned char*)C.p(26)) + WS_CTL) + CW_CNT + grp * 64;
    LAS float* rw = (LAS float*)C.lds;
    LAS unsigned* lcnt = (LAS unsigned*)(C.lds + MISC_OFF + MISC_LCNT);
    LAS unsigned* rec = (LAS unsigned*)(C.lds + MISC_OFF + 8192);
    if (C.tid < 32) lcnt[C.tid] = 0u;
    { f32x4 rv[16];
#pragma unroll
      for (int i = 0; i < 16; ++i) rv[i] = *(const f32x4*)(rwg + (size_t)(C.tid + 512 * i) * 4);
#pragma unroll
      for (int i = 0; i < 16; ++i) { const int q = C.tid + 512 * i, k = q >> 3, eg = q & 7; const int l = (k & 255) >> 2, j = k >> 8, c = k & 3; *(LAS f32x4*)(rw + (((j * 4 + c) * 8 + eg) * 64 + l) * 4) = rv[i]; } }
    __syncthreads();
    const int tl0 = C.gw * 16; const bool live = tl0 < TLM && 16 * 8 * C.G >= TLM;
    E1Par P; e1_params(P, g2, ada, grp, live ? tl0 : 0, C.lane);
    const float be = rb[C.lane >> 1];
    v2u rawA[4], rawB[4];
    e1_rawload(rawA, x1, grp, live ? tl0 : 0, C.lane); e1_rawload(rawB, x1, grp, live ? tl0 + 1 : 0, C.lane);
    for (int trip = 0; live && trip < 8; ++trip) {
        const int tlA = tl0 + 2 * trip, tlB = tlA + 1; const bool hasB = true;
        f32x4 vA[4], vB[4]; v2u nxA[4], nxB[4];
        { const int nA = trip < 7 ? tlA + 2 : tlA;
          e1_rawload(nxA, x1, grp, nA, C.lane); e1_rawload(nxB, x1, grp, nA + 1, C.lane); }
        e1_row(vA, rawA, P, h2, tlA, C.lane);
        e1_row(vB, rawB, P, h2, tlB, C.lane);
        float lgA[32], lgB[32];
        { f32x4 rb0[8], rb1[8];
#define E1_LD8(buf, eg, h) _Pragma("unroll") for (int k = 0; k < 8; ++k) buf[k] = *(const LAS f32x4*)(rw + ((((h) * 8 + k) * 8 + (eg)) * 64 + C.lane) * 4);
#define E1_FM8(buf, h) _Pragma("unroll") for (int k = 0; k < 8; ++k) { const int kk = (h) * 8 + k; const float a_ = vA[kk >> 2][kk & 3], b_ = vB[kk >> 2][kk & 3];                  \
            const f32x2 r01 = {buf[k].x, buf[k].y}, r23 = {buf[k].z, buf[k].w}, a2 = {a_, a_}, b2 = {b_, b_};                                                                   \
            if (kk == 0) { aA0 = a2 * r01; aA1 = a2 * r23; aB0 = b2 * r01; aB1 = b2 * r23; }                                                                                   \
            else { aA0 = __builtin_elementwise_fma(a2, r01, aA0); aA1 = __builtin_elementwise_fma(a2, r23, aA1); aB0 = __builtin_elementwise_fma(b2, r01, aB0); aB1 = __builtin_elementwise_fma(b2, r23, aB1); } }
          E1_LD8(rb0, 0, 0)
#pragma unroll
          for (int eg = 0; eg < 8; ++eg) { f32x2 aA0, aA1, aB0, aB1;
              E1_LD8(rb1, eg, 1) __builtin_amdgcn_sched_barrier(0);
              E1_FM8(rb0, 0) __builtin_amdgcn_sched_barrier(0);
              if (eg < 7) { E1_LD8(rb0, eg + 1, 0) } __builtin_amdgcn_sched_barrier(0);
              E1_FM8(rb1, 1) __builtin_amdgcn_sched_barrier(0);
              lgA[eg * 4 + 0] = aA0.x; lgA[eg * 4 + 1] = aA0.y; lgA[eg * 4 + 2] = aA1.x; lgA[eg * 4 + 3] = aA1.y;
              lgB[eg * 4 + 0] = aB0.x; lgB[eg * 4 + 1] = aB0.y; lgB[eg * 4 + 2] = aB1.x; lgB[eg * 4 + 3] = aB1.y; }
#undef E1_LD8
#undef E1_FM8
        }
        {
          const float vA1 = reduce32_transposed(lgA, C.lane) + be, vB1 = reduce32_transposed(lgB, C.lane) + be;
          e1_route_t((C.lane & 1) ? vB1 : vA1, C.wave * 16 + 2 * trip, hasB, C.lane, lcnt, rec); }
#pragma unroll
        for (int j = 0; j < 4; ++j) { rawA[j] = nxA[j]; rawB[j] = nxB[j]; }
    }
    __syncthreads();
    if (C.tid < 32) lcnt[32 + C.tid] = __hip_atomic_fetch_add(cnt + C.tid, lcnt[C.tid], RLX_AGENT);
    __syncthreads();
    { const int i = C.tid, w = i >> 6, t = (i >> 2) & 15, k = i & 3; const int tl = ((int)blockIdx.x * 8 + w) * 16 + t;
      if (tl < TLM && 16 * 8 * C.G >= TLM) {
          const unsigned e = rec[i * 3], lp = rec[i * 3 + 1]; const float gk = __builtin_bit_cast(float, rec[i * 3 + 2]);
          const unsigned posg = lcnt[32 + e] + lp, d = e * (unsigned)TLM + posg;
          float* rowg = (float*)(((unsigned char*)C.p(26)) + WS_ARENA + AR_ROWG); unsigned short* rowtok = (unsigned short*)(((unsigned char*)C.p(26)) + WS_ARENA + AR_ROWTOK);
          rowtok[(d & ~127u) + 2 * (d & 63u) + ((d >> 6) & 1u)] = (unsigned short)tl; rowg[d] = gk; sel[(size_t)TLM * 12 + (size_t)tl * 4 + k] = (int)(e | (posg << 8)); } }
    if (blockIdx.x == 0 && C.tid < 128) { unsigned zz = 0u; asm volatile("" : "+v"(zz)); ((v4u*)(h2 + (size_t)TLM * 1024))[C.tid] = (v4u){zz, zz, zz, zz}; }
    __syncthreads();
}
typedef int i32x4 __attribute__((ext_vector_type(4)));
__device__ __forceinline__ void e5_load(f32x4 (&v)[4], const float* out, const float* ada, const bf16* ys, const i32x4 rec4, const volatile LAS int* T, int grp, int tl, int lane) {
    const int bl = tl >> 12, b = grp * NBM + bl; const size_t tok = (size_t)b * SEQ + (tl & 4095);
    const float* g2v = ada + (size_t)b * 6144 + 5120;
    i32x4 d4;
#pragma unroll
    for (int k = 0; k < 4; ++k) d4[k] = T[16 + (rec4[k] & 255)] * 256 + (int)((unsigned)rec4[k] >> 8);
#pragma unroll
    for (int j = 0; j < 2; ++j) { const int c = 8 * lane + 512 * j; f32x4 m0 = (f32x4){0.f, 0.f, 0.f, 0.f}, m1 = m0;
#pragma unroll
        for (int k = 0; k < 4; ++k) { const v4u w = __builtin_nontemporal_load((const v4u*)(ys + (size_t)d4[k] * 1024 + c));
            m0 += (f32x4){bflo(w.x), bfhi(w.x), bflo(w.y), bfhi(w.y)}; m1 += (f32x4){bflo(w.z), bfhi(w.z), bflo(w.w), bfhi(w.w)}; }
        const v4u xw = *(const v4u*)((const bf16*)(out + tok * 1024) + c);
        v[2 * j] = (f32x4){bflo(xw.x), bfhi(xw.x), bflo(xw.y), bfhi(xw.y)} + *(const f32x4*)(g2v + c) * m0;
        v[2 * j + 1] = (f32x4){bflo(xw.z), bfhi(xw.z), bflo(xw.w), bfhi(xw.w)} + *(const f32x4*)(g2v + c + 4) * m1; }
}
__device__ __forceinline__ void e5_store(const f32x4 (&v)[4], float* out, const f32x4 (&fga)[4], int grp, int tl, int lane) {
    const int bl = tl >> 12, b = grp * NBM + bl; const size_t tok = (size_t)b * SEQ + (tl & 4095);
    float s = 0.f;
#pragma unroll
    for (int j = 0; j < 4; ++j) s += (v[j].x * v[j].x + v[j].y * v[j].y) + (v[j].z * v[j].z + v[j].w * v[j].w);
    const float rstd = 1.0f / sqrtf(wave_sum(s) * (1.f / D) + EPS);
#pragma unroll
    for (int j = 0; j < 4; ++j) { const int c = 8 * lane + 512 * (j >> 1) + 4 * (j & 1); __builtin_nontemporal_store(v[j] * rstd * fga[j], (f32x4*)(out + tok * 1024 + c)); }
}
__device__ __forceinline__ void p_e5(const Ctx& C, int grp) {
    float* out = ((float*)C.p(25)); const float* ada = (const float*)(((unsigned char*)C.p(26)) + WS_ADA); const float* fg = ((const float*)C.p(24));
    const bf16* ys = (const bf16*)(((unsigned char*)C.p(26)) + WS_ARENA + AR_XS); const int* sel = (const int*)(((unsigned char*)C.p(26)) + WS_ARENA + AR_SEL);
    build_ptab(C, (const unsigned*)(((unsigned char*)C.p(26)) + WS_CTL) + CW_CNT + grp * 64);
    const volatile LAS int* T = (const volatile LAS int*)(C.lds + MISC_OFF);
    f32x4 fga[4];
#pragma unroll
    for (int j = 0; j < 4; ++j) fga[j] = *(const f32x4*)(fg + 8 * C.lane + 512 * (j >> 1) + 4 * (j & 1));
    const int* dsel = sel + (size_t)TLM * 12;
    i32x4 dA = {0, 0, 0, 0}, dB = {0, 0, 0, 0};
    if (C.gw < TLM) { dA = *(const i32x4*)(dsel + (size_t)C.gw * 4); const int tb = C.gw + C.NGW; dB = *(const i32x4*)(dsel + (size_t)(tb < TLM ? tb : C.gw) * 4); }
    for (int tlA = C.gw; tlA < TLM; tlA += 2 * C.NGW) {
        const int tlB = tlA + C.NGW; const bool hasB = tlB < TLM;
        f32x4 vA[4], vB[4];
        e5_load(vA, out, ada, ys, dA, T, grp, tlA, C.lane);
        if (hasB) e5_load(vB, out, ada, ys, dB, T, grp, tlB, C.lane);
        { const int nA = tlA + 2 * C.NGW, nB = nA + C.NGW; if (nA < TLM) { dA = *(const i32x4*)(dsel + (size_t)nA * 4); dB = *(const i32x4*)(dsel + (size_t)(nB < TLM ? nB : nA) * 4); } }
        e5_store(vA, out, fga, grp, tlA, C.lane);
        if (hasB) e5_store(vB, out, fga, grp, tlB, C.lane);
    }
}
#ifndef PH_MASK
#define PH_MASK 0xFFFFFFFFu
#endif
#define EN(k) ((PH_MASK >> (k)) & 1u)
constexpr int NM = 8, NE = 4, NSGS = 2 * NM + NE, NSTEPS = 1 + NSG * NSGS;
#ifndef MK_ONE_LAUNCH
#define MK_ONE_LAUNCH 1
#endif

__global__ void __launch_bounds__(512, 2) fwd_kernel(Params P) {
    extern __shared__ __attribute__((aligned(16))) unsigned char lds_raw[];
    Ctx C; C.lds = (LAS unsigned char*)lds_raw; C.tid = threadIdx.x; C.lane = C.tid & 63; C.wave = __builtin_amdgcn_readfirstlane(C.tid >> 6);
    C.G = gridDim.x; C.gw = blockIdx.x * 8 + C.wave; C.NGW = C.G * 8; int wave_s = C.wave;
    volatile LAS unsigned* MISC = (volatile LAS unsigned*)(C.lds + MISC_OFF);
    if (C.tid < 4) MISC[C.tid] = 0u;
    if (C.tid == 0) { volatile LAS unsigned long long* PT = (volatile LAS unsigned long long*)(C.lds + MISC_OFF + MISC_PT);
#pragma unroll
        for (int i = 0; i < 25; ++i) PT[i] = (unsigned long long)P.in[i];
        PT[25] = (unsigned long long)P.out; PT[26] = (unsigned long long)P.ws; }
    __syncthreads();
    const int lo = P.ph_lo, hi = P.ph_hi;
    if (hi - lo > 1) (void)xcd_barrier_post((unsigned*)((unsigned char*)C.p(26) + WS_CTL) + CW_BAR, MISC);
#define IN(k) (lo <= (k) && (k) < hi)
#define NOCONT pg8::Cont{nullptr, nullptr, 0, 0}
#define OPAQ() { int l_; asm volatile("v_mbcnt_lo_u32_b32 %0, -1, 0\n\tv_mbcnt_hi_u32_b32 %0, -1, %0" : "=v"(l_)); asm volatile("" : "+s"(wave_s)); \
      C.lane = l_; C.wave = wave_s; C.tid = wave_s * 64 + l_; C.gw = blockIdx.x * 8 + wave_s; } \
    unsigned char* ws = (unsigned char*)C.p(26); unsigned char* ar = ws + WS_ARENA; (void)ar; \
    const float2* tabr = (const float2*)(ws + WS_TABR); const float2* tabm = (const float2*)(ws + WS_TABM); const float* lg = (const float*)(ws + WS_LG); (void)tabr; (void)tabm; (void)lg
#define SEAM(k) do { if (IN((k) + 1)) { XcdBarrier b2_; b2_.bar = (unsigned*)((unsigned char*)C.p(26) + WS_CTL) + CW_BAR; b2_.x = xb_xcc_id(); b2_.st = MISC; xcd_barrier(b2_, wave_s * 64 + lane_id_asm()); } } while (0)
    LAS unsigned char* ring = C.lds;
    const int G = C.G, cb = (int)blockIdx.x;

    if (EN(0) && IN(0)) { OPAQ(); p0_weights(C); __syncthreads(); p0_ada(C); SEAM(0); }

    for (int sg = 0; sg < NSG; ++sg) {
      const int b0 = 1 + sg * NSGS;
      if (hi <= b0 || lo >= b0 + NSGS) continue;
      for (int gi = 0; gi < 2; ++gi) {
        const int grp = sg * 2 + gi, s0 = b0 + gi * NM;
        if (hi <= s0 || lo >= s0 + NM) continue;
        if (EN(1) && grp == 0 && IN(s0 + 0)) { OPAQ(); p1_hext(C, grp); SEAM(s0 + 0); }
        if (EN(2) && IN(s0 + 1)) { OPAQ();
            { SchedGAV S{(const char*)(ar + AR_H), (const char*)(ws + WS_WIN), G, cb};
              EpiGAV E{EpiGA{(bf16*)(ar + AR_Q), (bf16*)(ar + AR_K), (bf16*)(ar + AR_ACAT), (bf16*)(ar + AR_MLAIN), tabr, tabm, lg, (float*)(ar + AR_SSQ)}, EpiStore<LocGV>{LocGV{(bf16*)(ar + AR_BCAT)}}};
              pg8::gemm_phase<EpiGAV, SchedGAV, 1024, 1024, 16>(ring, S, E, wave_s); }
            SEAM(s0 + 1); }
        if (EN(3) && IN(s0 + 2)) { OPAQ();
            const int gemm_first = (cb >> 3) & 1;
#pragma unroll 1
            for (int half = 0; half < 2; ++half) {
                int do_gemm = (half ^ gemm_first) ^ 1; asm volatile("" : "+s"(do_gemm));
                if (!do_gemm) { int l_; asm volatile("v_mbcnt_lo_u32_b32 %0, -1, 0\n\tv_mbcnt_hi_u32_b32 %0, -1, %0" : "=v"(l_)); C.lane = l_; C.tid = wave_s * 64 + l_; p_kt2(C); }
                else {
                       Sched2D<true, false> S2{(const char*)(ar + AR_H), (const char*)(ws + WS_WIN + (size_t)WIN_GATE * 1024 * 2), (size_t)256 * 1024 * 2, (size_t)256 * 1024 * 2, TL / 256, 8, G, cb};
                       pg8::Unit nu; const bool hn = S2.next(0, nu); bool ps;
                       { SchedRT4 S{(const char*)(ar + AR_Q), (const char*)(ar + AR_K), G, cb}; EpiRT4 E{(bf16*)(ar + AR_ACAT), lg};
                         ps = pg8::gemm_phase<EpiRT4, SchedRT4, 1024, 1024, 4>(ring, S, E, wave_s, hn ? pg8::Cont{nu.a, nu.b, 1024, 1024} : NOCONT); }
                       { EpiStore<LocGB> E{LocGB{(bf16*)(ar + AR_GATE), (bf16*)(ar + AR_GRET), (bf16*)(ar + AR_GMLA)}};
                         pg8::gemm_phase<EpiStore<LocGB>, Sched2D<true, false>, 1024, 1024, 16>(ring, S2, E, wave_s, NOCONT, ps); } }
                __syncthreads();
            }
            SEAM(s0 + 2); }
        if (EN(4) && IN(s0 + 3)) { OPAQ();
            Sched2D<true, false> SM2{(const char*)(ar + AR_MLAIN), (const char*)(ws + WS_WUQ), (size_t)256 * 768 * 2, (size_t)256 * 384 * 2, TL / 256, 6, G, cb};
            Sched2D<false, false> SM3{(const char*)(ar + AR_MLAIN) + 384 * 2, (const char*)(ws + WS_WUKV), (size_t)256 * 768 * 2, (size_t)256 * 256 * 2, TE / 256, 8, G, G == 256 ? ((cb + 128) & 255) : cb};
            pg8::Unit nu2, nu3; const bool hn2 = SM2.next(0, nu2), hn3 = SM3.next(0, nu3); bool ps2, ps3;
            { SchedRT2 S{(const char*)(ar + AR_BCAT), (const char*)(ar + AR_KT2), G, cb}; EpiStore<LocRT2> E{LocRT2{(bf16*)(ar + AR_BCAT)}};
              ps2 = pg8::gemm_phase<EpiStore<LocRT2>, SchedRT2, 768, 256, 4>(ring, S, E, wave_s, hn2 ? pg8::Cont{nu2.a, nu2.b, 768, 384} : NOCONT); }
            { EpiM2 E{(bf16*)(ar + AR_QMLA), tabm, (const float*)(ar + AR_SSQ)};
              ps3 = pg8::gemm_phase<EpiM2, Sched2D<true, false>, 768, 384, 6>(ring, SM2, E, wave_s, hn3 ? pg8::Cont{nu3.a, nu3.b, 768, 256} : NOCONT, ps2); }
            { const Sched2D<false, false>& S = SM3;
              EpiM3 E{(bf16*)(ar + AR_KVMLA), (const float*)(ar + AR_SSQ)};
              pg8::gemm_phase<EpiM3, Sched2D<false, false>, 768, 256, 4>(ring, S, E, wave_s, NOCONT, ps3); }
            SEAM(s0 + 3); }
        if (EN(5) && IN(s0 + 4)) { OPAQ();
            const int att_first = (cb >> 3) & 1;
#pragma unroll 1
            for (int half = 0; half < 2; ++half) {
                int do_att = (half ^ att_first) ^ 1; asm volatile("" : "+s"(do_att));
                if (!do_att) { int l_; asm volatile("v_mbcnt_lo_u32_b32 %0, -1, 0\n\tv_mbcnt_hi_u32_b32 %0, -1, %0" : "=v"(l_)); C.lane = l_; C.tid = wave_s * 64 + l_; p_scan(C); }
                else {
                    const bf16* qm = (const bf16*)(ar + AR_QMLA); const bf16* kv = (const bf16*)(ar + AR_KVMLA); const bf16* mi = (const bf16*)(ar + AR_MLAIN); bf16* ao = (bf16*)(ar + AR_ATTO);
                    for (int it0 = cb; it0 < NBG * 8 * 16; it0 += G) {
                        int it = it0; if (G == 256) { const int xcd = cb & 7, slot = cb >> 3, hp = (it0 >> 8) * 16 + xcd * 2 + (slot >> 4); it = hp * 16 + (slot & 15); }
                        const int qb = it & 15, h = (it >> 4) & 7, bl = it >> 7; const size_t rb = (size_t)bl * LE, rq = rb + CTX + qb * 256;
                        att::attn_body(qm + rq * 1536 + h * 192, kv + rb * 2048 + h * 256, mi + rb * 768 + 640, kv + rb * 2048 + h * 256 + 128, ao + rq * 1024 + h * 128, LE, (char*)lds_raw, wave_s);
                        __syncthreads(); }
                }
                __syncthreads();
            }
            SEAM(s0 + 4); }
        if (EN(6) && IN(s0 + 5)) { OPAQ();
            Sched2D<true, false> SG{(const char*)(ar + AR_H), (const char*)(ws + WS_WIN + (size_t)WIN_GATE * 1024 * 2), (size_t)256 * 1024 * 2, (size_t)256 * 1024 * 2, TL / 256, 8, G, cb, 8};
            pg8::Unit nu; const bool hn = SG.next(0, nu); bool ps;
            { SchedRT5 S{(const char*)(ar + AR_ACAT), (const char*)(ar + AR_BCAT), G, cb}; EpiRT5F E{(bf16*)(ar + AR_O), (const bf16*)(ar + AR_GATE), (float*)(ar + AR_SSQ)};
              ps = pg8::gemm_phase<EpiRT5F, SchedRT5, 3072, 768, 12>(ring, S, E, wave_s, hn ? pg8::Cont{nu.a, nu.b, 1024, 1024} : NOCONT); }
            { EpiStore<LocGB> E{LocGB{(bf16*)(ar + AR_GATE), (bf16*)(ar + AR_GRET), (bf16*)(ar + AR_GMLA)}};
              pg8::gemm_phase<EpiStore<LocGB>, Sched2D<true, false>, 1024, 1024, 16>(ring, SG, E, wave_s, NOCONT, ps); }
            SEAM(s0 + 5); }
        if (EN(8) && IN(s0 + 6)) { OPAQ();
            Sched2D<true, false> S2{(const char*)(ar + AR_ATTO), (const char*)(ws + WS_WBM), (size_t)256 * 1024 * 2, (size_t)256 * 1024 * 2, TL / 256, 4, G, cb};
            pg8::Unit nu; const bool hn = S2.next(0, nu); bool ps;
            { Sched2D<true, false> S{(const char*)(ar + AR_O), (const char*)(ws + WS_WBR), (size_t)256 * 2048 * 2, (size_t)256 * 2048 * 2, TL / 256, 4, G, cb};
              EpiG1 E{(const bf16*)(ar + AR_GRET), (bf16*)(ar + AR_T1), (const float*)(ar + AR_SSQ)};
              ps = pg8::gemm_phase<EpiG1, Sched2D<true, false>, 2048, 2048, 32>(ring, S, E, wave_s, hn ? pg8::Cont{nu.a, nu.b, 1024, 1024} : NOCONT); }
            asm volatile("s_waitcnt vmcnt(0)" ::: "memory");
            { EpiGate<true> E{(const bf16*)(ar + AR_GMLA), (const bf16*)(ar + AR_T1), (bf16*)(ar + AR_MERGED)};
              pg8::gemm_phase<EpiGate<true>, Sched2D<true, false>, 1024, 1024, 16>(ring, S2, E, wave_s, NOCONT, ps); }
            SEAM(s0 + 6); }
        if (EN(9) && IN(s0 + 7)) { OPAQ();
            const int gemm_first = (cb >> 3) & 1;
#pragma unroll 1
            for (int half = 0; half < 2; ++half) {
                int do_gemm = (half ^ gemm_first) ^ 1; asm volatile("" : "+s"(do_gemm));
                if (do_gemm) {
                    Sched2D<true, false> S{(const char*)(ar + AR_MERGED), (const char*)(ws + WS_WO), (size_t)256 * 1024 * 2, (size_t)256 * 1024 * 2, TL / 256, 4, G, cb};
                    EpiG3 E{((const float*)C.p(0)), (const float*)(ws + WS_ADA), ((float*)C.p(25)), grp * NBG};
                    pg8::gemm_phase<EpiG3, Sched2D<true, false>, 1024, 1024, 16>(ring, S, E, wave_s); }
                else if (gi == 0) { int l_; asm volatile("v_mbcnt_lo_u32_b32 %0, -1, 0\n\tv_mbcnt_hi_u32_b32 %0, -1, %0" : "=v"(l_)); C.lane = l_; C.tid = wave_s * 64 + l_; p1_hext(C, grp + 1); }
                __syncthreads();
            }
            SEAM(s0 + 7); }
      }
      const int e0 = b0 + 2 * NM;
      if (EN(12) && IN(e0 + 0)) { OPAQ(); p_e1(C, sg); SEAM(e0 + 0); }
      if (EN(14) && IN(e0 + 1)) { OPAQ();
          const unsigned* cnt = (const unsigned*)(ws + WS_CTL) + CW_CNT + sg * 64; build_ptab(C, cnt);
          volatile LAS int* T = (volatile LAS int*)(C.lds + MISC_OFF);
          SchedMoEG S{(const char*)(ar + AR_H2), (const unsigned short*)(ar + AR_ROWTOK), (const char*)(ws + WS_WGU), (size_t)2048 * 1024 * 2, T + 64, T[16 + NEXP], G, cb, TLM};
          EpiE3 E{(bf16*)(ar + AR_ACT), ((const float*)C.p(21))};
          pg8::gemm_phase<EpiE3, SchedMoEG, 1024, 1024, 16, true, true>(ring, S, E, wave_s);
          SEAM(e0 + 1); }
      if (EN(15) && IN(e0 + 2)) { OPAQ();
          const unsigned* cnt = (const unsigned*)(ws + WS_CTL) + CW_CNT + sg * 64; build_ptab(C, cnt);
          volatile LAS int* T = (volatile LAS int*)(C.lds + MISC_OFF);
          SchedMoE<4> S{(const char*)(ar + AR_ACT), (const char*)(ws + WS_WD), (size_t)1024 * 1024 * 2, T + 64, T[16 + NEXP], G, cb};
          EpiE4 E{(bf16*)(ar + AR_XS), ((const float*)C.p(23)), (const float*)(ar + AR_ROWG)};
          pg8::gemm_phase<EpiE4, SchedMoE<4>, 1024, 1024, 16, false, true>(ring, S, E, wave_s);
          SEAM(e0 + 2); }
      if (EN(16) && IN(e0 + 3)) { OPAQ(); p_e5(C, sg); if (sg + 1 < NSG) p1_hext(C, 2 * (sg + 1)); SEAM(e0 + 3); }
    }
#undef IN
#undef NOCONT
#undef SEAM
}

extern "C" void kernel_launch(void* const* d_in, const int* in_sizes, int n_in, void* d_out, int out_size, void* d_ws, size_t ws_size, hipStream_t stream) {
    static int grid = 0;
    if (grid == 0) {
        if (n_in != 25 || in_sizes[0] != BATCH * SEQ * D || out_size != BATCH * SEQ * D || ws_size < WS_END) {
            fprintf(stderr, "kernel_launch: shape mismatch: n_in %d in0 %d out %d ws %zu (need %zu)\n", n_in, n_in > 0 ? in_sizes[0] : -1, out_size, ws_size, (size_t)WS_END); grid = -1; return; }
        int dev = 0, cus = 0, per_cu = 0;
        if (hipGetDevice(&dev) != hipSuccess || hipDeviceGetAttribute(&cus, hipDeviceAttributeMultiprocessorCount, dev) != hipSuccess) { grid = -1; return; }
        if (hipFuncSetAttribute((const void*)fwd_kernel, hipFuncAttributeMaxDynamicSharedMemorySize, LDS_BYTES) != hipSuccess) { fprintf(stderr, "kernel_launch: hipFuncSetAttribute failed\n"); grid = -1; return; }
        if (hipOccupancyMaxActiveBlocksPerMultiprocessor(&per_cu, (const void*)fwd_kernel, 512, LDS_BYTES) != hipSuccess || per_cu < 1) fprintf(stderr, "kernel_launch: occupancy query reports %d\n", per_cu);
        (void)hipGetLastError();
        grid = cus < 256 ? cus : 256;
    }
    if (grid < 0) return;
    if (hipMemsetAsync((char*)d_ws + WS_CTL, 0, CTL_ZERO_BYTES, stream) != hipSuccess) return;
    Params p{};
    for (int i = 0; i < 25; ++i) p.in[i] = (const float*)d_in[i];
    p.out = (float*)d_out; p.ws = (unsigned char*)d_ws;
#if MK_ONE_LAUNCH
    p.ph_lo = 0; p.ph_hi = NSTEPS;
    hipLaunchKernelGGL(fwd_kernel, dim3(grid), dim3(512), LDS_BYTES, stream, p);
#else
    for (int s = 0; s < NSTEPS; ++s) { p.ph_lo = s; p.ph_hi = s + 1; hipLaunchKernelGGL(fwd_kernel, dim3(grid), dim3(512), LDS_BYTES, stream, p); }
#endif
}
```
